# Optimizing an MI355X kernel written in HIP

```python
import functools
import jax, jax.numpy as jnp
from jax import lax
import numpy as np

D_MODEL = 1024
BATCH = 2
SEQ = 16384
DEPTH = 1
DEC_BATCH = 32
DEC_SEQ = 16
PAST_LEN = 2048

CHUNK = 64
N_META = 16
GLA_HEADS = 4
GLA_DK = 128
GLA_DV = 256
GLA_RANK = 16
GLA_TAU = 16.0
GLA_BLOCK = 64
DSA_HEADS = 16
DSA_KV_HEADS = 4
DSA_HEAD_DIM = 64
DSA_GROUP = DSA_HEADS // DSA_KV_HEADS
DSA_SCALE = DSA_HEAD_DIM ** -0.5
IDX_HEADS = 8
IDX_DIM = 64
IDX_W_SCALE = (IDX_HEADS ** -0.5) * (IDX_DIM ** -0.5)
TOPK_MAX = 256
Q_BLOCK = 128
NORM_EPS = 1e-5
ALPHA = (2.0 * DEPTH) ** 0.25
BETA = (8.0 * DEPTH) ** -0.25
GLA_QK = GLA_HEADS * GLA_DK
GLA_V = GLA_HEADS * GLA_DV
DSA_Q = DSA_HEADS * DSA_HEAD_DIM
DSA_KV = DSA_KV_HEADS * DSA_HEAD_DIM
IDX_Q = IDX_HEADS * IDX_DIM
SPLITS = (GLA_QK, GLA_QK, GLA_V, GLA_RANK, GLA_V,
          DSA_Q, DSA_KV, DSA_KV, IDX_Q, IDX_DIM, IDX_HEADS, DSA_Q,
          D_MODEL, D_MODEL)
IN_COLS = sum(SPLITS)
SPLIT_OFFSETS = tuple(int(o) for o in np.cumsum(SPLITS)[:-1])

kernel_name = 'hybrid_gla_dsa_streaming_step'


def layer_norm(x, g, b):
    xf = x.astype(jnp.float32)
    mu = jnp.mean(xf, axis=-1, keepdims=True)
    xc = xf - mu
    var = jnp.mean(xc * xc, axis=-1, keepdims=True)
    return (xc * lax.rsqrt(var + NORM_EPS) * g.astype(jnp.float32) + b.astype(jnp.float32)).astype(x.dtype)


def gla_recurrence(q, k, v, log_f, s0):
    bsz, t = q.shape[0], q.shape[1]
    blk = min(GLA_BLOCK, t)
    nb = -(-t // blk)
    pad = nb * blk - t

    def to_blocks(a):
        a = jnp.pad(a.astype(jnp.float32), ((0, 0), (0, pad), (0, 0), (0, 0)))
        return a.reshape(bsz, nb, blk, a.shape[2], a.shape[3]).transpose(1, 0, 3, 2, 4)

    causal = jnp.tril(jnp.ones((blk, blk), dtype=bool))[:, :, None]

    def step(s, xs):
        qc, kc, vc, gc = xs
        b = jnp.cumsum(gc, axis=2)
        rel = jnp.where(causal, b[:, :, :, None, :] - b[:, :, None, :, :], -jnp.inf)
        a = jnp.einsum('bhid,bhjd,bhijd->bhij', qc, kc, jnp.exp(rel))
        o = (jnp.einsum('bhid,bhde->bhie', qc * jnp.exp(b), s)
             + jnp.einsum('bhij,bhje->bhie', a, vc))
        b_end = b[:, :, -1, :]
        s_new = (jnp.exp(b_end)[..., None] * s
                 + jnp.einsum('bhjd,bhje->bhde', kc * jnp.exp(b_end[:, :, None, :] - b), vc))
        return s_new, o

    s_t, o = lax.scan(step, s0.astype(jnp.float32),
                      (to_blocks(q), to_blocks(k), to_blocks(v), to_blocks(log_f)))
    o = o.transpose(1, 0, 3, 2, 4).reshape(bsz, nb * blk, q.shape[2], v.shape[3])[:, :t]
    return o, s_t


def dsa_select_attend(q, q_i, w_i, adm, k_all, v_all, ki_all, topk):
    bsz, nq = q.shape[0], q.shape[1]
    rel = jax.nn.relu(jnp.einsum('bqhd,bsd->bqhs', q_i.astype(jnp.float32), ki_all.astype(jnp.float32)))
    score = jnp.einsum('bqhs,bqh->bqs', rel, w_i.astype(jnp.float32))
    score = jnp.where(adm[None], score, -jnp.inf)
    top_val, top_idx = lax.top_k(score, topk)
    keep = jnp.isfinite(top_val)
    gather = jax.vmap(lambda rows, idx: rows[idx])
    k_sel = gather(k_all, top_idx)
    v_sel = gather(v_all, top_idx)
    qg = q.reshape(bsz, nq, DSA_KV_HEADS, DSA_GROUP, DSA_HEAD_DIM).astype(jnp.float32)
    logits = jnp.einsum('bqgrd,bqkgd->bqgrk', qg, k_sel.astype(jnp.float32)) * DSA_SCALE
    logits = jnp.where(keep[:, :, None, None, :], logits, -jnp.inf)
    p = jax.nn.softmax(logits, axis=-1)
    o = jnp.einsum('bqgrk,bqkgd->bqgrd', p, v_sel.astype(jnp.float32))
    return o.reshape(bsz, nq, DSA_Q).astype(q.dtype)


def chunk_ids(n):
    pos = jnp.arange(n)
    return jnp.where(pos < N_META, -1, (pos - N_META) // CHUNK)


def prompt_attend(q, q_i, w_i, k, v, k_i):
    bsz, t = q.shape[0], q.shape[1]
    nb = -(-t // Q_BLOCK)
    pad = nb * Q_BLOCK - t
    topk = min(TOPK_MAX, (t - N_META) // 4)
    chunk_k = chunk_ids(t)
    chunk_q = chunk_ids(nb * Q_BLOCK).reshape(nb, Q_BLOCK)

    def blocks(a):
        a = jnp.pad(a, [(0, 0), (0, pad)] + [(0, 0)] * (a.ndim - 2))
        return a.reshape((bsz, nb, Q_BLOCK) + a.shape[2:]).swapaxes(0, 1)

    def one_block(xs):
        qb, qib, wib, cq = xs
        adm = chunk_k[None, :] <= cq[:, None]
        return dsa_select_attend(qb, qib, wib, adm, k, v, k_i, topk)

    o = lax.map(one_block, (blocks(q), blocks(q_i), blocks(w_i), chunk_q))
    return o.swapaxes(0, 1).reshape(bsz, nb * Q_BLOCK, DSA_Q)[:, :t]


def sample_attend(cache_k_l, cache_v_l, cache_ik_l, q, q_i, w_i, k, v, k_i):
    k_all = jnp.concatenate([cache_k_l.astype(k.dtype), k], axis=1)
    v_all = jnp.concatenate([cache_v_l.astype(v.dtype), v], axis=1)
    ki_all = jnp.concatenate([cache_ik_l.astype(k_i.dtype), k_i], axis=1)
    n_keys = k_all.shape[1]
    topk = min(TOPK_MAX, n_keys // 4)
    adm = jnp.ones((q.shape[1], n_keys), dtype=bool)
    return dsa_select_attend(q, q_i, w_i, adm, k_all, v_all, ki_all, topk)


def layer_forward(h, s0, attend, w_in, gla_w2, gla_gate_b, gla_norm_g, idx_kn_g, idx_kn_b,
                  w_gla, w_dsa, gate_b, w_out, ln_g, ln_b):
    bsz, t, _ = h.shape
    (g_q, g_k, g_v, g_low, g_r, d_q, d_k, d_v, i_q, i_k, i_w, d_z, m_a, m_b) = jnp.split(
        h @ w_in, SPLIT_OFFSETS, axis=-1)
    q = (g_q * GLA_DK ** -0.5).reshape(bsz, t, GLA_HEADS, GLA_DK)
    k = g_k.reshape(bsz, t, GLA_HEADS, GLA_DK)
    v = g_v.reshape(bsz, t, GLA_HEADS, GLA_DV)
    log_f = (jax.nn.log_sigmoid((g_low @ gla_w2 + gla_gate_b).astype(jnp.float32)) / GLA_TAU
             ).reshape(bsz, t, GLA_HEADS, GLA_DK)
    o_a, s_t = gla_recurrence(q, k, v, log_f, s0)
    o_a = o_a * lax.rsqrt(jnp.mean(o_a * o_a, axis=-1, keepdims=True) + NORM_EPS) * gla_norm_g.astype(jnp.float32)
    y_a = (o_a.reshape(bsz, t, GLA_V).astype(h.dtype) * jax.nn.silu(g_r)) @ w_gla
    q_d = d_q.reshape(bsz, t, DSA_HEADS, DSA_HEAD_DIM)
    k_d = d_k.reshape(bsz, t, DSA_KV_HEADS, DSA_HEAD_DIM)
    v_d = d_v.reshape(bsz, t, DSA_KV_HEADS, DSA_HEAD_DIM)
    q_i = i_q.reshape(bsz, t, IDX_HEADS, IDX_DIM)
    k_i = layer_norm(i_k, idx_kn_g, idx_kn_b)
    w_i = i_w * IDX_W_SCALE
    o_b = attend(q_d, q_i, w_i, k_d, v_d, k_i)
    y_b = (o_b * jax.nn.silu(d_z)) @ w_dsa
    merged = jax.nn.sigmoid(m_a + gate_b[0]) * y_a + jax.nn.sigmoid(m_b + gate_b[1]) * y_b
    h_new = layer_norm(ALPHA * h + merged @ w_out, ln_g, ln_b)
    return h_new, k_d, v_d, k_i, s_t


def setup_inputs(seed: int = 0) -> dict:
    key = jax.random.key(seed)
    ks = jax.random.split(key, 24)
    n = jax.random.normal
    f32 = jnp.float32
    return {
        'x_prompt': n(ks[0], (BATCH, SEQ, D_MODEL), f32),
        'x_sample': n(ks[1], (DEC_BATCH, DEC_SEQ, D_MODEL), f32),
        'cache_k': n(ks[2], (DEPTH, DEC_BATCH, PAST_LEN, DSA_KV_HEADS, DSA_HEAD_DIM), f32),
        'cache_v': n(ks[3], (DEPTH, DEC_BATCH, PAST_LEN, DSA_KV_HEADS, DSA_HEAD_DIM), f32),
        'cache_idx_k': n(ks[4], (DEPTH, DEC_BATCH, PAST_LEN, IDX_DIM), f32),
        'state_gla': n(ks[5], (DEPTH, DEC_BATCH, GLA_HEADS, GLA_DK, GLA_DV), f32),
        'meta': n(ks[6], (N_META, D_MODEL), f32),
        'ln_in_g': 1.0 + 0.02 * n(ks[7], (D_MODEL,), f32),
        'ln_in_b': 0.02 * n(ks[8], (D_MODEL,), f32),
        'w_in': n(ks[9], (DEPTH, D_MODEL, IN_COLS), f32) * D_MODEL ** -0.5,
        'gla_w2': n(ks[10], (DEPTH, GLA_RANK, GLA_QK), f32) * GLA_RANK ** -0.5,
        'gla_gate_b': 0.1 * n(ks[11], (DEPTH, GLA_QK), f32),
        'gla_norm_g': 1.0 + 0.02 * n(ks[12], (DEPTH, GLA_DV), f32),
        'idx_kn_g': 1.0 + 0.02 * n(ks[13], (DEPTH, IDX_DIM), f32),
        'idx_kn_b': 0.02 * n(ks[14], (DEPTH, IDX_DIM), f32),
        'w_gla': n(ks[15], (DEPTH, GLA_V, D_MODEL), f32) * (GLA_V ** -0.5) * BETA,
        'w_dsa': n(ks[16], (DEPTH, DSA_Q, D_MODEL), f32) * (DSA_Q ** -0.5) * BETA,
        'gate_b': 0.02 * n(ks[17], (DEPTH, 2, D_MODEL), f32),
        'w_out': n(ks[18], (DEPTH, D_MODEL, D_MODEL), f32) * (D_MODEL ** -0.5) * BETA,
        'ln_g': 1.0 + 0.02 * n(ks[19], (DEPTH, D_MODEL), f32),
        'ln_b': 0.02 * n(ks[20], (DEPTH, D_MODEL), f32),
    }


def reference(x_prompt, x_sample, cache_k, cache_v, cache_idx_k, state_gla, meta, ln_in_g, ln_in_b,
              w_in, gla_w2, gla_gate_b, gla_norm_g, idx_kn_g, idx_kn_b, w_gla, w_dsa, gate_b,
              w_out, ln_g, ln_b):
    bsz = x_prompt.shape[0]
    meta_rows = jnp.broadcast_to(meta.astype(x_prompt.dtype)[None], (bsz, N_META, meta.shape[-1]))
    h_p = layer_norm(jnp.concatenate([meta_rows, x_prompt], axis=1), ln_in_g, ln_in_b)
    h_s = layer_norm(x_sample, ln_in_g, ln_in_b)
    s0_p = jnp.zeros((bsz, GLA_HEADS, GLA_DK, GLA_DV), jnp.float32)
    kp, vp, ikp, sp = [], [], [], []
    ksm, vsm, iks, ssm = [], [], [], []
    for l in range(DEPTH):
        weights = (w_in[l], gla_w2[l], gla_gate_b[l], gla_norm_g[l], idx_kn_g[l], idx_kn_b[l],
                   w_gla[l], w_dsa[l], gate_b[l], w_out[l], ln_g[l], ln_b[l])
        h_p, k_l, v_l, ik_l, s_l = layer_forward(h_p, s0_p, prompt_attend, *weights)
        kp.append(k_l); vp.append(v_l); ikp.append(ik_l); sp.append(s_l)
        attend_s = functools.partial(sample_attend, cache_k[l], cache_v[l], cache_idx_k[l])
        h_s, k_l, v_l, ik_l, s_l = layer_forward(h_s, state_gla[l], attend_s, *weights)
        ksm.append(k_l); vsm.append(v_l); iks.append(ik_l); ssm.append(s_l)
    y_prompt = h_p[:, N_META:]
    y_sample = h_s
    k_prompt = jnp.stack(kp, axis=0)
    v_prompt = jnp.stack(vp, axis=0)
    idx_k_prompt = jnp.stack(ikp, axis=0)
    gla_prompt = jnp.stack(sp, axis=0)
    k_sample = jnp.stack(ksm, axis=0)
    v_sample = jnp.stack(vsm, axis=0)
    idx_k_sample = jnp.stack(iks, axis=0)
    gla_sample = jnp.stack(ssm, axis=0)
    return (y_prompt, y_sample, k_prompt, v_prompt, idx_k_prompt, gla_prompt,
            k_sample, v_sample, idx_k_sample, gla_sample)
```

```cpp
#include <hip/hip_runtime.h>
#include <hip/hip_bf16.h>
#include <hip/hip_cooperative_groups.h>
#include <stdint.h>
#include <stdio.h>
namespace cg = cooperative_groups;

typedef unsigned short u16;
typedef uint32_t u32;
typedef __attribute__((ext_vector_type(8))) short bf16x8;
typedef __attribute__((ext_vector_type(4))) short s16x4;
typedef __attribute__((ext_vector_type(4))) float f32x4;
typedef __attribute__((ext_vector_type(16))) float f32x16;
typedef short v4i16_t __attribute__((ext_vector_type(4)));
typedef __attribute__((ext_vector_type(4))) unsigned int u32x4;
typedef __attribute__((address_space(3))) v4i16_t* lds_v4p;

#ifndef ONE_LAUNCH
#define ONE_LAUNCH 1
#endif

#define DM 1024
#define SEQP 16400
#define NPROMPT_ROWS 32800
#define NROWS 33312
#define RPMAX 16912
#define NCOL 8320
#define C_GQ 0
#define C_GK 512
#define C_GV 1024
#define C_GR 2048
#define C_DQ 3072
#define C_DK 4096
#define C_DV 4352
#define C_IQ 4608
#define C_DZ 5120
#define C_MA 6144
#define C_MB 7168
#define C_SM 8192
#define NKEYS_S 2064
#define CAP 576
#define CLIMIT 544
#define CVN 9
#define NORM_EPS 1e-5f
#define ALPHA_F 1.189207115002721f
#define IDX_W_SCALE 0.04419417382415922f
#define GLA_QSCALE 0.08838834764831845f
#define DSA_SCALE 0.125f

struct Params {
  const float *x_prompt, *x_sample, *cache_k, *cache_v, *cache_idx_k, *state_gla, *meta, *ln_in_g, *ln_in_b,
      *w_in, *gla_w2, *gla_gate_b, *gla_norm_g, *idx_kn_g, *idx_kn_b, *w_gla, *w_dsa, *gate_b, *w_out, *ln_g, *ln_b;
  float *y_prompt, *y_sample, *k_prompt, *v_prompt, *idx_k_prompt, *gla_prompt, *k_sample, *v_sample, *idx_k_sample, *gla_sample;
  u16 *WinT, *WglaT, *WdsaT, *WoutT, *H, *P, *KI, *US, *KVS, *KIS, *SEL, *KVP;
  float *STATS, *PS, *DEC;
  unsigned* bar;
};

#define XB_TMO      128
#define XB_XCNT(j)  (256  + 64 * (j))
#define XB_XSUB(j)  (1280 + 64 * (j))
#define XB_XGEN(j)  (2304 + 64 * (j))
#define XB_TOP      3328
#define XB_TOPGEN   3392
#define XCD_BAR_WORDS 3456
#define XB_SPIN_CAP (1u << 22)
#define LAS __attribute__((address_space(3)))
__device__ __forceinline__ unsigned xb_ld(unsigned* p)              { return __hip_atomic_load(p, __ATOMIC_RELAXED, __HIP_MEMORY_SCOPE_AGENT); }
__device__ __forceinline__ unsigned xb_add(unsigned* p, unsigned v) { return __hip_atomic_fetch_add(p, v, __ATOMIC_RELAXED, __HIP_MEMORY_SCOPE_AGENT); }
__device__ __forceinline__ unsigned xb_xcc_id() { return (unsigned)__builtin_amdgcn_s_getreg((3 << 11) | 20) & 0xFu; }
#define XB_SPIN(cond, bar) do { unsigned _sp = 0; while (cond) { __builtin_amdgcn_s_sleep(1); \
    if ((++_sp & 255u) == 0u) { if (xb_ld(&(bar)[XB_TMO])) break; if (_sp > XB_SPIN_CAP) { atomicAdd(&(bar)[XB_TMO], 1u); break; } } } } while (0)
struct XcdBarrier { unsigned* bar; unsigned x; volatile LAS unsigned* st; };
__device__ __forceinline__ XcdBarrier xcd_barrier_post(unsigned* bar, volatile LAS unsigned* st) {
    XcdBarrier b; b.bar = bar; b.x = xb_xcc_id(); b.st = st;
    if (threadIdx.x == 0) (void)xb_add(&bar[XB_XCNT(b.x)], 1u);
    return b;
}
__device__ __forceinline__ void xcd_barrier_complete(unsigned* bar, unsigned x, unsigned& nloc, unsigned& nx) {
    const unsigned G = gridDim.x * gridDim.y * gridDim.z;
    unsigned sum, cnt, mine, sp = 0u;
    for (;;) {
        sum = 0u; cnt = 0u; mine = 0u;
#pragma unroll
        for (unsigned j = 0; j < 16; ++j) { const unsigned c = xb_ld(&bar[XB_XCNT(j)]); sum += c; cnt += (c > 0u) ? 1u : 0u; mine = (j == x) ? c : mine; }
        if (sum == G) break;
        __builtin_amdgcn_s_sleep(1);
        if ((++sp & 255u) == 0u) { if (xb_ld(&bar[XB_TMO])) break; if (sp > XB_SPIN_CAP) { atomicAdd(&bar[XB_TMO], 1u); break; } }
    }
    nloc = mine > 0u ? mine : 1u; nx = cnt > 0u ? cnt : 1u;
}
__device__ __forceinline__ void xcd_barrier(const XcdBarrier& b) {
    asm volatile("s_waitcnt vmcnt(0)" ::: "memory");
    __syncthreads();
    if (threadIdx.x == 0) {
        unsigned* bar = b.bar;
        __builtin_amdgcn_s_waitcnt(0);
        unsigned nloc = b.st[0], nx = b.st[1];
        if (nloc == 0u) { xcd_barrier_complete(bar, b.x, nloc, nx); b.st[0] = nloc; b.st[1] = nx; }
        const unsigned old = xb_add(&bar[XB_XSUB(b.x)], 1u);
        const unsigned gen = old / nloc;
        if (old + 1u == (gen + 1u) * nloc) {
            __builtin_amdgcn_fence(__ATOMIC_RELEASE, "agent");
            asm volatile("s_waitcnt vmcnt(0)" ::: "memory");
            const unsigned og = xb_add(&bar[XB_TOP], 1u);
            const unsigned tg = og / nx;
            if (og + 1u == (tg + 1u) * nx) xb_add(&bar[XB_TOPGEN], 1u);
            else XB_SPIN(xb_ld(&bar[XB_TOPGEN]) == tg, bar);
            __builtin_amdgcn_fence(__ATOMIC_ACQUIRE, "agent");
            xb_add(&bar[XB_XGEN(b.x)], 1u);
            asm volatile("s_waitcnt vmcnt(0)" ::: "memory");
        } else {
            XB_SPIN(xb_ld(&bar[XB_XGEN(b.x)]) == gen, bar);
            __builtin_amdgcn_fence(__ATOMIC_ACQUIRE, "agent");
            asm volatile("s_waitcnt vmcnt(0)" ::: "memory");
        }
    }
    __syncthreads();
}

__device__ __forceinline__ int tid_opaque() { int t = threadIdx.x; asm volatile("" : "+v"(t)); return t; }
#define TIDX tid_opaque()
__device__ __forceinline__ u16 f2bf(float f) {
  u32 u = __float_as_uint(f);
  u += 0x7fffu + ((u >> 16) & 1u);
  return (u16)(u >> 16);
}
__device__ __forceinline__ float bf2f(u16 h) { return __uint_as_float(((u32)h) << 16); }
__device__ __forceinline__ u32 pack2(float a, float b) { return (u32)f2bf(a) | ((u32)f2bf(b) << 16); }
__device__ __forceinline__ float relu1(float x) { float r; asm("v_max_f32 %0, 0, %1" : "=v"(r) : "v"(x)); return r; }
__device__ __forceinline__ u32 cvt_pk_bf16(float lo, float hi) { u32 r; asm("v_cvt_pk_bf16_f32 %0, %1, %2" : "=v"(r) : "v"(lo), "v"(hi)); return r; }
__device__ __forceinline__ float sigmoidf_(float x) { return 1.f / (1.f + __expf(-x)); }
__device__ __forceinline__ float siluf_(float x) { return x / (1.f + __expf(-x)); }

__device__ __forceinline__ float wave_sum(float v) {
#pragma unroll
  for (int o = 32; o > 0; o >>= 1) v += __shfl_xor(v, o);
  return v;
}

__device__ __forceinline__ const float* xrow_ptr(const Params& p, int gr) {
  if (gr < NPROMPT_ROWS) {
    int b = gr / SEQP, pos = gr - b * SEQP;
    return pos < 16 ? p.meta + pos * DM : p.x_prompt + ((size_t)b * 16384 + (pos - 16)) * DM;
  }
  return p.x_sample + (size_t)(gr - NPROMPT_ROWS) * DM;
}
__device__ __forceinline__ float* yrow_ptr(const Params& p, int gr) {
  if (gr < NPROMPT_ROWS) {
    int b = gr / SEQP, pos = gr - b * SEQP;
    return pos < 16 ? nullptr : p.y_prompt + ((size_t)b * 16384 + (pos - 16)) * DM;
  }
  return p.y_sample + (size_t)(gr - NPROMPT_ROWS) * DM;
}

__device__ __forceinline__ int src_col(int n) {
  if (n < 2048) return n;
  if (n < 3072) return n - 2048 + 2064;
  if (n < 4096) return n - 3072 + 3088;
  if (n < 4352) return n - 4096 + 4112;
  if (n < 4608) return n - 4352 + 4368;
  if (n < 5120) return n - 4608 + 4624;
  if (n < 6144) return n - 5120 + 5208;
  if (n < 7168) return n - 6144 + 6232;
  if (n < 8192) return n - 7168 + 7256;
  if (n < 8256) return n - 8192 + 5136;
  if (n < 8272) return n - 8256 + 2048;
  if (n < 8280) return n - 8272 + 5200;
  return -1;
}

__device__ __forceinline__ int pass_row0(int pass) { return pass == 0 ? 0 : SEQP; }
__device__ __forceinline__ int pass_rows(int pass) { return pass == 0 ? SEQP : RPMAX; }
__device__ __forceinline__ int pass_nblk(int pass) { return pass == 0 ? 257 : 289; }
__device__ __forceinline__ void blk_info(int blk, int& row0, int& len) {
  if (blk < 257) { row0 = blk * 64; len = (blk == 256) ? 16 : 64; }
  else { row0 = SEQP + 16 * (blk - 257); len = 16; }
}

__device__ __forceinline__ int dq_next(unsigned* ctr, char* lds) {
  int* item = (int*)(lds + 77808);
  __syncthreads();
  if (TIDX == 0) *item = (int)atomicAdd(ctr, 1u);
  __syncthreads();
  return *item;
}

__device__ __forceinline__ void transpose_tile(const float* __restrict__ src, int nsrc, u16* __restrict__ dst, int k0, int n0, bool map, float* tile) {
  int tx = TIDX & 63, ty = TIDX >> 6;
  int sc = map ? src_col(n0 + tx) : (n0 + tx);
  for (int kk = ty; kk < 64; kk += 4) tile[kk * 65 + tx] = sc >= 0 ? src[(size_t)(k0 + kk) * nsrc + sc] : 0.f;
  __syncthreads();
  for (int nn = ty; nn < 64; nn += 4) dst[(size_t)(n0 + nn) * DM + k0 + tx] = f2bf(tile[tx * 65 + nn]);
  __syncthreads();
}

__device__ __forceinline__ void phase_prep(const Params& p, char* lds) {
  float* tile = (float*)lds;
  const int nt_in = 130 * 16;
  const int nt_all = nt_in + 3 * 256;
  for (int t = blockIdx.x; t < nt_all; t += gridDim.x) {
    if (t < nt_in) {
      transpose_tile(p.w_in, 8280, p.WinT, (t & 15) * 64, (t >> 4) * 64, true, tile);
    } else {
      int u = t - nt_in, w = u >> 8, r = u & 255;
      const float* s = w == 0 ? p.w_gla : (w == 1 ? p.w_dsa : p.w_out);
      u16* d = w == 0 ? p.WglaT : (w == 1 ? p.WdsaT : p.WoutT);
      transpose_tile(s, DM, d, (r & 15) * 64, (r >> 4) * 64, false, tile);
    }
  }
  const size_t nk4 = (size_t)32 * 2048 * 256 / 4;
  size_t stride = (size_t)gridDim.x * blockDim.x;
  for (size_t i = (size_t)blockIdx.x * blockDim.x + TIDX; i < nk4; i += stride) {
    size_t e = i * 4; size_t row = e >> 8; int c = (int)(e & 255);
    size_t sb = row >> 11, j = row & 2047;
    float4 kv = *(const float4*)(p.cache_k + e);
    float4 vv = *(const float4*)(p.cache_v + e);
    u16* o = p.KVS + (sb * NKEYS_S + j) * 512 + c;
    *(uint2*)o = make_uint2(pack2(kv.x, kv.y), pack2(kv.z, kv.w));
    *(uint2*)(o + 256) = make_uint2(pack2(vv.x, vv.y), pack2(vv.z, vv.w));
  }
  const size_t ni4 = (size_t)32 * 2048 * 64 / 4;
  for (size_t i = (size_t)blockIdx.x * blockDim.x + TIDX; i < ni4; i += stride) {
    size_t e = i * 4; size_t row = e >> 6; int c = (int)(e & 63);
    size_t sb = row >> 11, j = row & 2047;
    float4 kv = *(const float4*)(p.cache_idx_k + e);
    *(uint2*)(p.KIS + (sb * NKEYS_S + j) * 64 + c) = make_uint2(pack2(kv.x, kv.y), pack2(kv.z, kv.w));
  }
}

__device__ __forceinline__ void phase_ln_in(const Params& p, int pass) {
  int R = pass_rows(pass), r0 = pass_row0(pass);
  int wave = TIDX >> 6, lane = TIDX & 63;
  for (int m = blockIdx.x * 4 + wave; m < R; m += gridDim.x * 4) {
    int gr = r0 + m;
    const float* x = xrow_ptr(p, gr);
    float4 v[4];
    float s = 0.f;
#pragma unroll
    for (int i = 0; i < 4; ++i) { v[i] = *(const float4*)(x + i * 256 + lane * 4); s += v[i].x + v[i].y + v[i].z + v[i].w; }
    float mu = wave_sum(s) * (1.f / DM);
    float q = 0.f;
#pragma unroll
    for (int i = 0; i < 4; ++i) {
      float a = v[i].x - mu, b = v[i].y - mu, c = v[i].z - mu, d = v[i].w - mu;
      q += a * a + b * b + c * c + d * d;
    }
    float rstd = rsqrtf(wave_sum(q) * (1.f / DM) + NORM_EPS);
#pragma unroll
    for (int i = 0; i < 4; ++i) {
      int c = i * 256 + lane * 4;
      float4 g = *(const float4*)(p.ln_in_g + c), b = *(const float4*)(p.ln_in_b + c);
      float h0 = (v[i].x - mu) * rstd * g.x + b.x, h1 = (v[i].y - mu) * rstd * g.y + b.y;
      float h2 = (v[i].z - mu) * rstd * g.z + b.z, h3 = (v[i].w - mu) * rstd * g.w + b.w;
      *(uint2*)(p.H + (size_t)m * DM + c) = make_uint2(pack2(h0, h1), pack2(h2, h3));
    }
    if (lane == 0) { p.STATS[gr * 2] = mu; p.STATS[gr * 2 + 1] = rstd; }
  }
}

#define GS 72
template <bool SWAP = false>
__device__ __forceinline__ void gemm_core(const u16* __restrict__ A, int lda, int m0, int mvalid,
                                          const u16* __restrict__ B, int ldb, int n0, int K,
                                          f32x16 (&acc)[2][2], u16* lds) {
  const int tid = TIDX, lane = tid & 63, w = tid >> 6, wm = w >> 1, wn = w & 1;
  u16* As = lds;
  u16* Bs = lds + 2 * 128 * GS;
  uint4 ra0, ra1, ra2, ra3, rb0, rb1, rb2, rb3;
  const int nk = K >> 6;
  const int lrow = tid >> 3, lch = tid & 7;
  const u16* ap[4]; const u16* bp[4];
#pragma unroll
  for (int i = 0; i < 4; ++i) {
    int ar = m0 + lrow + 32 * i; ar = ar < mvalid ? ar : mvalid - 1;
    ap[i] = A + (size_t)ar * lda + lch * 8;
    bp[i] = B + (size_t)(n0 + lrow + 32 * i) * ldb + lch * 8;
  }
#define GLOAD(kt) do { \
    ra0 = *(const uint4*)(ap[0] + (kt) * 64); ra1 = *(const uint4*)(ap[1] + (kt) * 64); \
    ra2 = *(const uint4*)(ap[2] + (kt) * 64); ra3 = *(const uint4*)(ap[3] + (kt) * 64); \
    rb0 = *(const uint4*)(bp[0] + (kt) * 64); rb1 = *(const uint4*)(bp[1] + (kt) * 64); \
    rb2 = *(const uint4*)(bp[2] + (kt) * 64); rb3 = *(const uint4*)(bp[3] + (kt) * 64); } while (0)
#define GSWRITE(buf) do { \
    u16* as_ = As + ((buf) * 128 + lrow) * GS + lch * 8; u16* bs_ = Bs + ((buf) * 128 + lrow) * GS + lch * 8; \
    *(uint4*)(as_) = ra0; *(uint4*)(as_ + 32 * GS) = ra1; *(uint4*)(as_ + 64 * GS) = ra2; *(uint4*)(as_ + 96 * GS) = ra3; \
    *(uint4*)(bs_) = rb0; *(uint4*)(bs_ + 32 * GS) = rb1; *(uint4*)(bs_ + 64 * GS) = rb2; *(uint4*)(bs_ + 96 * GS) = rb3; } while (0)
  GLOAD(0);
  GSWRITE(0);
  __syncthreads();
  for (int kt = 0; kt < nk; ++kt) {
    int buf = kt & 1;
    if (kt + 1 < nk) GLOAD(kt + 1);
    __builtin_amdgcn_sched_barrier(0);
    bf16x8 af[4][2], bf[4][2];
#pragma unroll
    for (int ks = 0; ks < 4; ++ks)
#pragma unroll
      for (int t = 0; t < 2; ++t) {
        af[ks][t] = *(const bf16x8*)(As + (buf * 128 + wm * 64 + t * 32 + (lane & 31)) * GS + ks * 16 + (lane >> 5) * 8);
        bf[ks][t] = *(const bf16x8*)(Bs + (buf * 128 + wn * 64 + t * 32 + (lane & 31)) * GS + ks * 16 + (lane >> 5) * 8);
      }
    __builtin_amdgcn_sched_barrier(0);
#pragma unroll
    for (int ks = 0; ks < 4; ++ks)
#pragma unroll
      for (int tm = 0; tm < 2; ++tm)
#pragma unroll
        for (int tn = 0; tn < 2; ++tn)
          acc[tm][tn] = SWAP ? __builtin_amdgcn_mfma_f32_32x32x16_bf16(bf[ks][tn], af[ks][tm], acc[tm][tn], 0, 0, 0)
                             : __builtin_amdgcn_mfma_f32_32x32x16_bf16(af[ks][tm], bf[ks][tn], acc[tm][tn], 0, 0, 0);
    __builtin_amdgcn_sched_barrier(0);
    if (kt + 1 < nk) GSWRITE(buf ^ 1);
    __syncthreads();
  }
}
#define ACC_ROW(wm, tm, r, lane) ((wm) * 64 + (tm) * 32 + ((r) & 3) + 8 * ((r) >> 2) + 4 * ((lane) >> 5))
#define ACC_COL(wn, tn, lane) ((wn) * 64 + (tn) * 32 + ((lane) & 31))

#define ES 136
__device__ __forceinline__ void store_tile_bf16(const f32x16 (&acc)[2][2], u16* lds, u16* __restrict__ dst, int ldd, int m0, int mvalid, int n0) {
  const int tid = TIDX, lane = tid & 63, w = tid >> 6, wm = w >> 1, wn = w & 1;
#pragma unroll
  for (int tm = 0; tm < 2; ++tm)
#pragma unroll
    for (int tn = 0; tn < 2; ++tn)
#pragma unroll
      for (int r = 0; r < 16; ++r)
        lds[ACC_ROW(wm, tm, r, lane) * ES + ACC_COL(wn, tn, lane)] = f2bf(acc[tm][tn][r]);
  __syncthreads();
#pragma unroll
  for (int i = 0; i < 8; ++i) {
    int c = tid + 256 * i, row = c >> 4, ch = c & 15;
    if (m0 + row < mvalid) *(uint4*)(dst + (size_t)(m0 + row) * ldd + n0 + ch * 8) = *(const uint4*)(lds + row * ES + ch * 8);
  }
  __syncthreads();
}

__device__ __forceinline__ void phase_gemm1(const Params& p, int pass, char* lds, unsigned xcc) {
  int R = pass_rows(pass), r0 = pass_row0(pass);
  int mt = (R + 127) >> 7;
  int lane = TIDX & 63, w = TIDX >> 6, wm = w >> 1, wn = w & 1;
  int* item = (int*)(lds + 77808);
  unsigned* ctr = p.bar + XCD_BAR_WORDS + 32 + pass * 8;
  int q = (int)(xcc & 7u), tries = 0;
  while (tries < 8) {
    __syncthreads();
    if (TIDX == 0) *item = (int)atomicAdd(&ctr[q], 1u);
    __syncthreads();
    int idx = *item;
    int nq = mt * 8 + (mt - q + 7) / 8;
    if (idx >= nq) { q = (q + 1) & 7; ++tries; continue; }
    int tm_, tn_;
    if (idx < mt * 8) { tm_ = idx >> 3; tn_ = q * 8 + (idx & 7); }
    else { tm_ = q + 8 * (idx - mt * 8); tn_ = 64; }
    int m0 = tm_ * 128, n0 = tn_ * 128;
    f32x16 acc[2][2];
#pragma unroll
    for (int i = 0; i < 2; ++i)
#pragma unroll
      for (int j = 0; j < 2; ++j)
#pragma unroll
        for (int r = 0; r < 16; ++r) acc[i][j][r] = 0.f;
    gemm_core<true>(p.H, DM, m0, R, p.WinT, DM, n0, DM, acc, (u16*)lds);
    int kind = 0;
    if (n0 >= C_DK && n0 < C_DV) kind = 1; else if (n0 >= C_DV && n0 < C_IQ) kind = 2; else if (n0 >= C_SM) kind = 3;
    const int half = lane >> 5;
#pragma unroll
    for (int tm = 0; tm < 2; ++tm) {
      int m = m0 + wm * 64 + tm * 32 + (lane & 31);
      if (kind != 3) {
#pragma unroll
        for (int tn = 0; tn < 2; ++tn)
#pragma unroll
          for (int gp = 0; gp < 2; ++gp) {
            u32 a0 = pack2(acc[tm][tn][8 * gp + 0], acc[tm][tn][8 * gp + 1]), a1 = pack2(acc[tm][tn][8 * gp + 2], acc[tm][tn][8 * gp + 3]);
            u32 b0 = pack2(acc[tm][tn][8 * gp + 4], acc[tm][tn][8 * gp + 5]), b1 = pack2(acc[tm][tn][8 * gp + 6], acc[tm][tn][8 * gp + 7]);
            auto s0 = __builtin_amdgcn_permlane32_swap(a0, b0, false, false);
            auto s1 = __builtin_amdgcn_permlane32_swap(a1, b1, false, false);
            int n = n0 + wn * 64 + tn * 32 + 8 * (2 * gp + half);
            if (m < R) *(uint4*)(p.P + (size_t)m * NCOL + n) = make_uint4(s0[0], s1[0], s0[1], s1[1]);
          }
      }
      if (kind != 0 && m < R) {
        int gr = r0 + m;
#pragma unroll
        for (int tn = 0; tn < 2; ++tn)
#pragma unroll
          for (int g = 0; g < 4; ++g) {
            int n = n0 + wn * 64 + tn * 32 + 8 * g + 4 * half;
            float4 v = make_float4(acc[tm][tn][4 * g + 0], acc[tm][tn][4 * g + 1], acc[tm][tn][4 * g + 2], acc[tm][tn][4 * g + 3]);
            if (kind == 3) {
              *(float4*)(p.PS + (size_t)m * 128 + (n - C_SM)) = v;
            } else {
              float* base = kind == 1 ? (gr < NPROMPT_ROWS ? p.k_prompt : p.k_sample) : (gr < NPROMPT_ROWS ? p.v_prompt : p.v_sample);
              int rr = gr < NPROMPT_ROWS ? gr : gr - NPROMPT_ROWS;
              *(float4*)(base + (size_t)rr * 256 + (n - (kind == 1 ? C_DK : C_DV))) = v;
            }
          }
      }
    }
  }
}

__device__ __forceinline__ void phase_tok(const Params& p, int pass, char* lds, bool dry) {
  float* glow = (float*)lds;
  int r0g = pass_row0(pass);
  int nblk = pass_nblk(pass);
  int tid = TIDX, lane = tid & 63, wave = tid >> 6;
  for (int tile = blockIdx.x; tile < nblk * 2; tile += gridDim.x) {
    int blk = tile >> 1, hf = tile & 1;
    int row0, len; blk_info(blk, row0, len);
    for (int t = wave; t < (hf == 0 ? len : 0); t += 4) {
      int m = row0 + t, gr = r0g + m;
      float x = p.PS[(size_t)m * 128 + lane];
      float mu = wave_sum(x) * (1.f / 64);
      float xc = x - mu;
      float var = wave_sum(xc * xc) * (1.f / 64);
      float y = xc * rsqrtf(var + NORM_EPS) * p.idx_kn_g[lane] + p.idx_kn_b[lane];
      u16 yb = f2bf(y);
      p.KI[(size_t)m * 64 + lane] = yb;
      if (gr < NPROMPT_ROWS) p.idx_k_prompt[(size_t)gr * 64 + lane] = y;
      else {
        int sr = gr - NPROMPT_ROWS; p.idx_k_sample[(size_t)sr * 64 + lane] = y;
        int sb = sr >> 4, tt = sr & 15;
        p.KIS[((size_t)sb * NKEYS_S + 2048 + tt) * 64 + lane] = yb;
      }
    }
    if (blk < 257 && hf == 0) {
      for (int i = tid; i < len * 64; i += 256) {
        int tt = i >> 6, c = (i & 63) * 8;
        *(uint4*)(p.KVP + (size_t)(row0 + tt) * 512 + c) = *(const uint4*)(p.P + (size_t)(row0 + tt) * NCOL + C_DK + c);
      }
    }
    if (blk >= 257 && hf == 0) {
      int sb = blk - 257;
      for (int i = tid; i < 16 * 512; i += 256) {
        int tt = i >> 9, c = i & 511;
        p.KVS[((size_t)sb * NKEYS_S + 2048 + tt) * 512 + c] = p.P[(size_t)(row0 + tt) * NCOL + C_DK + c];
      }
    }
    for (int i = tid; i < 64 * 16; i += 256) {
      int t = i >> 4, r = i & 15;
      glow[i] = t < len ? p.PS[(size_t)(row0 + t) * 128 + 64 + r] : 0.f;
    }
    __syncthreads();
    {
      const int ch = hf * 256 + tid;
      float w2[16];
#pragma unroll
      for (int r = 0; r < 16; ++r) w2[r] = p.gla_w2[r * 512 + ch];
      float bias = p.gla_gate_b[ch];
      float b = 0.f;
      for (int t = 0; t < len; ++t) {
        float x = bias;
#pragma unroll
        for (int r = 0; r < 16; ++r) x += glow[t * 16 + r] * w2[r];
        float ls = fminf(x, 0.f) - log1pf(expf(-fabsf(x)));
        b += ls * (1.f / 16.f);
        size_t o = (size_t)(row0 + t) * NCOL;
        float qv = bf2f(p.P[o + C_GQ + ch]) * GLA_QSCALE * expf(b);
        float kv = bf2f(p.P[o + C_GK + ch]) * expf(-b);
        if (!dry) { p.P[o + C_GQ + ch] = f2bf(qv); p.P[o + C_GK + ch] = f2bf(kv); }
      }
      p.DEC[blk * 512 + ch] = expf(b);
    }
    __syncthreads();
  }
}

#define TS 72
template <int NIT>
__device__ __forceinline__ void stage_transposed(const u16* __restrict__ P, int row0, int len, int col0, u16* dst) {
  const int tid = TIDX, t = tid & 63, dc0 = tid >> 6;
  u32x4 v[NIT];
  const u16* src = P + (size_t)(row0 + (t < len ? t : 0)) * NCOL + col0;
#pragma unroll
  for (int i = 0; i < NIT; ++i) v[i] = *(const u32x4*)(src + (dc0 + 4 * i) * 8);
  __builtin_amdgcn_sched_barrier(0);
#pragma unroll
  for (int i = 0; i < NIT; ++i) {
    u32x4 x = v[i];
    if (t >= len) x = u32x4{0u, 0u, 0u, 0u};
    u16* d = dst + ((dc0 + 4 * i) * 8) * TS + t;
    d[0 * TS] = (u16)(x[0] & 0xffff); d[1 * TS] = (u16)(x[0] >> 16);
    d[2 * TS] = (u16)(x[1] & 0xffff); d[3 * TS] = (u16)(x[1] >> 16);
    d[4 * TS] = (u16)(x[2] & 0xffff); d[5 * TS] = (u16)(x[2] >> 16);
    d[6 * TS] = (u16)(x[3] & 0xffff); d[7 * TS] = (u16)(x[3] >> 16);
  }
}

__device__ __forceinline__ void phase_u(const Params& p, int pass, char* lds) {
  u16* KT = (u16*)lds;
  u16* VT = KT + 128 * TS;
  int nblk = pass_nblk(pass);
  int lane = TIDX & 63, w = TIDX >> 6;
  unsigned* ctr = p.bar + XCD_BAR_WORDS + 64 + pass;
  for (int t = dq_next(ctr, lds); t < nblk * 4; t = dq_next(ctr, lds)) {
    int blk = t >> 2, h = t & 3;
    int row0, len; blk_info(blk, row0, len);
    stage_transposed<4>(p.P, row0, len, C_GK + h * 128, KT);
    stage_transposed<8>(p.P, row0, len, C_GV + h * 256, VT);
    __syncthreads();
#pragma unroll
    for (int half = 0; half < 2; ++half) {
      f32x16 acc[2][2];
#pragma unroll
      for (int i = 0; i < 2; ++i)
#pragma unroll
        for (int j = 0; j < 2; ++j)
#pragma unroll
          for (int r = 0; r < 16; ++r) acc[i][j][r] = 0.f;
#pragma unroll
      for (int ks = 0; ks < 4; ++ks) {
        bf16x8 a[2], b[2];
#pragma unroll
        for (int tn = 0; tn < 2; ++tn) {
          a[tn] = *(const bf16x8*)(VT + (w * 64 + tn * 32 + (lane & 31)) * TS + ks * 16 + (lane >> 5) * 8);
          b[tn] = *(const bf16x8*)(KT + (half * 64 + tn * 32 + (lane & 31)) * TS + ks * 16 + (lane >> 5) * 8);
        }
#pragma unroll
        for (int tm = 0; tm < 2; ++tm)
#pragma unroll
          for (int tn = 0; tn < 2; ++tn)
            acc[tm][tn] = __builtin_amdgcn_mfma_f32_32x32x16_bf16(a[tm], b[tn], acc[tm][tn], 0, 0, 0);
      }
#pragma unroll
      for (int tn = 0; tn < 2; ++tn) {
        int d = half * 64 + tn * 32 + (lane & 31);
        float dec = p.DEC[blk * 512 + h * 128 + d];
#pragma unroll
        for (int tm = 0; tm < 2; ++tm)
#pragma unroll
          for (int r = 0; r < 16; ++r) {
            int e = w * 64 + tm * 32 + (r & 3) + 8 * (r >> 2) + 4 * (lane >> 5);
            p.US[((size_t)(blk * 4 + h) * 256 + e) * 128 + d] = f2bf(acc[tm][tn][r] * dec);
          }
      }
    }
    __syncthreads();
  }
}

__device__ __forceinline__ void phase_scan(const Params& p, int pass, bool dry) {
  int ntiles = 128 + (pass == 1 ? 32 * 128 : 0);
  for (int t = blockIdx.x; t < ntiles; t += gridDim.x) {
    bool samp = t >= 128;
    int sb = samp ? (t - 128) >> 7 : 0;
    int g4 = ((samp ? (t - 128) & 127 : t) << 8) + TIDX;
    int h = g4 >> 13, e = (g4 >> 5) & 255, d4 = (g4 & 31) * 4;
    float S[4];
    float* outp;
    int blk0, nb;
    if (!samp) {
      S[0] = S[1] = S[2] = S[3] = 0.f;
      outp = p.gla_prompt + (size_t)pass * 131072;
      blk0 = 0; nb = 257;
    } else {
      const float* st = p.state_gla + (size_t)sb * 131072;
#pragma unroll
      for (int j = 0; j < 4; ++j) S[j] = st[((size_t)(h * 128 + d4 + j)) * 256 + e];
      outp = p.gla_sample + (size_t)sb * 131072;
      blk0 = 257 + sb; nb = 1;
    }
    size_t eoff = (size_t)g4 * 4;
    for (int n0 = 0; n0 < nb; n0 += 8) {
      uint2 u[8]; float4 dc[8];
#pragma unroll
      for (int j = 0; j < 8; ++j) {
        int n = n0 + j; if (n < nb) {
          u[j] = *(const uint2*)(p.US + (size_t)(blk0 + n) * 131072 + eoff);
          dc[j] = *(const float4*)(p.DEC + (blk0 + n) * 512 + h * 128 + d4);
        }
      }
      __builtin_amdgcn_sched_barrier(0);
#pragma unroll
      for (int j = 0; j < 8; ++j) {
        int n = n0 + j; if (n < nb) {
          if (!dry) *(uint2*)(p.US + (size_t)(blk0 + n) * 131072 + eoff) = make_uint2(pack2(S[0], S[1]), pack2(S[2], S[3]));
          S[0] = dc[j].x * S[0] + bf2f((u16)(u[j].x & 0xffff));
          S[1] = dc[j].y * S[1] + bf2f((u16)(u[j].x >> 16));
          S[2] = dc[j].z * S[2] + bf2f((u16)(u[j].y & 0xffff));
          S[3] = dc[j].w * S[3] + bf2f((u16)(u[j].y >> 16));
        }
      }
    }
#pragma unroll
    for (int j = 0; j < 4; ++j) outp[((size_t)(h * 128 + d4 + j)) * 256 + e] = S[j];
  }
}

#define OS 264
__device__ __forceinline__ void phase_o(const Params& p, int pass, char* lds, bool dry) {
  u16* VT = (u16*)lds;
  u16* AS = VT + 256 * TS;
  u16* OT = VT;
  int nblk = pass_nblk(pass);
  int tid = TIDX, lane = tid & 63, w = tid >> 6;
  int* item = (int*)(lds + 77808);
  unsigned* ctr = p.bar + XCD_BAR_WORDS + 48 + (dry ? 8 : 0) + pass;
  for (;;) {
    __syncthreads();
    if (tid == 0) *item = (int)atomicAdd(ctr, 1u);
    __syncthreads();
    int t = *item;
    if (t >= nblk * 4) break;
    int blk = t >> 2, h = t & 3;
    int row0, len; blk_info(blk, row0, len);
    stage_transposed<8>(p.P, row0, len, C_GV + h * 256, VT);
    {
      int ti = w >> 1, tj = w & 1;
      f32x16 acc;
#pragma unroll
      for (int r = 0; r < 16; ++r) acc[r] = 0.f;
      if (tj <= ti) {
        int qi = ti * 32 + (lane & 31), kj = tj * 32 + (lane & 31);
        const u16* qp = p.P + (size_t)(row0 + (qi < len ? qi : 0)) * NCOL + C_GQ + h * 128 + (lane >> 5) * 8;
        const u16* kp = p.P + (size_t)(row0 + (kj < len ? kj : 0)) * NCOL + C_GK + h * 128 + (lane >> 5) * 8;
#pragma unroll
        for (int ks = 0; ks < 8; ++ks) {
          bf16x8 a = *(const bf16x8*)(qp + ks * 16), b = *(const bf16x8*)(kp + ks * 16);
          acc = __builtin_amdgcn_mfma_f32_32x32x16_bf16(a, b, acc, 0, 0, 0);
        }
      }
#pragma unroll
      for (int r = 0; r < 16; ++r) {
        int i = ti * 32 + (r & 3) + 8 * (r >> 2) + 4 * (lane >> 5), j = tj * 32 + (lane & 31);
        float v = (j <= i && i < len && j < len) ? acc[r] : 0.f;
        AS[i * TS + j] = f2bf(v);
      }
    }
    __syncthreads();
    f32x16 acc[2][2];
#pragma unroll
    for (int i = 0; i < 2; ++i)
#pragma unroll
      for (int j = 0; j < 2; ++j)
#pragma unroll
        for (int r = 0; r < 16; ++r) acc[i][j][r] = 0.f;
#pragma unroll
    for (int ks = 0; ks < 4; ++ks) {
      bf16x8 a[2], b[2];
#pragma unroll
      for (int x = 0; x < 2; ++x) {
        a[x] = *(const bf16x8*)(AS + (x * 32 + (lane & 31)) * TS + ks * 16 + (lane >> 5) * 8);
        b[x] = *(const bf16x8*)(VT + (w * 64 + x * 32 + (lane & 31)) * TS + ks * 16 + (lane >> 5) * 8);
      }
#pragma unroll
      for (int tm = 0; tm < 2; ++tm)
#pragma unroll
        for (int tn = 0; tn < 2; ++tn)
          acc[tm][tn] = __builtin_amdgcn_mfma_f32_32x32x16_bf16(a[tm], b[tn], acc[tm][tn], 0, 0, 0);
    }
    {
      const u16* Sp = p.US + (size_t)(blk * 4 + h) * 32768;
#pragma unroll
      for (int ks = 0; ks < 8; ++ks) {
        bf16x8 a[2], b[2];
#pragma unroll
        for (int x = 0; x < 2; ++x) {
          int qi = x * 32 + (lane & 31);
          bf16x8 z = {0, 0, 0, 0, 0, 0, 0, 0};
          a[x] = qi < len ? *(const bf16x8*)(p.P + (size_t)(row0 + qi) * NCOL + C_GQ + h * 128 + ks * 16 + (lane >> 5) * 8) : z;
          b[x] = *(const bf16x8*)(Sp + (size_t)(w * 64 + x * 32 + (lane & 31)) * 128 + ks * 16 + (lane >> 5) * 8);
        }
#pragma unroll
        for (int tm = 0; tm < 2; ++tm)
#pragma unroll
          for (int tn = 0; tn < 2; ++tn)
            acc[tm][tn] = __builtin_amdgcn_mfma_f32_32x32x16_bf16(a[tm], b[tn], acc[tm][tn], 0, 0, 0);
      }
    }
    __syncthreads();
#pragma unroll
    for (int tm = 0; tm < 2; ++tm)
#pragma unroll
      for (int tn = 0; tn < 2; ++tn)
#pragma unroll
        for (int r = 0; r < 16; ++r) {
          int i = tm * 32 + (r & 3) + 8 * (r >> 2) + 4 * (lane >> 5), e = w * 64 + tn * 32 + (lane & 31);
          OT[i * OS + e] = f2bf(acc[tm][tn][r]);
        }
    __syncthreads();
    {
      int i = tid >> 2, seg = tid & 3;
      float vals[64];
      float ss = 0.f;
#pragma unroll
      for (int c = 0; c < 8; ++c) {
        uint4 v = *(const uint4*)(OT + i * OS + seg * 64 + c * 8);
        u32 ww[4] = {v.x, v.y, v.z, v.w};
#pragma unroll
        for (int k = 0; k < 4; ++k) {
          float a = bf2f((u16)(ww[k] & 0xffff)), b = bf2f((u16)(ww[k] >> 16));
          vals[c * 8 + 2 * k] = a; vals[c * 8 + 2 * k + 1] = b; ss += a * a + b * b;
        }
      }
      ss += __shfl_xor(ss, 1); ss += __shfl_xor(ss, 2);
      float rstd = rsqrtf(ss * (1.f / 256) + NORM_EPS);
      if (i < len && !dry) {
        size_t o = (size_t)(row0 + i) * NCOL;
#pragma unroll
        for (int c = 0; c < 8; ++c) {
          int e = seg * 64 + c * 8;
          uint4 gr = *(const uint4*)(p.P + o + C_GR + h * 256 + e);
          u32 gw[4] = {gr.x, gr.y, gr.z, gr.w};
          u32 ow[4];
#pragma unroll
          for (int k = 0; k < 4; ++k) {
            float g0 = bf2f((u16)(gw[k] & 0xffff)), g1 = bf2f((u16)(gw[k] >> 16));
            float y0 = vals[c * 8 + 2 * k] * rstd * p.gla_norm_g[e + 2 * k] * siluf_(g0);
            float y1 = vals[c * 8 + 2 * k + 1] * rstd * p.gla_norm_g[e + 2 * k + 1] * siluf_(g1);
            ow[k] = pack2(y0, y1);
          }
          *(uint4*)(p.P + o + C_GV + h * 256 + e) = make_uint4(ow[0], ow[1], ow[2], ow[3]);
        }
      }
    }
    __syncthreads();
  }
}

struct DTile {
  int qrow0, qrow1;
  int nkeys0, nkeys1;
  const u16* ki; int ki_stride;
  const u16* kv; int kv_stride;
};

__device__ __forceinline__ u32 score_key(float s, int keyidx) {
  u32 u = __float_as_uint(s);
  u ^= (u32)(((int)u) >> 31) | 0x80000000u;
  return (u & 0xFFFF8000u) | (u32)(32767 - keyidx);
}

__device__ __forceinline__ void compact(u32* cand, int n, int hi, int& newcnt, u32& newthr) {
  int lane = TIDX & 63;
  u32 v[CVN];
#pragma unroll
  for (int e = 0; e < CVN; ++e) { int idx = lane + 64 * e; v[e] = idx < n ? cand[idx] : 0u; }
  u32 prefix = 0;
  for (int bit = 31; bit >= 0; --bit) {
    u32 trial = prefix | (1u << bit);
    int c = 0;
#pragma unroll
    for (int e = 0; e < CVN; ++e) c += __popcll(__ballot(v[e] >= trial));
    if (c >= 256) { prefix = trial; if (c <= hi) break; }
  }
  int base = 0;
  unsigned long long lt = (1ull << lane) - 1ull;
#pragma unroll
  for (int e = 0; e < CVN; ++e) {
    bool keep = v[e] >= prefix && prefix != 0;
    unsigned long long m = __ballot(keep);
    int pos = base + __popcll(m & lt);
    if (keep) cand[pos] = v[e];
    base += __popcll(m);
  }
  newcnt = base; newthr = prefix - 1u;
}

__device__ __forceinline__ void dsa_tile(const Params& p, const DTile& T, char* lds, bool dry) {
  u32* cand = (u32*)lds;
  u16* kst = (u16*)(lds + 32 * CAP * 4);
  const int tid = TIDX, lane = tid & 63, w = tid >> 6, half = lane >> 5;
  bf16x8 afr[2][4];
  bf16x8 aW[2][2];
#pragma unroll
  for (int rt = 0; rt < 2; ++rt) {
    bool act = (rt == 0 ? T.nkeys0 : T.nkeys1) > 0;
    int qr = (act && rt == 1) ? T.qrow1 : T.qrow0;
    int m = qr + 4 * w + ((lane & 31) >> 3);
    const u16* ap = p.P + (size_t)m * NCOL + C_IQ + (lane & 7) * 64 + half * 8;
#pragma unroll
    for (int ks = 0; ks < 4; ++ks) afr[rt][ks] = *(const bf16x8*)(ap + ks * 16);
    const int rho = lane & 31;
    const bool vrow = (rho & ~5) == 0;
    const int qi = 2 * (rho & 1) + ((rho >> 2) & 1);
    float4 w4 = *(const float4*)(p.PS + (size_t)(qr + 4 * w + qi) * 128 + 80 + 4 * half);
    u32 lo = pack2(w4.x * IDX_W_SCALE, w4.y * IDX_W_SCALE), hi = pack2(w4.z * IDX_W_SCALE, w4.w * IDX_W_SCALE);
#pragma unroll
    for (int sx = 0; sx < 2; ++sx) {
      bool on = vrow && (qi >> 1) == sx;
      u32x4 wd = {0u, 0u, 0u, 0u};
      if (on && (qi & 1) == 0) { wd[0] = lo; wd[1] = hi; }
      if (on && (qi & 1) == 1) { wd[2] = lo; wd[3] = hi; }
      aW[rt][sx] = __builtin_bit_cast(bf16x8, wd);
    }
  }
  u32 thr[2][2]; int cnt[2][2];
#pragma unroll
  for (int rt = 0; rt < 2; ++rt)
#pragma unroll
    for (int pp = 0; pp < 2; ++pp) { thr[rt][pp] = 0u; cnt[rt][pp] = 0; }
  const int NH = T.nkeys0, NL = T.nkeys1;
  const int nkt = (NH + 63) >> 6;
  const unsigned long long lt = (1ull << lane) - 1ull;
#define SCORE(ACC, RT, K0, KEY0, KEY1, M0, M1) do { \
    const int N_ = (RT) == 0 ? NH : NL; \
    M0 = 0ull; M1 = 0ull; KEY0 = 0u; KEY1 = 0u; \
    if ((K0) < N_) { \
      const int keyidx = (K0) + (lane & 31); \
      const bool valid = keyidx < N_; \
      u32x4 xa_ = {cvt_pk_bf16(relu1(ACC[0]), relu1(ACC[1])), cvt_pk_bf16(relu1(ACC[2]), relu1(ACC[3])), \
                   cvt_pk_bf16(relu1(ACC[4]), relu1(ACC[5])), cvt_pk_bf16(relu1(ACC[6]), relu1(ACC[7]))}; \
      u32x4 xb_ = {cvt_pk_bf16(relu1(ACC[8]), relu1(ACC[9])), cvt_pk_bf16(relu1(ACC[10]), relu1(ACC[11])), \
                   cvt_pk_bf16(relu1(ACC[12]), relu1(ACC[13])), cvt_pk_bf16(relu1(ACC[14]), relu1(ACC[15]))}; \
      f32x16 s2_; \
      _Pragma("unroll") for (int r_ = 0; r_ < 16; ++r_) s2_[r_] = 0.f; \
      s2_ = __builtin_amdgcn_mfma_f32_32x32x16_bf16(aW[RT][0], __builtin_bit_cast(bf16x8, xa_), s2_, 0, 0, 0); \
      s2_ = __builtin_amdgcn_mfma_f32_32x32x16_bf16(aW[RT][1], __builtin_bit_cast(bf16x8, xb_), s2_, 0, 0, 0); \
      KEY0 = score_key(s2_[0], keyidx); \
      KEY1 = score_key(s2_[1], keyidx); \
      M0 = __ballot(valid && KEY0 > thr[RT][0]); \
      M1 = __ballot(valid && KEY1 > thr[RT][1]); \
    } } while (0)
#define APPEND(RT, PP, KEY, M) do { \
    if (M) { \
      bool pass = (M >> lane) & 1ull; \
      pass = pass && (KEY > thr[RT][PP]); \
      unsigned long long m = __ballot(pass); \
      u32 mh = half ? (u32)(m >> 32) : (u32)m; \
      int slot = (RT) * 16 + 4 * w + 2 * (PP) + half; \
      int pos = cnt[RT][PP] + __popc(mh & (u32)(lt >> (half * 32))); \
      if (pass) cand[slot * CAP + pos] = KEY; \
      cnt[RT][PP] += __popc(mh); \
      unsigned long long over = __ballot(cnt[RT][PP] > CLIMIT); \
      if (over) { \
        _Pragma("unroll") \
        for (int hh = 0; hh < 2; ++hh) { \
          if ((u32)(over >> (hh * 32)) != 0u) { \
            int sl = (RT) * 16 + 4 * w + 2 * (PP) + hh; \
            int n = __shfl(cnt[RT][PP], hh * 32); \
            int nc; u32 nt; \
            compact(cand + sl * CAP, n, 320, nc, nt); \
            if (half == hh) { cnt[RT][PP] = nc; thr[RT][PP] = nt; } \
          } \
        } \
      } \
    } } while (0)
  bf16x8 nA[4], nB[4];
#define BLOAD(kt) do { \
    int ka_ = (kt) * 64 + (lane & 31), kb_ = ka_ + 32; \
    ka_ = ka_ < NH ? ka_ : NH - 1; kb_ = kb_ < NH ? kb_ : NH - 1; \
    const u16* pa_ = T.ki + (size_t)ka_ * T.ki_stride + half * 8; \
    const u16* pb_ = T.ki + (size_t)kb_ * T.ki_stride + half * 8; \
    _Pragma("unroll") for (int ks = 0; ks < 4; ++ks) { nA[ks] = *(const bf16x8*)(pa_ + ks * 16); nB[ks] = *(const bf16x8*)(pb_ + ks * 16); } } while (0)
  BLOAD(0);
#pragma unroll 1
  for (int kt = 0; kt < nkt; ++kt) {
    const int k0a = kt * 64, k0b = kt * 64 + 32;
    bf16x8 bA[4], bB[4];
#pragma unroll
    for (int ks = 0; ks < 4; ++ks) { bA[ks] = nA[ks]; bB[ks] = nB[ks]; }
    if (kt + 1 < nkt) BLOAD(kt + 1);
    __builtin_amdgcn_sched_barrier(0);
    f32x16 aH0, aL0, aH1, aL1;
#pragma unroll
    for (int r = 0; r < 16; ++r) { aH0[r] = 0.f; aL0[r] = 0.f; aH1[r] = 0.f; aL1[r] = 0.f; }
    const bool lact = k0a < NL;
#pragma unroll
    for (int ks = 0; ks < 4; ++ks) {
      aH0 = __builtin_amdgcn_mfma_f32_32x32x16_bf16(afr[0][ks], bA[ks], aH0, 0, 0, 0);
      aH1 = __builtin_amdgcn_mfma_f32_32x32x16_bf16(afr[0][ks], bB[ks], aH1, 0, 0, 0);
    }
    if (lact) {
#pragma unroll
      for (int ks = 0; ks < 4; ++ks) {
        aL0 = __builtin_amdgcn_mfma_f32_32x32x16_bf16(afr[1][ks], bA[ks], aL0, 0, 0, 0);
        aL1 = __builtin_amdgcn_mfma_f32_32x32x16_bf16(afr[1][ks], bB[ks], aL1, 0, 0, 0);
      }
    }
    u32 kH0a, kH0b, kH1a, kH1b, kL0a, kL0b, kL1a, kL1b;
    unsigned long long mH0a, mH0b, mH1a, mH1b, mL0a, mL0b, mL1a, mL1b;
    SCORE(aH0, 0, k0a, kH0a, kH0b, mH0a, mH0b);
    SCORE(aH1, 0, k0b, kH1a, kH1b, mH1a, mH1b);
    SCORE(aL0, 1, k0a, kL0a, kL0b, mL0a, mL0b);
    SCORE(aL1, 1, k0b, kL1a, kL1b, mL1a, mL1b);
    if (mH0a | mH0b | mH1a | mH1b | mL0a | mL0b | mL1a | mL1b) {
      APPEND(0, 0, kH0a, mH0a); APPEND(0, 1, kH0b, mH0b);
      APPEND(0, 0, kH1a, mH1a); APPEND(0, 1, kH1b, mH1b);
      APPEND(1, 0, kL0a, mL0a); APPEND(1, 1, kL0b, mL0b);
      APPEND(1, 0, kL1a, mL1a); APPEND(1, 1, kL1b, mL1b);
    }
  }
  int* nselp = (int*)(lds + 32 * CAP * 4);
#pragma unroll
  for (int rt = 0; rt < 2; ++rt)
#pragma unroll
    for (int pp = 0; pp < 2; ++pp)
#pragma unroll
      for (int hh = 0; hh < 2; ++hh) {
        int sl = rt * 16 + 4 * w + 2 * pp + hh;
        int n = __shfl(cnt[rt][pp], hh * 32);
        if (n > 256) { int nc; u32 nt; compact(cand + sl * CAP, n, 256, nc, nt); n = nc; }
        if (lane == 0) nselp[sl] = n;
      }
#pragma unroll 1
  for (int qq = 0; qq < 8; ++qq) {
    int rt = qq >> 2, qi = qq & 3;
    if ((rt == 0 ? T.nkeys0 : T.nkeys1) == 0) continue;
    int sl = rt * 16 + 4 * w + qi;
    int nsel = nselp[sl];
    const u32* cq = cand + sl * CAP;
    int m = (rt == 0 ? T.qrow0 : T.qrow1) + 4 * w + qi;
    u32 k0 = 4 * lane + 0 < nsel ? 32767u - (cq[4 * lane + 0] & 0x7fffu) : 0u;
    u32 k1 = 4 * lane + 1 < nsel ? 32767u - (cq[4 * lane + 1] & 0x7fffu) : 0u;
    u32 k2 = 4 * lane + 2 < nsel ? 32767u - (cq[4 * lane + 2] & 0x7fffu) : 0u;
    u32 k3 = 4 * lane + 3 < nsel ? 32767u - (cq[4 * lane + 3] & 0x7fffu) : 0u;
    if (!dry) *(uint2*)(p.SEL + (size_t)m * 256 + 4 * lane) = make_uint2(k0 | (k1 << 16), k2 | (k3 << 16));
  }
  __syncthreads();
}

__device__ __forceinline__ void att_unit(const Params& p, int m, int g, int nsel, const u16* __restrict__ kv, int kv_stride,
                                         const u16* sl, u16* vs, bool dry) {
  const int lane = TIDX & 63, g4 = lane >> 4, i16 = lane & 15;
  bf16x8 bq0, bq1;
  {
    bf16x8 z = {0, 0, 0, 0, 0, 0, 0, 0};
    const u16* qp = p.P + (size_t)m * NCOL + C_DQ + (g * 4 + (i16 & 3)) * 64 + g4 * 8;
    bq0 = i16 < 4 ? *(const bf16x8*)(qp) : z;
    bq1 = i16 < 4 ? *(const bf16x8*)(qp + 32) : z;
  }
  const int npad = (nsel + 31) & ~31;
  const int nchunk = (npad + 63) >> 6;
  const u16* kbase = kv + g * 64 + g4 * 8;
  const u16* vbase = kv + 256 + g * 64 + (lane & 7) * 8;
  bf16x8 kc[4][2], kn[4][2];
#pragma unroll
  for (int tt = 0; tt < 4; ++tt) {
    const u16* kp = kbase + (size_t)sl[tt * 16 + i16] * kv_stride;
    kc[tt][0] = *(const bf16x8*)kp; kc[tt][1] = *(const bf16x8*)(kp + 32);
    kn[tt][0] = kc[tt][0]; kn[tt][1] = kc[tt][1];
  }
  float mrun = -3.0e38f, lrun = 0.f;
  f32x4 oacc[4];
#pragma unroll
  for (int dt = 0; dt < 4; ++dt) oacc[dt] = f32x4{0.f, 0.f, 0.f, 0.f};
#pragma unroll 1
  for (int c = 0; c < nchunk; ++c) {
    u32x4 vr[2][4];
#pragma unroll
    for (int s2 = 0; s2 < 2; ++s2)
#pragma unroll
      for (int it = 0; it < 4; ++it)
        vr[s2][it] = *(const u32x4*)(vbase + (size_t)sl[c * 64 + s2 * 32 + it * 8 + (lane >> 3)] * kv_stride);
    if (c + 1 < nchunk) {
#pragma unroll
      for (int tt = 0; tt < 4; ++tt) {
        const u16* kp = kbase + (size_t)sl[(c + 1) * 64 + tt * 16 + i16] * kv_stride;
        kn[tt][0] = *(const bf16x8*)kp; kn[tt][1] = *(const bf16x8*)(kp + 32);
      }
    }
    __builtin_amdgcn_sched_barrier(0);
    f32x4 lg[4];
    float cmax = -3.0e38f;
#pragma unroll
    for (int tt = 0; tt < 4; ++tt) {
      f32x4 cc = {0.f, 0.f, 0.f, 0.f};
      cc = __builtin_amdgcn_mfma_f32_16x16x32_bf16(kc[tt][0], bq0, cc, 0, 0, 0);
      cc = __builtin_amdgcn_mfma_f32_16x16x32_bf16(kc[tt][1], bq1, cc, 0, 0, 0);
#pragma unroll
      for (int r = 0; r < 4; ++r) {
        int ks = (c * 4 + tt) * 16 + 4 * g4 + r;
        float v = ks < nsel ? cc[r] : -3.0e38f;
        lg[tt][r] = v; cmax = fmaxf(cmax, v);
      }
    }
    cmax = fmaxf(cmax, __shfl_xor(cmax, 16)); cmax = fmaxf(cmax, __shfl_xor(cmax, 32));
    float mnew = fmaxf(mrun, cmax);
    float alpha = __expf((mrun - mnew) * DSA_SCALE);
    mrun = mnew;
    bf16x8 pa[2];
    float psum = 0.f;
#pragma unroll
    for (int s2 = 0; s2 < 2; ++s2) {
#pragma unroll
      for (int r = 0; r < 4; ++r) {
        float e0 = __expf((lg[2 * s2][r] - mnew) * DSA_SCALE);
        float e1 = __expf((lg[2 * s2 + 1][r] - mnew) * DSA_SCALE);
        psum += e0 + e1;
        pa[s2][r] = (short)f2bf(e0); pa[s2][4 + r] = (short)f2bf(e1);
      }
    }
    lrun = lrun * alpha + psum;
    float al[4];
#pragma unroll
    for (int r = 0; r < 4; ++r) al[r] = __shfl(alpha, r);
#pragma unroll
    for (int dt = 0; dt < 4; ++dt)
#pragma unroll
      for (int r = 0; r < 4; ++r) oacc[dt][r] *= al[r];
#pragma unroll
    for (int s2 = 0; s2 < 2; ++s2) {
      __builtin_amdgcn_wave_barrier();
#pragma unroll
      for (int it = 0; it < 4; ++it)
        *(u32x4*)(vs + (it * 8 + (lane >> 3)) * 64 + (lane & 7) * 8) = vr[s2][it];
      __builtin_amdgcn_fence(__ATOMIC_RELEASE, "wavefront");
      __builtin_amdgcn_wave_barrier();
      __builtin_amdgcn_fence(__ATOMIC_ACQUIRE, "wavefront");
#pragma unroll
      for (int dt = 0; dt < 4; ++dt) {
        int q = i16 >> 2, pq = i16 & 3;
        const u16* a0 = vs + (4 * g4 + q) * 64 + dt * 16 + 4 * pq;
        const u16* a1 = vs + (16 + 4 * g4 + q) * 64 + dt * 16 + 4 * pq;
        s16x4 lo = __builtin_bit_cast(s16x4, __builtin_amdgcn_ds_read_tr16_b64_v4i16((lds_v4p)(a0)));
        s16x4 hi = __builtin_bit_cast(s16x4, __builtin_amdgcn_ds_read_tr16_b64_v4i16((lds_v4p)(a1)));
        bf16x8 bv = {lo[0], lo[1], lo[2], lo[3], hi[0], hi[1], hi[2], hi[3]};
        oacc[dt] = __builtin_amdgcn_mfma_f32_16x16x32_bf16(pa[s2], bv, oacc[dt], 0, 0, 0);
      }
    }
#pragma unroll
    for (int tt = 0; tt < 4; ++tt) { kc[tt][0] = kn[tt][0]; kc[tt][1] = kn[tt][1]; }
  }
  float sum = lrun;
  sum += __shfl_xor(sum, 16); sum += __shfl_xor(sum, 32);
  float inv[4];
#pragma unroll
  for (int r = 0; r < 4; ++r) inv[r] = 1.f / __shfl(sum, r);
  if (lane < 16 && !dry) {
    size_t o = (size_t)m * NCOL;
#pragma unroll
    for (int r = 0; r < 4; ++r)
#pragma unroll
      for (int dt = 0; dt < 4; ++dt) {
        int col = (g * 4 + r) * 64 + dt * 16 + lane;
        float z = bf2f(p.P[o + C_DZ + col]);
        p.P[o + C_DQ + col] = f2bf(oacc[dt][r] * inv[r] * siluf_(z));
      }
  }
}

__device__ __forceinline__ void phase_att(const Params& p, int pass, char* lds, bool dry, unsigned xcc) {
  const int tid = TIDX, lane = tid & 63, w = tid >> 6;
  u16* sl = (u16*)lds + w * 256;
  u16* vs = (u16*)(lds + 2048) + w * (32 * 64);
  int* item = (int*)(lds + 2048 + 4 * 4096);
  const int ngroups = 1024 + (pass == 1 ? 32 : 0);
  unsigned* ctr = p.bar + XCD_BAR_WORDS + (dry ? 16 : 0) + pass * 4;
  int gsel = (int)(xcc & 3u);
  int tries = 0;
  while (tries < 4) {
    __syncthreads();
    if (tid == 0) *item = (int)atomicAdd(&ctr[gsel], 1u);
    __syncthreads();
    int it = *item;
    if (it >= ngroups) { gsel = (gsel + 1) & 3; ++tries; continue; }
    int row0, nsel; const u16* kv; int kvs;
    if (it < 1024) {
      int c = it >> 2;
      row0 = 16 + 16 * it; int n = 80 + 64 * c; nsel = n < 256 ? n : 256;
      kv = p.KVP; kvs = 512;
    } else {
      int sb = it - 1024;
      row0 = SEQP + 16 * sb; nsel = 256;
      kv = p.KVS + (size_t)sb * NKEYS_S * 512; kvs = 512;
    }
#pragma unroll 1
    for (int qi = 0; qi < 4; ++qi) {
      int m = row0 + 4 * w + qi;
      __builtin_amdgcn_wave_barrier();
      *(uint2*)(sl + 4 * lane) = *(const uint2*)(p.SEL + (size_t)m * 256 + 4 * lane);
      __builtin_amdgcn_fence(__ATOMIC_RELEASE, "wavefront");
      __builtin_amdgcn_wave_barrier();
      __builtin_amdgcn_fence(__ATOMIC_ACQUIRE, "wavefront");
      att_unit(p, m, gsel, nsel, kv, kvs, sl, vs, dry);
    }
  }
}

__device__ __forceinline__ void phase_dsa(const Params& p, int pass, char* lds, bool dry) {
  int ntiles = 512 + (pass == 1 ? 32 : 0);
  for (int t = blockIdx.x; t < ntiles; t += gridDim.x) {
    DTile T;
    if (t < 512) {
      int c = t >> 2, qq = t & 3;
      int chh = 255 - c, cl = c;
      T.qrow0 = 16 + 64 * chh + 16 * qq; T.nkeys0 = 80 + 64 * chh;
      T.qrow1 = 16 + 64 * cl + 16 * qq;  T.nkeys1 = 80 + 64 * cl;
      T.ki = p.KI; T.ki_stride = 64;
      T.kv = p.P + C_DK; T.kv_stride = NCOL;
    } else {
      int sb = t - 512;
      T.qrow0 = SEQP + 16 * sb; T.nkeys0 = NKEYS_S;
      T.qrow1 = SEQP + 16 * sb; T.nkeys1 = 0;
      T.ki = p.KIS + (size_t)sb * NKEYS_S * 64; T.ki_stride = 64;
      T.kv = p.KVS + (size_t)sb * NKEYS_S * 512; T.kv_stride = 512;
    }
    dsa_tile(p, T, lds, dry);
  }
}

template <int BR>
__device__ __forceinline__ void merge_half(const Params& p, int R, int m0, int n0, char* ldsc, bool dry) {
  const int tid = TIDX, lane = tid & 63, w = tid >> 6, wm = w >> 1, wn = w & 1;
  u16* lds = (u16*)ldsc;
  f32x16 acc[2][2];
#pragma unroll
  for (int i = 0; i < 2; ++i)
#pragma unroll
    for (int j = 0; j < 2; ++j)
#pragma unroll
      for (int r = 0; r < 16; ++r) acc[i][j][r] = 0.f;
  gemm_core(p.P + (BR == 0 ? C_GV : C_DQ), NCOL, m0, R, BR == 0 ? p.WglaT : p.WdsaT, DM, n0, DM, acc, lds);
#pragma unroll
  for (int tm = 0; tm < 2; ++tm)
#pragma unroll
    for (int tn = 0; tn < 2; ++tn)
#pragma unroll
      for (int r = 0; r < 16; ++r)
        lds[ACC_ROW(wm, tm, r, lane) * ES + ACC_COL(wn, tn, lane)] = f2bf(acc[tm][tn][r]);
  __syncthreads();
  const int ch = tid & 15;
  float gb[8];
#pragma unroll
  for (int k = 0; k < 8; ++k) gb[k] = p.gate_b[(BR == 0 ? 0 : DM) + n0 + ch * 8 + k];
#pragma unroll
  for (int i = 0; i < 8; ++i) {
    int row = (tid >> 4) + 16 * i;
    if (m0 + row < R && !dry) {
      size_t o = (size_t)(m0 + row) * NCOL + n0 + ch * 8;
      uint4 yv = *(const uint4*)(lds + row * ES + ch * 8);
      uint4 mv = *(const uint4*)(p.P + o + (BR == 0 ? C_MA : C_MB));
      uint4 pv = make_uint4(0, 0, 0, 0);
      if (BR == 1) pv = *(const uint4*)(p.P + o + C_MA);
      u32 yw[4] = {yv.x, yv.y, yv.z, yv.w}, mw[4] = {mv.x, mv.y, mv.z, mv.w}, pw[4] = {pv.x, pv.y, pv.z, pv.w}, ow[4];
#pragma unroll
      for (int k = 0; k < 4; ++k) {
        float y0 = bf2f((u16)(yw[k] & 0xffff)), y1 = bf2f((u16)(yw[k] >> 16));
        float g0 = sigmoidf_(bf2f((u16)(mw[k] & 0xffff)) + gb[2 * k]), g1 = sigmoidf_(bf2f((u16)(mw[k] >> 16)) + gb[2 * k + 1]);
        float r0 = g0 * y0, r1 = g1 * y1;
        if (BR == 1) { r0 += bf2f((u16)(pw[k] & 0xffff)); r1 += bf2f((u16)(pw[k] >> 16)); }
        ow[k] = pack2(r0, r1);
      }
      *(uint4*)(p.P + o + C_MA) = make_uint4(ow[0], ow[1], ow[2], ow[3]);
    }
  }
  __syncthreads();
}
__device__ __forceinline__ void phase_merge(const Params& p, int pass, char* lds, bool dry) {
  int R = pass_rows(pass);
  int mt = (R + 127) >> 7;
  unsigned* ctr = p.bar + XCD_BAR_WORDS + 72 + (dry ? 8 : 0) + pass;
  for (int t = dq_next(ctr, lds); t < mt * 8; t = dq_next(ctr, lds)) {
    int tn_ = t & 7, tm_ = t >> 3;
    int m0 = tm_ * 128, n0 = tn_ * 128;
    merge_half<0>(p, R, m0, n0, lds, dry);
    merge_half<1>(p, R, m0, n0, lds, dry);
  }
}

__device__ __forceinline__ void phase_out(const Params& p, int pass, char* lds) {
  int R = pass_rows(pass), r0 = pass_row0(pass);
  int mt = (R + 127) >> 7;
  int lane = TIDX & 63, w = TIDX >> 6, wm = w >> 1, wn = w & 1;
  unsigned* ctr = p.bar + XCD_BAR_WORDS + 88 + pass;
  for (int t = dq_next(ctr, lds); t < mt * 8; t = dq_next(ctr, lds)) {
    int tn_ = t & 7, tm_ = t >> 3;
    int m0 = tm_ * 128, n0 = tn_ * 128;
    f32x16 acc[2][2];
#pragma unroll
    for (int i = 0; i < 2; ++i)
#pragma unroll
      for (int j = 0; j < 2; ++j)
#pragma unroll
        for (int r = 0; r < 16; ++r) acc[i][j][r] = 0.f;
    gemm_core(p.P + C_MA, NCOL, m0, R, p.WoutT, DM, n0, DM, acc, (u16*)lds);
#pragma unroll
    for (int tm = 0; tm < 2; ++tm)
#pragma unroll
      for (int r = 0; r < 16; ++r) {
        int m = m0 + ACC_ROW(wm, tm, r, lane);
        if (m < R) {
          int gr = r0 + m;
          float* y = yrow_ptr(p, gr);
          if (y) {
            const float* x = xrow_ptr(p, gr);
            float mu = p.STATS[gr * 2], rstd = p.STATS[gr * 2 + 1];
#pragma unroll
            for (int tn = 0; tn < 2; ++tn) {
              int n = n0 + ACC_COL(wn, tn, lane);
              float hh = (x[n] - mu) * rstd * p.ln_in_g[n] + p.ln_in_b[n];
              y[n] = ALPHA_F * hh + acc[tm][tn][r];
            }
          }
        }
      }
  }
}

__device__ __forceinline__ void phase_ln_out(const Params& p, int pass, bool dry) {
  int R = pass_rows(pass), r0 = pass_row0(pass);
  int wave = TIDX >> 6, lane = TIDX & 63;
  for (int m = blockIdx.x * 4 + wave; m < R; m += gridDim.x * 4) {
    float* y = yrow_ptr(p, r0 + m);
    if (!y) continue;
    float4 v[4];
    float s = 0.f;
#pragma unroll
    for (int i = 0; i < 4; ++i) { v[i] = *(const float4*)(y + i * 256 + lane * 4); s += v[i].x + v[i].y + v[i].z + v[i].w; }
    float mu = wave_sum(s) * (1.f / DM);
    float q = 0.f;
#pragma unroll
    for (int i = 0; i < 4; ++i) {
      float a = v[i].x - mu, b = v[i].y - mu, c = v[i].z - mu, d = v[i].w - mu;
      q += a * a + b * b + c * c + d * d;
    }
    float rstd = rsqrtf(wave_sum(q) * (1.f / DM) + NORM_EPS);
#pragma unroll
    for (int i = 0; i < 4; ++i) {
      int c = i * 256 + lane * 4;
      float4 g = *(const float4*)(p.ln_g + c), b = *(const float4*)(p.ln_b + c);
      float4 o;
      o.x = (v[i].x - mu) * rstd * g.x + b.x; o.y = (v[i].y - mu) * rstd * g.y + b.y;
      o.z = (v[i].z - mu) * rstd * g.z + b.z; o.w = (v[i].w - mu) * rstd * g.w + b.w;
      if (!dry) *(float4*)(y + c) = o;
    }
  }
}

#define LDS_BYTES 77824
#define NPHASE 9
#ifndef PHASE_MASK
#define PHASE_MASK 0x7ff
#endif
#define EN(x) (((PHASE_MASK) >> (x)) & 1)
__device__ __forceinline__ void run_phase(const Params& p, int pass, int ph, char* lds, bool dry = false, unsigned xcc = 0) {
  switch (ph) {
    case 0: if (EN(0)) { if (pass == 0) phase_prep(p, lds); phase_ln_in(p, pass); } break;
    case 1: if (EN(1)) phase_gemm1(p, pass, lds, xcc); break;
    case 2: if (EN(2)) phase_tok(p, pass, lds, dry); break;
    case 3: if (EN(3)) phase_u(p, pass, lds); break;
    case 4: if (EN(4)) phase_scan(p, pass, dry); break;
    case 5: if (EN(5)) phase_dsa(p, pass, lds, dry); break;
    case 9: if (EN(9)) phase_o(p, pass, lds, dry); break;
    case 10: if (EN(10)) phase_att(p, pass, lds, dry, xcc); break;
    case 6: if (EN(6)) phase_merge(p, pass, lds, dry); break;
    case 7: if (EN(7)) phase_out(p, pass, lds); break;
    case 8: if (EN(8)) phase_ln_out(p, pass, dry); break;
  }
}

#if ONE_LAUNCH
#ifndef PROBE_BAR2
#define PROBE_BAR2 0
#endif
#define XBAR do { xcd_barrier(xb); if (PROBE_BAR2) xcd_barrier(xb); } while (0)
#ifndef PROBE_REP
#define PROBE_REP 0
#endif
#define RUNP(ph) do { if ((PROBE_REP >> (ph)) & 1) run_phase(p, pass, ph, lds, true, xb.x); run_phase(p, pass, ph, lds, false, xb.x); } while (0)
__global__ void __launch_bounds__(256, 2) fwd_kernel(Params p) {
  __shared__ __attribute__((aligned(16))) char lds[LDS_BYTES];
  __shared__ uint4 xb_words;
  cg::grid_group grid = cg::this_grid();
  if (threadIdx.x == 0) xb_words = make_uint4(0u, 0u, 0u, 0u);
  __syncthreads();
  XcdBarrier xb = xcd_barrier_post(p.bar, (volatile LAS unsigned*)&xb_words);
#pragma unroll 1
  for (int pass = 0; pass < 2; ++pass) {
    RUNP(0);
    if (pass == 0) grid.sync(); else XBAR;
    RUNP(1); XBAR;
    RUNP(2); XBAR;
    RUNP(3); XBAR;
    RUNP(4); XBAR;
    RUNP(5);
    RUNP(9); XBAR;
    RUNP(10); XBAR;
    RUNP(6); XBAR;
    RUNP(7); XBAR;
    RUNP(8);
  }
}
#else
template <int PH>
__global__ void __launch_bounds__(256, 2) phase_kernel(Params p, int pass) {
  __shared__ __attribute__((aligned(16))) char lds[LDS_BYTES];
  run_phase(p, pass, PH, lds, false, xb_xcc_id());
}
#endif

static inline size_t align_up(size_t x) { return (x + 255) & ~(size_t)255; }

extern "C" void kernel_launch(void* const* d_in, const int* in_sizes, int n_in, void* d_out, int out_size,
                              void* d_ws, size_t ws_size, hipStream_t stream) {
  Params p{};
  const float* const* in = (const float* const*)d_in;
  p.x_prompt = in[0]; p.x_sample = in[1]; p.cache_k = in[2]; p.cache_v = in[3]; p.cache_idx_k = in[4];
  p.state_gla = in[5]; p.meta = in[6]; p.ln_in_g = in[7]; p.ln_in_b = in[8]; p.w_in = in[9]; p.gla_w2 = in[10];
  p.gla_gate_b = in[11]; p.gla_norm_g = in[12]; p.idx_kn_g = in[13]; p.idx_kn_b = in[14]; p.w_gla = in[15];
  p.w_dsa = in[16]; p.gate_b = in[17]; p.w_out = in[18]; p.ln_g = in[19]; p.ln_b = in[20];
  float* o = (float*)d_out;
  p.y_prompt = o; o += (size_t)2 * 16384 * 1024;
  p.y_sample = o; o += (size_t)32 * 16 * 1024;
  p.k_prompt = o; o += (size_t)2 * SEQP * 256;
  p.v_prompt = o; o += (size_t)2 * SEQP * 256;
  p.idx_k_prompt = o; o += (size_t)2 * SEQP * 64;
  p.gla_prompt = o; o += (size_t)2 * 131072;
  p.k_sample = o; o += (size_t)512 * 256;
  p.v_sample = o; o += (size_t)512 * 256;
  p.idx_k_sample = o; o += (size_t)512 * 64;
  p.gla_sample = o; o += (size_t)32 * 131072;
  char* wsp = (char*)d_ws;
  size_t off = 0;
  auto take = [&](size_t bytes) { char* r = wsp + off; off = align_up(off + bytes); return r; };
  p.WinT = (u16*)take((size_t)NCOL * DM * 2);
  p.WglaT = (u16*)take((size_t)DM * DM * 2);
  p.WdsaT = (u16*)take((size_t)DM * DM * 2);
  p.WoutT = (u16*)take((size_t)DM * DM * 2);
  p.H = (u16*)take((size_t)RPMAX * DM * 2);
  p.P = (u16*)take((size_t)(RPMAX + 8) * NCOL * 2);
  p.KI = (u16*)take((size_t)RPMAX * 64 * 2);
  p.US = (u16*)take((size_t)289 * 131072 * 2);
  p.KVS = (u16*)take((size_t)32 * NKEYS_S * 512 * 2);
  p.KIS = (u16*)take((size_t)32 * NKEYS_S * 64 * 2);
  p.SEL = (u16*)take((size_t)RPMAX * 256 * 2);
  p.KVP = (u16*)take((size_t)SEQP * 512 * 2);
  p.STATS = (float*)take((size_t)NROWS * 2 * 4);
  p.PS = (float*)take((size_t)RPMAX * 128 * 4);
  p.DEC = (float*)take((size_t)289 * 512 * 4);
  p.bar = (unsigned*)take((size_t)(XCD_BAR_WORDS + 128) * 4);
  if (off > ws_size) { fprintf(stderr, "workspace too small: need %zu have %zu\n", off, ws_size); return; }
#if ONE_LAUNCH
  static int grid_blocks = 0;
  if (!grid_blocks) {
    int dev = 0, cus = 0, per_cu = 0;
    hipGetDevice(&dev);
    hipDeviceGetAttribute(&cus, hipDeviceAttributeMultiprocessorCount, dev);
    hipOccupancyMaxActiveBlocksPerMultiprocessor(&per_cu, fwd_kernel, 256, 0);
    per_cu = 2;
    grid_blocks = cus * per_cu;
  }
  (void)hipMemsetAsync(p.bar, 0, (size_t)(XCD_BAR_WORDS + 128) * 4, stream);
  void* args[] = {&p};
  hipError_t e = hipLaunchCooperativeKernel((void*)fwd_kernel, dim3(grid_blocks), dim3(256), args, 0, stream);
  if (e != hipSuccess) fprintf(stderr, "cooperative launch failed: %s (grid %d)\n", hipGetErrorString(e), grid_blocks);
#else
  (void)hipMemsetAsync(p.bar, 0, (size_t)(XCD_BAR_WORDS + 128) * 4, stream);
  for (int pass = 0; pass < 2; ++pass) {
    phase_kernel<0><<<512, 256, 0, stream>>>(p, pass);
    phase_kernel<1><<<512, 256, 0, stream>>>(p, pass);
    phase_kernel<2><<<512, 256, 0, stream>>>(p, pass);
    phase_kernel<3><<<512, 256, 0, stream>>>(p, pass);
    phase_kernel<4><<<512, 256, 0, stream>>>(p, pass);
    phase_kernel<5><<<512, 256, 0, stream>>>(p, pass);
    phase_kernel<10><<<512, 256, 0, stream>>>(p, pass);
    phase_kernel<9><<<512, 256, 0, stream>>>(p, pass);
    phase_kernel<6><<<512, 256, 0, stream>>>(p, pass);
    phase_kernel<7><<<512, 256, 0, stream>>>(p, pass);
    phase_kernel<8><<<512, 256, 0, stream>>>(p, pass);
  }
#endif
}
```

```cpp
#include <hip/hip_runtime.h>
#include <hip/hip_bf16.h>
#include <hip/hip_cooperative_groups.h>
#include <stdint.h>
#include <stdio.h>
namespace cg = cooperative_groups;

typedef unsigned short u16;
typedef unsigned char u8;
typedef uint32_t u32;
typedef __attribute__((ext_vector_type(8))) short bf16x8;
typedef __attribute__((ext_vector_type(4))) short s16x4;
typedef __attribute__((ext_vector_type(4))) float f32x4;
typedef __attribute__((ext_vector_type(16))) float f32x16;
typedef short v4i16_t __attribute__((ext_vector_type(4)));
typedef __attribute__((ext_vector_type(4))) unsigned int u32x4;
typedef __attribute__((address_space(3))) v4i16_t* lds_v4p;

#ifndef ONE_LAUNCH
#define ONE_LAUNCH 1
#endif

#define DM 1024
#define SEQP 16400
#define NPROMPT_ROWS 32800
#define NROWS 33312
#define RPMAX 16912
#define NCOL 8320
#define C_GQ 0
#define C_GK 512
#define C_GV 1024
#define C_GR 2048
#define C_DQ 3072
#define C_DK 4096
#define C_DV 4352
#define C_IQ 4608
#define C_DZ 5120
#define C_MA 6144
#define C_MB 7168
#define C_SM 8192
#define NKEYS_S 2064
#define CAP 576
#define CLIMIT 544
#define CVN 9
#define NORM_EPS 1e-5f
#define ALPHA_F 1.189207115002721f
#define IDX_W_SCALE 0.04419417382415922f
#define GLA_QSCALE 0.08838834764831845f
#define DSA_SCALE 0.125f

struct Params {
  const float *x_prompt, *x_sample, *cache_k, *cache_v, *cache_idx_k, *state_gla, *meta, *ln_in_g, *ln_in_b,
      *w_in, *gla_w2, *gla_gate_b, *gla_norm_g, *idx_kn_g, *idx_kn_b, *w_gla, *w_dsa, *gate_b, *w_out, *ln_g, *ln_b;
  float *y_prompt, *y_sample, *k_prompt, *v_prompt, *idx_k_prompt, *gla_prompt, *k_sample, *v_sample, *idx_k_sample, *gla_sample;
  u16 *WinT, *WglaT, *WdsaT, *WoutT, *H, *P, *KI, *US, *KIS, *SEL;
  u8 *KV8S, *KV8P;
  float *STATS, *PS, *DEC;
  unsigned* bar;
};

#define XB_TMO      128
#define XB_XCNT(j)  (256  + 64 * (j))
#define XB_XSUB(j)  (1280 + 64 * (j))
#define XB_XGEN(j)  (2304 + 64 * (j))
#define XB_TOP      3328
#define XB_TOPGEN   3392
#define XCD_BAR_WORDS 3456
#define XB_SPIN_CAP (1u << 22)
#define LAS __attribute__((address_space(3)))
__device__ __forceinline__ unsigned xb_ld(unsigned* p)              { return __hip_atomic_load(p, __ATOMIC_RELAXED, __HIP_MEMORY_SCOPE_AGENT); }
__device__ __forceinline__ unsigned xb_add(unsigned* p, unsigned v) { return __hip_atomic_fetch_add(p, v, __ATOMIC_RELAXED, __HIP_MEMORY_SCOPE_AGENT); }
__device__ __forceinline__ unsigned xb_xcc_id() { return (unsigned)__builtin_amdgcn_s_getreg((3 << 11) | 20) & 0xFu; }
#define XB_SPIN(cond, bar) do { unsigned _sp = 0; while (cond) { __builtin_amdgcn_s_sleep(1); \
    if ((++_sp & 255u) == 0u) { if (xb_ld(&(bar)[XB_TMO])) break; if (_sp > XB_SPIN_CAP) { atomicAdd(&(bar)[XB_TMO], 1u); break; } } } } while (0)
struct XcdBarrier { unsigned* bar; unsigned x; volatile LAS unsigned* st; };
__device__ __forceinline__ XcdBarrier xcd_barrier_post(unsigned* bar, volatile LAS unsigned* st) {
    XcdBarrier b; b.bar = bar; b.x = xb_xcc_id(); b.st = st;
    if (threadIdx.x == 0) (void)xb_add(&bar[XB_XCNT(b.x)], 1u);
    return b;
}
__device__ __forceinline__ void xcd_barrier_complete(unsigned* bar, unsigned x, unsigned& nloc, unsigned& nx) {
    const unsigned G = gridDim.x * gridDim.y * gridDim.z;
    unsigned sum, cnt, mine, sp = 0u;
    for (;;) {
        sum = 0u; cnt = 0u; mine = 0u;
#pragma unroll
        for (unsigned j = 0; j < 16; ++j) { const unsigned c = xb_ld(&bar[XB_XCNT(j)]); sum += c; cnt += (c > 0u) ? 1u : 0u; mine = (j == x) ? c : mine; }
        if (sum == G) break;
        __builtin_amdgcn_s_sleep(1);
        if ((++sp & 255u) == 0u) { if (xb_ld(&bar[XB_TMO])) break; if (sp > XB_SPIN_CAP) { atomicAdd(&bar[XB_TMO], 1u); break; } }
    }
    nloc = mine > 0u ? mine : 1u; nx = cnt > 0u ? cnt : 1u;
}
__device__ __forceinline__ void xcd_barrier(const XcdBarrier& b) {
    asm volatile("s_waitcnt vmcnt(0)" ::: "memory");
    __syncthreads();
    if (threadIdx.x == 0) {
        unsigned* bar = b.bar;
        __builtin_amdgcn_s_waitcnt(0);
        unsigned nloc = b.st[0], nx = b.st[1];
        if (nloc == 0u) { xcd_barrier_complete(bar, b.x, nloc, nx); b.st[0] = nloc; b.st[1] = nx; }
        const unsigned old = xb_add(&bar[XB_XSUB(b.x)], 1u);
        const unsigned gen = old / nloc;
        if (old + 1u == (gen + 1u) * nloc) {
            __builtin_amdgcn_fence(__ATOMIC_RELEASE, "agent");
            asm volatile("s_waitcnt vmcnt(0)" ::: "memory");
            const unsigned og = xb_add(&bar[XB_TOP], 1u);
            const unsigned tg = og / nx;
            if (og + 1u == (tg + 1u) * nx) xb_add(&bar[XB_TOPGEN], 1u);
            else XB_SPIN(xb_ld(&bar[XB_TOPGEN]) == tg, bar);
            __builtin_amdgcn_fence(__ATOMIC_ACQUIRE, "agent");
            xb_add(&bar[XB_XGEN(b.x)], 1u);
            asm volatile("s_waitcnt vmcnt(0)" ::: "memory");
        } else {
            XB_SPIN(xb_ld(&bar[XB_XGEN(b.x)]) == gen, bar);
            __builtin_amdgcn_fence(__ATOMIC_ACQUIRE, "agent");
            asm volatile("s_waitcnt vmcnt(0)" ::: "memory");
        }
    }
    __syncthreads();
}

__device__ __forceinline__ int tid_opaque() { int t = threadIdx.x; asm volatile("" : "+v"(t)); return t; }
#define TIDX tid_opaque()
__device__ __forceinline__ u16 f2bf(float f) {
  u32 u = __float_as_uint(f);
  u += 0x7fffu + ((u >> 16) & 1u);
  return (u16)(u >> 16);
}
__device__ __forceinline__ float bf2f(u16 h) { return __uint_as_float(((u32)h) << 16); }
__device__ __forceinline__ u32 pack2(float a, float b) { return (u32)f2bf(a) | ((u32)f2bf(b) << 16); }
__device__ __forceinline__ float relu1(float x) { float r; asm("v_max_f32 %0, 0, %1" : "=v"(r) : "v"(x)); return r; }
__device__ __forceinline__ u32 cvt_pk_bf16(float lo, float hi) { u32 r; asm("v_cvt_pk_bf16_f32 %0, %1, %2" : "=v"(r) : "v"(lo), "v"(hi)); return r; }
__device__ __forceinline__ u32 pk4_fp8(float a, float b, float c, float d) {
  int r = __builtin_amdgcn_cvt_pk_fp8_f32(a, b, 0, false);
  r = __builtin_amdgcn_cvt_pk_fp8_f32(c, d, r, true);
  return (u32)r;
}
__device__ __forceinline__ void fp8x4_to_bf16(u32 x, u32& lo, u32& hi) {
  auto a = __builtin_amdgcn_cvt_pk_f32_fp8((int)x, false);
  auto b = __builtin_amdgcn_cvt_pk_f32_fp8((int)x, true);
  lo = cvt_pk_bf16(a[0], a[1]); hi = cvt_pk_bf16(b[0], b[1]);
}
__device__ __forceinline__ float sigmoidf_(float x) { return 1.f / (1.f + __expf(-x)); }
__device__ __forceinline__ float siluf_(float x) { return x / (1.f + __expf(-x)); }

__device__ __forceinline__ float wave_sum(float v) {
#pragma unroll
  for (int o = 32; o > 0; o >>= 1) v += __shfl_xor(v, o);
  return v;
}

__device__ __forceinline__ const float* xrow_ptr(const Params& p, int gr) {
  if (gr < NPROMPT_ROWS) {
    int b = gr / SEQP, pos = gr - b * SEQP;
    return pos < 16 ? p.meta + pos * DM : p.x_prompt + ((size_t)b * 16384 + (pos - 16)) * DM;
  }
  return p.x_sample + (size_t)(gr - NPROMPT_ROWS) * DM;
}
__device__ __forceinline__ float* yrow_ptr(const Params& p, int gr) {
  if (gr < NPROMPT_ROWS) {
    int b = gr / SEQP, pos = gr - b * SEQP;
    return pos < 16 ? nullptr : p.y_prompt + ((size_t)b * 16384 + (pos - 16)) * DM;
  }
  return p.y_sample + (size_t)(gr - NPROMPT_ROWS) * DM;
}

__device__ __forceinline__ int src_col(int n) {
  if (n < 2048) return n;
  if (n < 3072) return n - 2048 + 2064;
  if (n < 4096) return n - 3072 + 3088;
  if (n < 4352) return n - 4096 + 4112;
  if (n < 4608) return n - 4352 + 4368;
  if (n < 5120) return n - 4608 + 4624;
  if (n < 6144) return n - 5120 + 5208;
  if (n < 7168) return n - 6144 + 6232;
  if (n < 8192) return n - 7168 + 7256;
  if (n < 8256) return n - 8192 + 5136;
  if (n < 8272) return n - 8256 + 2048;
  if (n < 8280) return n - 8272 + 5200;
  return -1;
}

__device__ __forceinline__ int pass_row0(int pass) { return pass == 0 ? 0 : SEQP; }
__device__ __forceinline__ int pass_rows(int pass) { return pass == 0 ? SEQP : RPMAX; }
__device__ __forceinline__ int pass_nblk(int pass) { return pass == 0 ? 257 : 289; }
__device__ __forceinline__ void blk_info(int blk, int& row0, int& len) {
  if (blk < 257) { row0 = blk * 64; len = (blk == 256) ? 16 : 64; }
  else { row0 = SEQP + 16 * (blk - 257); len = 16; }
}

__device__ __forceinline__ int dq_next(unsigned* ctr, char* lds) {
  int* item = (int*)(lds + 77808);
  __syncthreads();
  if (TIDX == 0) *item = (int)atomicAdd(ctr, 1u);
  __syncthreads();
  return *item;
}

__device__ __forceinline__ void transpose_tile(const float* __restrict__ src, int nsrc, u16* __restrict__ dst, int k0, int n0, bool map, float* tile) {
  int tx = TIDX & 63, ty = TIDX >> 6;
  int sc = map ? src_col(n0 + tx) : (n0 + tx);
  for (int kk = ty; kk < 64; kk += 4) tile[kk * 65 + tx] = sc >= 0 ? src[(size_t)(k0 + kk) * nsrc + sc] : 0.f;
  __syncthreads();
  for (int nn = ty; nn < 64; nn += 4) dst[(size_t)(n0 + nn) * DM + k0 + tx] = f2bf(tile[tx * 65 + nn]);
  __syncthreads();
}

__device__ __forceinline__ void phase_prep(const Params& p, char* lds) {
  float* tile = (float*)lds;
  const int nt_in = 130 * 16;
  const int nt_all = nt_in + 3 * 256;
  for (int t = blockIdx.x; t < nt_all; t += gridDim.x) {
    if (t < nt_in) {
      transpose_tile(p.w_in, 8280, p.WinT, (t & 15) * 64, (t >> 4) * 64, true, tile);
    } else {
      int u = t - nt_in, w = u >> 8, r = u & 255;
      const float* s = w == 0 ? p.w_gla : (w == 1 ? p.w_dsa : p.w_out);
      u16* d = w == 0 ? p.WglaT : (w == 1 ? p.WdsaT : p.WoutT);
      transpose_tile(s, DM, d, (r & 15) * 64, (r >> 4) * 64, false, tile);
    }
  }
  const size_t nk4 = (size_t)32 * 2048 * 256 / 4;
  size_t stride = (size_t)gridDim.x * blockDim.x;
  for (size_t i = (size_t)blockIdx.x * blockDim.x + TIDX; i < nk4; i += stride) {
    size_t e = i * 4; size_t row = e >> 8; int c = (int)(e & 255);
    size_t sb = row >> 11, j = row & 2047;
    float4 kv = *(const float4*)(p.cache_k + e);
    float4 vv = *(const float4*)(p.cache_v + e);
    u8* o = p.KV8S + (sb * NKEYS_S + j) * 512 + (c >> 6) * 128 + (c & 63);
    *(u32*)o = pk4_fp8(kv.x, kv.y, kv.z, kv.w);
    *(u32*)(o + 64) = pk4_fp8(vv.x, vv.y, vv.z, vv.w);
  }
  const size_t ni4 = (size_t)32 * 2048 * 64 / 4;
  for (size_t i = (size_t)blockIdx.x * blockDim.x + TIDX; i < ni4; i += stride) {
    size_t e = i * 4; size_t row = e >> 6; int c = (int)(e & 63);
    size_t sb = row >> 11, j = row & 2047;
    float4 kv = *(const float4*)(p.cache_idx_k + e);
    *(uint2*)(p.KIS + (sb * NKEYS_S + j) * 64 + c) = make_uint2(pack2(kv.x, kv.y), pack2(kv.z, kv.w));
  }
}

__device__ __forceinline__ void phase_ln_in(const Params& p, int pass) {
  int R = pass_rows(pass), r0 = pass_row0(pass);
  int wave = TIDX >> 6, lane = TIDX & 63;
  for (int m = blockIdx.x * 4 + wave; m < R; m += gridDim.x * 4) {
    int gr = r0 + m;
    const float* x = xrow_ptr(p, gr);
    float4 v[4];
    float s = 0.f;
#pragma unroll
    for (int i = 0; i < 4; ++i) { v[i] = *(const float4*)(x + i * 256 + lane * 4); s += v[i].x + v[i].y + v[i].z + v[i].w; }
    float mu = wave_sum(s) * (1.f / DM);
    float q = 0.f;
#pragma unroll
    for (int i = 0; i < 4; ++i) {
      float a = v[i].x - mu, b = v[i].y - mu, c = v[i].z - mu, d = v[i].w - mu;
      q += a * a + b * b + c * c + d * d;
    }
    float rstd = rsqrtf(wave_sum(q) * (1.f / DM) + NORM_EPS);
#pragma unroll
    for (int i = 0; i < 4; ++i) {
      int c = i * 256 + lane * 4;
      float4 g = *(const float4*)(p.ln_in_g + c), b = *(const float4*)(p.ln_in_b + c);
      float h0 = (v[i].x - mu) * rstd * g.x + b.x, h1 = (v[i].y - mu) * rstd * g.y + b.y;
      float h2 = (v[i].z - mu) * rstd * g.z + b.z, h3 = (v[i].w - mu) * rstd * g.w + b.w;
      *(uint2*)(p.H + (size_t)m * DM + c) = make_uint2(pack2(h0, h1), pack2(h2, h3));
    }
    if (lane == 0) { p.STATS[gr * 2] = mu; p.STATS[gr * 2 + 1] = rstd; }
  }
}

#define GS 72
template <bool SWAP = false>
__device__ __forceinline__ void gemm_core(const u16* __restrict__ A, int lda, int m0, int mvalid,
                                          const u16* __restrict__ B, int ldb, int n0, int K,
                                          f32x16 (&acc)[2][2], u16* lds) {
  const int tid = TIDX, lane = tid & 63, w = tid >> 6, wm = w >> 1, wn = w & 1;
  u16* As = lds;
  u16* Bs = lds + 2 * 128 * GS;
  uint4 ra0, ra1, ra2, ra3, rb0, rb1, rb2, rb3;
  const int nk = K >> 6;
  const int lrow = tid >> 3, lch = tid & 7;
  const u16* ap[4]; const u16* bp[4];
#pragma unroll
  for (int i = 0; i < 4; ++i) {
    int ar = m0 + lrow + 32 * i; ar = ar < mvalid ? ar : mvalid - 1;
    ap[i] = A + (size_t)ar * lda + lch * 8;
    bp[i] = B + (size_t)(n0 + lrow + 32 * i) * ldb + lch * 8;
  }
#define GLOAD(kt) do { \
    ra0 = *(const uint4*)(ap[0] + (kt) * 64); ra1 = *(const uint4*)(ap[1] + (kt) * 64); \
    ra2 = *(const uint4*)(ap[2] + (kt) * 64); ra3 = *(const uint4*)(ap[3] + (kt) * 64); \
    rb0 = *(const uint4*)(bp[0] + (kt) * 64); rb1 = *(const uint4*)(bp[1] + (kt) * 64); \
    rb2 = *(const uint4*)(bp[2] + (kt) * 64); rb3 = *(const uint4*)(bp[3] + (kt) * 64); } while (0)
#define GSWRITE(buf) do { \
    u16* as_ = As + ((buf) * 128 + lrow) * GS + lch * 8; u16* bs_ = Bs + ((buf) * 128 + lrow) * GS + lch * 8; \
    *(uint4*)(as_) = ra0; *(uint4*)(as_ + 32 * GS) = ra1; *(uint4*)(as_ + 64 * GS) = ra2; *(uint4*)(as_ + 96 * GS) = ra3; \
    *(uint4*)(bs_) = rb0; *(uint4*)(bs_ + 32 * GS) = rb1; *(uint4*)(bs_ + 64 * GS) = rb2; *(uint4*)(bs_ + 96 * GS) = rb3; } while (0)
  GLOAD(0);
  GSWRITE(0);
  __syncthreads();
  for (int kt = 0; kt < nk; ++kt) {
    int buf = kt & 1;
    if (kt + 1 < nk) GLOAD(kt + 1);
    __builtin_amdgcn_sched_barrier(0);
    bf16x8 af[4][2], bf[4][2];
#pragma unroll
    for (int ks = 0; ks < 4; ++ks)
#pragma unroll
      for (int t = 0; t < 2; ++t) {
        af[ks][t] = *(const bf16x8*)(As + (buf * 128 + wm * 64 + t * 32 + (lane & 31)) * GS + ks * 16 + (lane >> 5) * 8);
        bf[ks][t] = *(const bf16x8*)(Bs + (buf * 128 + wn * 64 + t * 32 + (lane & 31)) * GS + ks * 16 + (lane >> 5) * 8);
      }
    __builtin_amdgcn_sched_barrier(0);
#pragma unroll
    for (int ks = 0; ks < 4; ++ks)
#pragma unroll
      for (int tm = 0; tm < 2; ++tm)
#pragma unroll
        for (int tn = 0; tn < 2; ++tn)
          acc[tm][tn] = SWAP ? __builtin_amdgcn_mfma_f32_32x32x16_bf16(bf[ks][tn], af[ks][tm], acc[tm][tn], 0, 0, 0)
                             : __builtin_amdgcn_mfma_f32_32x32x16_bf16(af[ks][tm], bf[ks][tn], acc[tm][tn], 0, 0, 0);
    __builtin_amdgcn_sched_barrier(0);
    if (kt + 1 < nk) GSWRITE(buf ^ 1);
    __syncthreads();
  }
}
#define ACC_ROW(wm, tm, r, lane) ((wm) * 64 + (tm) * 32 + ((r) & 3) + 8 * ((r) >> 2) + 4 * ((lane) >> 5))
#define ACC_COL(wn, tn, lane) ((wn) * 64 + (tn) * 32 + ((lane) & 31))

#define ES 136
__device__ __forceinline__ void store_tile_bf16(const f32x16 (&acc)[2][2], u16* lds, u16* __restrict__ dst, int ldd, int m0, int mvalid, int n0) {
  const int tid = TIDX, lane = tid & 63, w = tid >> 6, wm = w >> 1, wn = w & 1;
#pragma unroll
  for (int tm = 0; tm < 2; ++tm)
#pragma unroll
    for (int tn = 0; tn < 2; ++tn)
#pragma unroll
      for (int r = 0; r < 16; ++r)
        lds[ACC_ROW(wm, tm, r, lane) * ES + ACC_COL(wn, tn, lane)] = f2bf(acc[tm][tn][r]);
  __syncthreads();
#pragma unroll
  for (int i = 0; i < 8; ++i) {
    int c = tid + 256 * i, row = c >> 4, ch = c & 15;
    if (m0 + row < mvalid) *(uint4*)(dst + (size_t)(m0 + row) * ldd + n0 + ch * 8) = *(const uint4*)(lds + row * ES + ch * 8);
  }
  __syncthreads();
}

__device__ __forceinline__ void phase_gemm1(const Params& p, int pass, char* lds, unsigned xcc) {
  int R = pass_rows(pass), r0 = pass_row0(pass);
  int mt = (R + 127) >> 7;
  int lane = TIDX & 63, w = TIDX >> 6, wm = w >> 1, wn = w & 1;
  int* item = (int*)(lds + 77808);
  unsigned* ctr = p.bar + XCD_BAR_WORDS + 32 + pass * 8;
  int q = (int)(xcc & 7u), tries = 0;
  while (tries < 8) {
    __syncthreads();
    if (TIDX == 0) *item = (int)atomicAdd(&ctr[q], 1u);
    __syncthreads();
    int idx = *item;
    int nq = mt * 8 + (mt - q + 7) / 8;
    if (idx >= nq) { q = (q + 1) & 7; ++tries; continue; }
    int tm_, tn_;
    if (idx < mt * 8) { tm_ = idx >> 3; tn_ = q * 8 + (idx & 7); }
    else { tm_ = q + 8 * (idx - mt * 8); tn_ = 64; }
    int m0 = tm_ * 128, n0 = tn_ * 128;
    f32x16 acc[2][2];
#pragma unroll
    for (int i = 0; i < 2; ++i)
#pragma unroll
      for (int j = 0; j < 2; ++j)
#pragma unroll
        for (int r = 0; r < 16; ++r) acc[i][j][r] = 0.f;
    gemm_core<true>(p.H, DM, m0, R, p.WinT, DM, n0, DM, acc, (u16*)lds);
    int kind = 0;
    if (n0 >= C_DK && n0 < C_DV) kind = 1; else if (n0 >= C_DV && n0 < C_IQ) kind = 2; else if (n0 >= C_SM) kind = 3;
    const int half = lane >> 5;
#pragma unroll
    for (int tm = 0; tm < 2; ++tm) {
      int m = m0 + wm * 64 + tm * 32 + (lane & 31);
      if (kind != 3) {
#pragma unroll
        for (int tn = 0; tn < 2; ++tn)
#pragma unroll
          for (int gp = 0; gp < 2; ++gp) {
            u32 a0 = pack2(acc[tm][tn][8 * gp + 0], acc[tm][tn][8 * gp + 1]), a1 = pack2(acc[tm][tn][8 * gp + 2], acc[tm][tn][8 * gp + 3]);
            u32 b0 = pack2(acc[tm][tn][8 * gp + 4], acc[tm][tn][8 * gp + 5]), b1 = pack2(acc[tm][tn][8 * gp + 6], acc[tm][tn][8 * gp + 7]);
            auto s0 = __builtin_amdgcn_permlane32_swap(a0, b0, false, false);
            auto s1 = __builtin_amdgcn_permlane32_swap(a1, b1, false, false);
            int n = n0 + wn * 64 + tn * 32 + 8 * (2 * gp + half);
            if (m < R) *(uint4*)(p.P + (size_t)m * NCOL + n) = make_uint4(s0[0], s1[0], s0[1], s1[1]);
          }
      }
      if (kind != 0 && m < R) {
        int gr = r0 + m;
#pragma unroll
        for (int tn = 0; tn < 2; ++tn)
#pragma unroll
          for (int g = 0; g < 4; ++g) {
            int n = n0 + wn * 64 + tn * 32 + 8 * g + 4 * half;
            float4 v = make_float4(acc[tm][tn][4 * g + 0], acc[tm][tn][4 * g + 1], acc[tm][tn][4 * g + 2], acc[tm][tn][4 * g + 3]);
            if (kind == 3) {
              *(float4*)(p.PS + (size_t)m * 128 + (n - C_SM)) = v;
            } else {
              float* base = kind == 1 ? (gr < NPROMPT_ROWS ? p.k_prompt : p.k_sample) : (gr < NPROMPT_ROWS ? p.v_prompt : p.v_sample);
              int rr = gr < NPROMPT_ROWS ? gr : gr - NPROMPT_ROWS;
              *(float4*)(base + (size_t)rr * 256 + (n - (kind == 1 ? C_DK : C_DV))) = v;
            }
          }
      }
    }
  }
}

__device__ __forceinline__ void phase_tok(const Params& p, int pass, char* lds, bool dry) {
  float* glow = (float*)lds;
  int r0g = pass_row0(pass);
  int nblk = pass_nblk(pass);
  int tid = TIDX, lane = tid & 63, wave = tid >> 6;
  for (int tile = blockIdx.x; tile < nblk * 2; tile += gridDim.x) {
    int blk = tile >> 1, hf = tile & 1;
    int row0, len; blk_info(blk, row0, len);
    for (int t = wave; t < (hf == 0 ? len : 0); t += 4) {
      int m = row0 + t, gr = r0g + m;
      float x = p.PS[(size_t)m * 128 + lane];
      float mu = wave_sum(x) * (1.f / 64);
      float xc = x - mu;
      float var = wave_sum(xc * xc) * (1.f / 64);
      float y = xc * rsqrtf(var + NORM_EPS) * p.idx_kn_g[lane] + p.idx_kn_b[lane];
      u16 yb = f2bf(y);
      p.KI[(size_t)m * 64 + lane] = yb;
      if (gr < NPROMPT_ROWS) p.idx_k_prompt[(size_t)gr * 64 + lane] = y;
      else {
        int sr = gr - NPROMPT_ROWS; p.idx_k_sample[(size_t)sr * 64 + lane] = y;
        int sb = sr >> 4, tt = sr & 15;
        p.KIS[((size_t)sb * NKEYS_S + 2048 + tt) * 64 + lane] = yb;
      }
    }
    if (hf == 0) {
      u8* dst0 = blk < 257 ? p.KV8P + (size_t)row0 * 512 : p.KV8S + ((size_t)(blk - 257) * NKEYS_S + 2048) * 512;
      for (int i = tid; i < len * 64; i += 256) {
        int tt = i >> 6, c = (i & 63) * 4;
        const u16* src = p.P + (size_t)(row0 + tt) * NCOL + C_DK + c;
        uint2 kk = *(const uint2*)src, vv = *(const uint2*)(src + 256);
        u8* o = dst0 + (size_t)tt * 512 + (c >> 6) * 128 + (c & 63);
        *(u32*)o = pk4_fp8(bf2f((u16)(kk.x & 0xffff)), bf2f((u16)(kk.x >> 16)), bf2f((u16)(kk.y & 0xffff)), bf2f((u16)(kk.y >> 16)));
        *(u32*)(o + 64) = pk4_fp8(bf2f((u16)(vv.x & 0xffff)), bf2f((u16)(vv.x >> 16)), bf2f((u16)(vv.y & 0xffff)), bf2f((u16)(vv.y >> 16)));
      }
    }
    for (int i = tid; i < 64 * 16; i += 256) {
      int t = i >> 4, r = i & 15;
      glow[i] = t < len ? p.PS[(size_t)(row0 + t) * 128 + 64 + r] : 0.f;
    }
    __syncthreads();
    {
      const int ch = hf * 256 + tid;
      float w2[16];
#pragma unroll
      for (int r = 0; r < 16; ++r) w2[r] = p.gla_w2[r * 512 + ch];
      float bias = p.gla_gate_b[ch];
      float b = 0.f;
      for (int t = 0; t < len; ++t) {
        float x = bias;
#pragma unroll
        for (int r = 0; r < 16; ++r) x += glow[t * 16 + r] * w2[r];
        float ls = fminf(x, 0.f) - log1pf(expf(-fabsf(x)));
        b += ls * (1.f / 16.f);
        size_t o = (size_t)(row0 + t) * NCOL;
        float qv = bf2f(p.P[o + C_GQ + ch]) * GLA_QSCALE * expf(b);
        float kv = bf2f(p.P[o + C_GK + ch]) * expf(-b);
        if (!dry) { p.P[o + C_GQ + ch] = f2bf(qv); p.P[o + C_GK + ch] = f2bf(kv); }
      }
      p.DEC[blk * 512 + ch] = expf(b);
    }
    __syncthreads();
  }
}

#define TS 72
template <int NIT>
__device__ __forceinline__ void stage_transposed(const u16* __restrict__ P, int row0, int len, int col0, u16* dst) {
  const int tid = TIDX, t = tid & 63, dc0 = tid >> 6;
  u32x4 v[NIT];
  const u16* src = P + (size_t)(row0 + (t < len ? t : 0)) * NCOL + col0;
#pragma unroll
  for (int i = 0; i < NIT; ++i) v[i] = *(const u32x4*)(src + (dc0 + 4 * i) * 8);
  __builtin_amdgcn_sched_barrier(0);
#pragma unroll
  for (int i = 0; i < NIT; ++i) {
    u32x4 x = v[i];
    if (t >= len) x = u32x4{0u, 0u, 0u, 0u};
    u16* d = dst + ((dc0 + 4 * i) * 8) * TS + t;
    d[0 * TS] = (u16)(x[0] & 0xffff); d[1 * TS] = (u16)(x[0] >> 16);
    d[2 * TS] = (u16)(x[1] & 0xffff); d[3 * TS] = (u16)(x[1] >> 16);
    d[4 * TS] = (u16)(x[2] & 0xffff); d[5 * TS] = (u16)(x[2] >> 16);
    d[6 * TS] = (u16)(x[3] & 0xffff); d[7 * TS] = (u16)(x[3] >> 16);
  }
}

__device__ __forceinline__ void phase_u(const Params& p, int pass, char* lds) {
  u16* KT = (u16*)lds;
  u16* VT = KT + 128 * TS;
  int nblk = pass_nblk(pass);
  int lane = TIDX & 63, w = TIDX >> 6;
  unsigned* ctr = p.bar + XCD_BAR_WORDS + 64 + pass;
  for (int t = dq_next(ctr, lds); t < nblk * 4; t = dq_next(ctr, lds)) {
    int blk = t >> 2, h = t & 3;
    int row0, len; blk_info(blk, row0, len);
    stage_transposed<4>(p.P, row0, len, C_GK + h * 128, KT);
    stage_transposed<8>(p.P, row0, len, C_GV + h * 256, VT);
    __syncthreads();
#pragma unroll
    for (int half = 0; half < 2; ++half) {
      f32x16 acc[2][2];
#pragma unroll
      for (int i = 0; i < 2; ++i)
#pragma unroll
        for (int j = 0; j < 2; ++j)
#pragma unroll
          for (int r = 0; r < 16; ++r) acc[i][j][r] = 0.f;
#pragma unroll
      for (int ks = 0; ks < 4; ++ks) {
        bf16x8 a[2], b[2];
#pragma unroll
        for (int tn = 0; tn < 2; ++tn) {
          a[tn] = *(const bf16x8*)(VT + (w * 64 + tn * 32 + (lane & 31)) * TS + ks * 16 + (lane >> 5) * 8);
          b[tn] = *(const bf16x8*)(KT + (half * 64 + tn * 32 + (lane & 31)) * TS + ks * 16 + (lane >> 5) * 8);
        }
#pragma unroll
        for (int tm = 0; tm < 2; ++tm)
#pragma unroll
          for (int tn = 0; tn < 2; ++tn)
            acc[tm][tn] = __builtin_amdgcn_mfma_f32_32x32x16_bf16(a[tm], b[tn], acc[tm][tn], 0, 0, 0);
      }
#pragma unroll
      for (int tn = 0; tn < 2; ++tn) {
        int d = half * 64 + tn * 32 + (lane & 31);
        float dec = p.DEC[blk * 512 + h * 128 + d];
#pragma unroll
        for (int tm = 0; tm < 2; ++tm)
#pragma unroll
          for (int r = 0; r < 16; ++r) {
            int e = w * 64 + tm * 32 + (r & 3) + 8 * (r >> 2) + 4 * (lane >> 5);
            p.US[((size_t)(blk * 4 + h) * 256 + e) * 128 + d] = f2bf(acc[tm][tn][r] * dec);
          }
      }
    }
    __syncthreads();
  }
}

__device__ __forceinline__ void phase_scan(const Params& p, int pass, bool dry) {
  int ntiles = 128 + (pass == 1 ? 32 * 128 : 0);
  for (int t = blockIdx.x; t < ntiles; t += gridDim.x) {
    bool samp = t >= 128;
    int sb = samp ? (t - 128) >> 7 : 0;
    int g4 = ((samp ? (t - 128) & 127 : t) << 8) + TIDX;
    int h = g4 >> 13, e = (g4 >> 5) & 255, d4 = (g4 & 31) * 4;
    float S[4];
    float* outp;
    int blk0, nb;
    if (!samp) {
      S[0] = S[1] = S[2] = S[3] = 0.f;
      outp = p.gla_prompt + (size_t)pass * 131072;
      blk0 = 0; nb = 257;
    } else {
      const float* st = p.state_gla + (size_t)sb * 131072;
#pragma unroll
      for (int j = 0; j < 4; ++j) S[j] = st[((size_t)(h * 128 + d4 + j)) * 256 + e];
      outp = p.gla_sample + (size_t)sb * 131072;
      blk0 = 257 + sb; nb = 1;
    }
    size_t eoff = (size_t)g4 * 4;
    for (int n0 = 0; n0 < nb; n0 += 8) {
      uint2 u[8]; float4 dc[8];
#pragma unroll
      for (int j = 0; j < 8; ++j) {
        int n = n0 + j; if (n < nb) {
          u[j] = *(const uint2*)(p.US + (size_t)(blk0 + n) * 131072 + eoff);
          dc[j] = *(const float4*)(p.DEC + (blk0 + n) * 512 + h * 128 + d4);
        }
      }
      __builtin_amdgcn_sched_barrier(0);
#pragma unroll
      for (int j = 0; j < 8; ++j) {
        int n = n0 + j; if (n < nb) {
          if (!dry) *(uint2*)(p.US + (size_t)(blk0 + n) * 131072 + eoff) = make_uint2(pack2(S[0], S[1]), pack2(S[2], S[3]));
          S[0] = dc[j].x * S[0] + bf2f((u16)(u[j].x & 0xffff));
          S[1] = dc[j].y * S[1] + bf2f((u16)(u[j].x >> 16));
          S[2] = dc[j].z * S[2] + bf2f((u16)(u[j].y & 0xffff));
          S[3] = dc[j].w * S[3] + bf2f((u16)(u[j].y >> 16));
        }
      }
    }
#pragma unroll
    for (int j = 0; j < 4; ++j) outp[((size_t)(h * 128 + d4 + j)) * 256 + e] = S[j];
  }
}

#define OS 264
__device__ __forceinline__ void phase_o(const Params& p, int pass, char* lds, bool dry) {
  u16* VT = (u16*)lds;
  u16* AS = VT + 256 * TS;
  u16* OT = VT;
  int nblk = pass_nblk(pass);
  int tid = TIDX, lane = tid & 63, w = tid >> 6;
  int* item = (int*)(lds + 77808);
  unsigned* ctr = p.bar + XCD_BAR_WORDS + 48 + (dry ? 8 : 0) + pass;
  for (;;) {
    __syncthreads();
    if (tid == 0) *item = (int)atomicAdd(ctr, 1u);
    __syncthreads();
    int t = *item;
    if (t >= nblk * 4) break;
    int blk = t >> 2, h = t & 3;
    int row0, len; blk_info(blk, row0, len);
    stage_transposed<8>(p.P, row0, len, C_GV + h * 256, VT);
    {
      int ti = w >> 1, tj = w & 1;
      f32x16 acc;
#pragma unroll
      for (int r = 0; r < 16; ++r) acc[r] = 0.f;
      if (tj <= ti) {
        int qi = ti * 32 + (lane & 31), kj = tj * 32 + (lane & 31);
        const u16* qp = p.P + (size_t)(row0 + (qi < len ? qi : 0)) * NCOL + C_GQ + h * 128 + (lane >> 5) * 8;
        const u16* kp = p.P + (size_t)(row0 + (kj < len ? kj : 0)) * NCOL + C_GK + h * 128 + (lane >> 5) * 8;
#pragma unroll
        for (int ks = 0; ks < 8; ++ks) {
          bf16x8 a = *(const bf16x8*)(qp + ks * 16), b = *(const bf16x8*)(kp + ks * 16);
          acc = __builtin_amdgcn_mfma_f32_32x32x16_bf16(a, b, acc, 0, 0, 0);
        }
      }
#pragma unroll
      for (int r = 0; r < 16; ++r) {
        int i = ti * 32 + (r & 3) + 8 * (r >> 2) + 4 * (lane >> 5), j = tj * 32 + (lane & 31);
        float v = (j <= i && i < len && j < len) ? acc[r] : 0.f;
        AS[i * TS + j] = f2bf(v);
      }
    }
    __syncthreads();
    f32x16 acc[2][2];
#pragma unroll
    for (int i = 0; i < 2; ++i)
#pragma unroll
      for (int j = 0; j < 2; ++j)
#pragma unroll
        for (int r = 0; r < 16; ++r) acc[i][j][r] = 0.f;
#pragma unroll
    for (int ks = 0; ks < 4; ++ks) {
      bf16x8 a[2], b[2];
#pragma unroll
      for (int x = 0; x < 2; ++x) {
        a[x] = *(const bf16x8*)(AS + (x * 32 + (lane & 31)) * TS + ks * 16 + (lane >> 5) * 8);
        b[x] = *(const bf16x8*)(VT + (w * 64 + x * 32 + (lane & 31)) * TS + ks * 16 + (lane >> 5) * 8);
      }
#pragma unroll
      for (int tm = 0; tm < 2; ++tm)
#pragma unroll
        for (int tn = 0; tn < 2; ++tn)
          acc[tm][tn] = __builtin_amdgcn_mfma_f32_32x32x16_bf16(a[tm], b[tn], acc[tm][tn], 0, 0, 0);
    }
    {
      const u16* Sp = p.US + (size_t)(blk * 4 + h) * 32768;
#pragma unroll
      for (int ks = 0; ks < 8; ++ks) {
        bf16x8 a[2], b[2];
#pragma unroll
        for (int x = 0; x < 2; ++x) {
          int qi = x * 32 + (lane & 31);
          bf16x8 z = {0, 0, 0, 0, 0, 0, 0, 0};
          a[x] = qi < len ? *(const bf16x8*)(p.P + (size_t)(row0 + qi) * NCOL + C_GQ + h * 128 + ks * 16 + (lane >> 5) * 8) : z;
          b[x] = *(const bf16x8*)(Sp + (size_t)(w * 64 + x * 32 + (lane & 31)) * 128 + ks * 16 + (lane >> 5) * 8);
        }
#pragma unroll
        for (int tm = 0; tm < 2; ++tm)
#pragma unroll
          for (int tn = 0; tn < 2; ++tn)
            acc[tm][tn] = __builtin_amdgcn_mfma_f32_32x32x16_bf16(a[tm], b[tn], acc[tm][tn], 0, 0, 0);
      }
    }
    __syncthreads();
#pragma unroll
    for (int tm = 0; tm < 2; ++tm)
#pragma unroll
      for (int tn = 0; tn < 2; ++tn)
#pragma unroll
        for (int r = 0; r < 16; ++r) {
          int i = tm * 32 + (r & 3) + 8 * (r >> 2) + 4 * (lane >> 5), e = w * 64 + tn * 32 + (lane & 31);
          OT[i * OS + e] = f2bf(acc[tm][tn][r]);
        }
    __syncthreads();
    {
      int i = tid >> 2, seg = tid & 3;
      float vals[64];
      float ss = 0.f;
#pragma unroll
      for (int c = 0; c < 8; ++c) {
        uint4 v = *(const uint4*)(OT + i * OS + seg * 64 + c * 8);
        u32 ww[4] = {v.x, v.y, v.z, v.w};
#pragma unroll
        for (int k = 0; k < 4; ++k) {
          float a = bf2f((u16)(ww[k] & 0xffff)), b = bf2f((u16)(ww[k] >> 16));
          vals[c * 8 + 2 * k] = a; vals[c * 8 + 2 * k + 1] = b; ss += a * a + b * b;
        }
      }
      ss += __shfl_xor(ss, 1); ss += __shfl_xor(ss, 2);
      float rstd = rsqrtf(ss * (1.f / 256) + NORM_EPS);
      if (i < len && !dry) {
        size_t o = (size_t)(row0 + i) * NCOL;
#pragma unroll
        for (int c = 0; c < 8; ++c) {
          int e = seg * 64 + c * 8;
          uint4 gr = *(const uint4*)(p.P + o + C_GR + h * 256 + e);
          u32 gw[4] = {gr.x, gr.y, gr.z, gr.w};
          u32 ow[4];
#pragma unroll
          for (int k = 0; k < 4; ++k) {
            float g0 = bf2f((u16)(gw[k] & 0xffff)), g1 = bf2f((u16)(gw[k] >> 16));
            float y0 = vals[c * 8 + 2 * k] * rstd * p.gla_norm_g[e + 2 * k] * siluf_(g0);
            float y1 = vals[c * 8 + 2 * k + 1] * rstd * p.gla_norm_g[e + 2 * k + 1] * siluf_(g1);
            ow[k] = pack2(y0, y1);
          }
          *(uint4*)(p.P + o + C_GV + h * 256 + e) = make_uint4(ow[0], ow[1], ow[2], ow[3]);
        }
      }
    }
    __syncthreads();
  }
}

struct DTile {
  int qrow0, qrow1;
  int nkeys0, nkeys1;
  const u16* ki; int ki_stride;
  const u16* kv; int kv_stride;
};

__device__ __forceinline__ u32 score_key(float s, int keyidx) {
  u32 u = __float_as_uint(s);
  u ^= (u32)(((int)u) >> 31) | 0x80000000u;
  return (u & 0xFFFF8000u) | (u32)(32767 - keyidx);
}

__device__ __forceinline__ void compact(u32* cand, int n, int hi, int& newcnt, u32& newthr) {
  int lane = TIDX & 63;
  u32 v[CVN];
#pragma unroll
  for (int e = 0; e < CVN; ++e) { int idx = lane + 64 * e; v[e] = idx < n ? cand[idx] : 0u; }
  u32 prefix = 0;
  for (int bit = 31; bit >= 0; --bit) {
    u32 trial = prefix | (1u << bit);
    int c = 0;
#pragma unroll
    for (int e = 0; e < CVN; ++e) c += __popcll(__ballot(v[e] >= trial));
    if (c >= 256) { prefix = trial; if (c <= hi) break; }
  }
  int base = 0;
  unsigned long long lt = (1ull << lane) - 1ull;
#pragma unroll
  for (int e = 0; e < CVN; ++e) {
    bool keep = v[e] >= prefix && prefix != 0;
    unsigned long long m = __ballot(keep);
    int pos = base + __popcll(m & lt);
    if (keep) cand[pos] = v[e];
    base += __popcll(m);
  }
  newcnt = base; newthr = prefix - 1u;
}

__device__ __forceinline__ void dsa_tile(const Params& p, const DTile& T, char* lds, bool dry) {
  u32* cand = (u32*)lds;
  u16* kst = (u16*)(lds + 32 * CAP * 4);
  const int tid = TIDX, lane = tid & 63, w = tid >> 6, half = lane >> 5;
  bf16x8 afr[2][4];
  bf16x8 aW[2][2];
#pragma unroll
  for (int rt = 0; rt < 2; ++rt) {
    bool act = (rt == 0 ? T.nkeys0 : T.nkeys1) > 0;
    int qr = (act && rt == 1) ? T.qrow1 : T.qrow0;
    int m = qr + 4 * w + ((lane & 31) >> 3);
    const u16* ap = p.P + (size_t)m * NCOL + C_IQ + (lane & 7) * 64 + half * 8;
#pragma unroll
    for (int ks = 0; ks < 4; ++ks) afr[rt][ks] = *(const bf16x8*)(ap + ks * 16);
    const int rho = lane & 31;
    const bool vrow = (rho & ~5) == 0;
    const int qi = 2 * (rho & 1) + ((rho >> 2) & 1);
    float4 w4 = *(const float4*)(p.PS + (size_t)(qr + 4 * w + qi) * 128 + 80 + 4 * half);
    u32 lo = pack2(w4.x * IDX_W_SCALE, w4.y * IDX_W_SCALE), hi = pack2(w4.z * IDX_W_SCALE, w4.w * IDX_W_SCALE);
#pragma unroll
    for (int sx = 0; sx < 2; ++sx) {
      bool on = vrow && (qi >> 1) == sx;
      u32x4 wd = {0u, 0u, 0u, 0u};
      if (on && (qi & 1) == 0) { wd[0] = lo; wd[1] = hi; }
      if (on && (qi & 1) == 1) { wd[2] = lo; wd[3] = hi; }
      aW[rt][sx] = __builtin_bit_cast(bf16x8, wd);
    }
  }
  u32 thr[2][2]; int cnt[2][2];
#pragma unroll
  for (int rt = 0; rt < 2; ++rt)
#pragma unroll
    for (int pp = 0; pp < 2; ++pp) { thr[rt][pp] = 0u; cnt[rt][pp] = 0; }
  const int NH = T.nkeys0, NL = T.nkeys1;
  const int nkt = (NH + 63) >> 6;
  const unsigned long long lt = (1ull << lane) - 1ull;
#define SCORE(ACC, RT, K0, KEY0, KEY1, M0, M1) do { \
    const int N_ = (RT) == 0 ? NH : NL; \
    M0 = 0ull; M1 = 0ull; KEY0 = 0u; KEY1 = 0u; \
    if ((K0) < N_) { \
      const int keyidx = (K0) + (lane & 31); \
      const bool valid = keyidx < N_; \
      u32x4 xa_ = {cvt_pk_bf16(relu1(ACC[0]), relu1(ACC[1])), cvt_pk_bf16(relu1(ACC[2]), relu1(ACC[3])), \
                   cvt_pk_bf16(relu1(ACC[4]), relu1(ACC[5])), cvt_pk_bf16(relu1(ACC[6]), relu1(ACC[7]))}; \
      u32x4 xb_ = {cvt_pk_bf16(relu1(ACC[8]), relu1(ACC[9])), cvt_pk_bf16(relu1(ACC[10]), relu1(ACC[11])), \
                   cvt_pk_bf16(relu1(ACC[12]), relu1(ACC[13])), cvt_pk_bf16(relu1(ACC[14]), relu1(ACC[15]))}; \
      f32x16 s2_; \
      _Pragma("unroll") for (int r_ = 0; r_ < 16; ++r_) s2_[r_] = 0.f; \
      s2_ = __builtin_amdgcn_mfma_f32_32x32x16_bf16(aW[RT][0], __builtin_bit_cast(bf16x8, xa_), s2_, 0, 0, 0); \
      s2_ = __builtin_amdgcn_mfma_f32_32x32x16_bf16(aW[RT][1], __builtin_bit_cast(bf16x8, xb_), s2_, 0, 0, 0); \
      KEY0 = score_key(s2_[0], keyidx); \
      KEY1 = score_key(s2_[1], keyidx); \
      M0 = __ballot(valid && KEY0 > thr[RT][0]); \
      M1 = __ballot(valid && KEY1 > thr[RT][1]); \
    } } while (0)
#define APPEND(RT, PP, KEY, M) do { \
    if (M) { \
      bool pass = (M >> lane) & 1ull; \
      pass = pass && (KEY > thr[RT][PP]); \
      unsigned long long m = __ballot(pass); \
      u32 mh = half ? (u32)(m >> 32) : (u32)m; \
      int slot = (RT) * 16 + 4 * w + 2 * (PP) + half; \
      int pos = cnt[RT][PP] + __popc(mh & (u32)(lt >> (half * 32))); \
      if (pass) cand[slot * CAP + pos] = KEY; \
      cnt[RT][PP] += __popc(mh); \
      unsigned long long over = __ballot(cnt[RT][PP] > CLIMIT); \
      if (over) { \
        _Pragma("unroll") \
        for (int hh = 0; hh < 2; ++hh) { \
          if ((u32)(over >> (hh * 32)) != 0u) { \
            int sl = (RT) * 16 + 4 * w + 2 * (PP) + hh; \
            int n = __shfl(cnt[RT][PP], hh * 32); \
            int nc; u32 nt; \
            compact(cand + sl * CAP, n, 320, nc, nt); \
            if (half == hh) { cnt[RT][PP] = nc; thr[RT][PP] = nt; } \
          } \
        } \
      } \
    } } while (0)
  bf16x8 nA[4], nB[4];
#define BLOAD(kt) do { \
    int ka_ = (kt) * 64 + (lane & 31), kb_ = ka_ + 32; \
    ka_ = ka_ < NH ? ka_ : NH - 1; kb_ = kb_ < NH ? kb_ : NH - 1; \
    const u16* pa_ = T.ki + (size_t)ka_ * T.ki_stride + half * 8; \
    const u16* pb_ = T.ki + (size_t)kb_ * T.ki_stride + half * 8; \
    _Pragma("unroll") for (int ks = 0; ks < 4; ++ks) { nA[ks] = *(const bf16x8*)(pa_ + ks * 16); nB[ks] = *(const bf16x8*)(pb_ + ks * 16); } } while (0)
  BLOAD(0);
#pragma unroll 1
  for (int kt = 0; kt < nkt; ++kt) {
    const int k0a = kt * 64, k0b = kt * 64 + 32;
    bf16x8 bA[4], bB[4];
#pragma unroll
    for (int ks = 0; ks < 4; ++ks) { bA[ks] = nA[ks]; bB[ks] = nB[ks]; }
    if (kt + 1 < nkt) BLOAD(kt + 1);
    __builtin_amdgcn_sched_barrier(0);
    f32x16 aH0, aL0, aH1, aL1;
#pragma unroll
    for (int r = 0; r < 16; ++r) { aH0[r] = 0.f; aL0[r] = 0.f; aH1[r] = 0.f; aL1[r] = 0.f; }
    const bool lact = k0a < NL;
#pragma unroll
    for (int ks = 0; ks < 4; ++ks) {
      aH0 = __builtin_amdgcn_mfma_f32_32x32x16_bf16(afr[0][ks], bA[ks], aH0, 0, 0, 0);
      aH1 = __builtin_amdgcn_mfma_f32_32x32x16_bf16(afr[0][ks], bB[ks], aH1, 0, 0, 0);
    }
    if (lact) {
#pragma unroll
      for (int ks = 0; ks < 4; ++ks) {
        aL0 = __builtin_amdgcn_mfma_f32_32x32x16_bf16(afr[1][ks], bA[ks], aL0, 0, 0, 0);
        aL1 = __builtin_amdgcn_mfma_f32_32x32x16_bf16(afr[1][ks], bB[ks], aL1, 0, 0, 0);
      }
    }
    u32 kH0a, kH0b, kH1a, kH1b, kL0a, kL0b, kL1a, kL1b;
    unsigned long long mH0a, mH0b, mH1a, mH1b, mL0a, mL0b, mL1a, mL1b;
    SCORE(aH0, 0, k0a, kH0a, kH0b, mH0a, mH0b);
    SCORE(aH1, 0, k0b, kH1a, kH1b, mH1a, mH1b);
    SCORE(aL0, 1, k0a, kL0a, kL0b, mL0a, mL0b);
    SCORE(aL1, 1, k0b, kL1a, kL1b, mL1a, mL1b);
    if (mH0a | mH0b | mH1a | mH1b | mL0a | mL0b | mL1a | mL1b) {
      APPEND(0, 0, kH0a, mH0a); APPEND(0, 1, kH0b, mH0b);
      APPEND(0, 0, kH1a, mH1a); APPEND(0, 1, kH1b, mH1b);
      APPEND(1, 0, kL0a, mL0a); APPEND(1, 1, kL0b, mL0b);
      APPEND(1, 0, kL1a, mL1a); APPEND(1, 1, kL1b, mL1b);
    }
  }
  int* nselp = (int*)(lds + 32 * CAP * 4);
#pragma unroll
  for (int rt = 0; rt < 2; ++rt)
#pragma unroll
    for (int pp = 0; pp < 2; ++pp)
#pragma unroll
      for (int hh = 0; hh < 2; ++hh) {
        int sl = rt * 16 + 4 * w + 2 * pp + hh;
        int n = __shfl(cnt[rt][pp], hh * 32);
        if (n > 256) { int nc; u32 nt; compact(cand + sl * CAP, n, 256, nc, nt); n = nc; }
        if (lane == 0) nselp[sl] = n;
      }
#pragma unroll 1
  for (int qq = 0; qq < 8; ++qq) {
    int rt = qq >> 2, qi = qq & 3;
    if ((rt == 0 ? T.nkeys0 : T.nkeys1) == 0) continue;
    int sl = rt * 16 + 4 * w + qi;
    int nsel = nselp[sl];
    const u32* cq = cand + sl * CAP;
    int m = (rt == 0 ? T.qrow0 : T.qrow1) + 4 * w + qi;
    u32 k0 = 4 * lane + 0 < nsel ? 32767u - (cq[4 * lane + 0] & 0x7fffu) : 0u;
    u32 k1 = 4 * lane + 1 < nsel ? 32767u - (cq[4 * lane + 1] & 0x7fffu) : 0u;
    u32 k2 = 4 * lane + 2 < nsel ? 32767u - (cq[4 * lane + 2] & 0x7fffu) : 0u;
    u32 k3 = 4 * lane + 3 < nsel ? 32767u - (cq[4 * lane + 3] & 0x7fffu) : 0u;
    if (!dry) *(uint2*)(p.SEL + (size_t)m * 256 + 4 * lane) = make_uint2(k0 | (k1 << 16), k2 | (k3 << 16));
  }
  __syncthreads();
}

typedef __attribute__((ext_vector_type(2))) unsigned int u32x2;
__device__ __forceinline__ bf16x8 fp8x8_to_bf16x8(u32x2 x) {
  u32 a0, a1, a2, a3;
  fp8x4_to_bf16(x[0], a0, a1);
  fp8x4_to_bf16(x[1], a2, a3);
  u32x4 r = {a0, a1, a2, a3};
  return __builtin_bit_cast(bf16x8, r);
}
__device__ __forceinline__ void att_unit(const Params& p, int m, int g, int nsel, const u8* __restrict__ kv,
                                         const u16* sl, u16* vs, bool dry) {
  const int lane = TIDX & 63, g4 = lane >> 4, i16 = lane & 15;
  bf16x8 bq0, bq1;
  {
    bf16x8 z = {0, 0, 0, 0, 0, 0, 0, 0};
    const u16* qp = p.P + (size_t)m * NCOL + C_DQ + (g * 4 + (i16 & 3)) * 64 + g4 * 8;
    bq0 = i16 < 4 ? *(const bf16x8*)(qp) : z;
    bq1 = i16 < 4 ? *(const bf16x8*)(qp + 32) : z;
  }
  const int npad = (nsel + 31) & ~31;
  const int nchunk = (npad + 63) >> 6;
  const u8* kbase = kv + g * 128 + g4 * 8;
  const u8* vbase = kv + g * 128 + 64 + (lane & 3) * 16;
  u32x2 kc[4][2], kn[4][2];
#pragma unroll
  for (int tt = 0; tt < 4; ++tt) {
    const u8* kp = kbase + (size_t)sl[tt * 16 + i16] * 512;
    kc[tt][0] = *(const u32x2*)kp; kc[tt][1] = *(const u32x2*)(kp + 32);
    kn[tt][0] = kc[tt][0]; kn[tt][1] = kc[tt][1];
  }
  u32x4 vc[2][2], vn[2][2];
#pragma unroll
  for (int s2 = 0; s2 < 2; ++s2)
#pragma unroll
    for (int it = 0; it < 2; ++it) {
      vc[s2][it] = *(const u32x4*)(vbase + (size_t)sl[s2 * 32 + it * 16 + (lane >> 2)] * 512);
      vn[s2][it] = vc[s2][it];
    }
  float mrun = -3.0e38f, lrun = 0.f;
  f32x4 oacc[4];
#pragma unroll
  for (int dt = 0; dt < 4; ++dt) oacc[dt] = f32x4{0.f, 0.f, 0.f, 0.f};
#pragma unroll 1
  for (int c = 0; c < nchunk; ++c) {
    if (c + 1 < nchunk) {
#pragma unroll
      for (int s2 = 0; s2 < 2; ++s2)
#pragma unroll
        for (int it = 0; it < 2; ++it)
          vn[s2][it] = *(const u32x4*)(vbase + (size_t)sl[(c + 1) * 64 + s2 * 32 + it * 16 + (lane >> 2)] * 512);
#pragma unroll
      for (int tt = 0; tt < 4; ++tt) {
        const u8* kp = kbase + (size_t)sl[(c + 1) * 64 + tt * 16 + i16] * 512;
        kn[tt][0] = *(const u32x2*)kp; kn[tt][1] = *(const u32x2*)(kp + 32);
      }
    }
    __builtin_amdgcn_sched_barrier(0);
    f32x4 lg[4];
    float cmax = -3.0e38f;
#pragma unroll
    for (int tt = 0; tt < 4; ++tt) {
      f32x4 cc = {0.f, 0.f, 0.f, 0.f};
      cc = __builtin_amdgcn_mfma_f32_16x16x32_bf16(fp8x8_to_bf16x8(kc[tt][0]), bq0, cc, 0, 0, 0);
      cc = __builtin_amdgcn_mfma_f32_16x16x32_bf16(fp8x8_to_bf16x8(kc[tt][1]), bq1, cc, 0, 0, 0);
#pragma unroll
      for (int r = 0; r < 4; ++r) {
        int ks = (c * 4 + tt) * 16 + 4 * g4 + r;
        float v = ks < nsel ? cc[r] : -3.0e38f;
        lg[tt][r] = v; cmax = fmaxf(cmax, v);
      }
    }
    cmax = fmaxf(cmax, __shfl_xor(cmax, 16)); cmax = fmaxf(cmax, __shfl_xor(cmax, 32));
    float mnew = fmaxf(mrun, cmax);
    float alpha = __expf((mrun - mnew) * DSA_SCALE);
    mrun = mnew;
    bf16x8 pa[2];
    float psum = 0.f;
#pragma unroll
    for (int s2 = 0; s2 < 2; ++s2) {
#pragma unroll
      for (int r = 0; r < 4; ++r) {
        float e0 = __expf((lg[2 * s2][r] - mnew) * DSA_SCALE);
        float e1 = __expf((lg[2 * s2 + 1][r] - mnew) * DSA_SCALE);
        psum += e0 + e1;
        pa[s2][r] = (short)f2bf(e0); pa[s2][4 + r] = (short)f2bf(e1);
      }
    }
    lrun = lrun * alpha + psum;
    float al[4];
#pragma unroll
    for (int r = 0; r < 4; ++r) al[r] = __shfl(alpha, r);
#pragma unroll
    for (int dt = 0; dt < 4; ++dt)
#pragma unroll
      for (int r = 0; r < 4; ++r) oacc[dt][r] *= al[r];
#pragma unroll
    for (int s2 = 0; s2 < 2; ++s2) {
      __builtin_amdgcn_wave_barrier();
#pragma unroll
      for (int it = 0; it < 2; ++it) {
        u32 a0, a1, a2, a3, b0, b1, b2, b3;
        fp8x4_to_bf16(vc[s2][it][0], a0, a1); fp8x4_to_bf16(vc[s2][it][1], a2, a3);
        fp8x4_to_bf16(vc[s2][it][2], b0, b1); fp8x4_to_bf16(vc[s2][it][3], b2, b3);
        u32x4 w0 = {a0, a1, a2, a3}, w1 = {b0, b1, b2, b3};
        u16* vd = vs + (it * 16 + (lane >> 2)) * 64 + (lane & 3) * 16;
        *(u32x4*)vd = w0; *(u32x4*)(vd + 8) = w1;
      }
      __builtin_amdgcn_fence(__ATOMIC_RELEASE, "wavefront");
      __builtin_amdgcn_wave_barrier();
      __builtin_amdgcn_fence(__ATOMIC_ACQUIRE, "wavefront");
#pragma unroll
      for (int dt = 0; dt < 4; ++dt) {
        int q = i16 >> 2, pq = i16 & 3;
        const u16* a0 = vs + (4 * g4 + q) * 64 + dt * 16 + 4 * pq;
        const u16* a1 = vs + (16 + 4 * g4 + q) * 64 + dt * 16 + 4 * pq;
        s16x4 lo = __builtin_bit_cast(s16x4, __builtin_amdgcn_ds_read_tr16_b64_v4i16((lds_v4p)(a0)));
        s16x4 hi = __builtin_bit_cast(s16x4, __builtin_amdgcn_ds_read_tr16_b64_v4i16((lds_v4p)(a1)));
        bf16x8 bv = {lo[0], lo[1], lo[2], lo[3], hi[0], hi[1], hi[2], hi[3]};
        oacc[dt] = __builtin_amdgcn_mfma_f32_16x16x32_bf16(pa[s2], bv, oacc[dt], 0, 0, 0);
      }
    }
#pragma unroll
    for (int tt = 0; tt < 4; ++tt) { kc[tt][0] = kn[tt][0]; kc[tt][1] = kn[tt][1]; }
#pragma unroll
    for (int s2 = 0; s2 < 2; ++s2) { vc[s2][0] = vn[s2][0]; vc[s2][1] = vn[s2][1]; }
  }
  float sum = lrun;
  sum += __shfl_xor(sum, 16); sum += __shfl_xor(sum, 32);
  float inv[4];
#pragma unroll
  for (int r = 0; r < 4; ++r) inv[r] = 1.f / __shfl(sum, r);
  if (lane < 16 && !dry) {
    size_t o = (size_t)m * NCOL;
#pragma unroll
    for (int r = 0; r < 4; ++r)
#pragma unroll
      for (int dt = 0; dt < 4; ++dt) {
        int col = (g * 4 + r) * 64 + dt * 16 + lane;
        float z = bf2f(p.P[o + C_DZ + col]);
        p.P[o + C_DQ + col] = f2bf(oacc[dt][r] * inv[r] * siluf_(z));
      }
  }
}

__device__ __forceinline__ void att_item(const Params& p, int m0, int g, int nsel, const u8* __restrict__ kv,
                                         u16* slw, u16* vs, bool dry) {
  const int lane = TIDX & 63, g4 = lane >> 4, i16 = lane & 15;
  const int npad = (nsel + 31) & ~31;
  const int nchunk = (npad + 63) >> 6;
  const u8* kbase = kv + g * 128 + g4 * 8;
  const u8* vbase = kv + g * 128 + 64 + (lane & 3) * 16;
  const bf16x8 zf = {0, 0, 0, 0, 0, 0, 0, 0};
  u32x2 selr = *(const u32x2*)(p.SEL + (size_t)m0 * 256 + 4 * lane);
  __builtin_amdgcn_wave_barrier();
  *(u32x2*)(slw + 4 * lane) = selr;
  __builtin_amdgcn_fence(__ATOMIC_RELEASE, "wavefront");
  __builtin_amdgcn_wave_barrier();
  __builtin_amdgcn_fence(__ATOMIC_ACQUIRE, "wavefront");
  selr = *(const u32x2*)(p.SEL + (size_t)(m0 + 1) * 256 + 4 * lane);
  bf16x8 bq0, bq1, bn0, bn1;
  {
    const u16* qp = p.P + (size_t)m0 * NCOL + C_DQ + (g * 4 + (i16 & 3)) * 64 + g4 * 8;
    bq0 = i16 < 4 ? *(const bf16x8*)(qp) : zf;
    bq1 = i16 < 4 ? *(const bf16x8*)(qp + 32) : zf;
    bn0 = bq0; bn1 = bq1;
  }
  u32x2 kc[4][2], kn[4][2];
  u32x4 vc[2][2], vn[2][2];
#pragma unroll
  for (int tt = 0; tt < 4; ++tt) {
    const u8* kp = kbase + (size_t)slw[tt * 16 + i16] * 512;
    kc[tt][0] = *(const u32x2*)kp; kc[tt][1] = *(const u32x2*)(kp + 32);
    kn[tt][0] = kc[tt][0]; kn[tt][1] = kc[tt][1];
  }
#pragma unroll
  for (int s2 = 0; s2 < 2; ++s2)
#pragma unroll
    for (int it = 0; it < 2; ++it) {
      vc[s2][it] = *(const u32x4*)(vbase + (size_t)slw[s2 * 32 + it * 16 + (lane >> 2)] * 512);
      vn[s2][it] = vc[s2][it];
    }
  float mrun = -3.0e38f, lrun = 0.f;
  f32x4 oacc[4];
#pragma unroll
  for (int dt = 0; dt < 4; ++dt) oacc[dt] = f32x4{0.f, 0.f, 0.f, 0.f};
  const int nt = 4 * nchunk;
  int u = 0, c = 0;
#pragma unroll 1
  for (int t = 0; t < nt; ++t) {
    const int m = m0 + u;
    if (c + 1 < nchunk) {
      const u16* slc = slw + (u & 1) * 256 + (c + 1) * 64;
#pragma unroll
      for (int s2 = 0; s2 < 2; ++s2)
#pragma unroll
        for (int it = 0; it < 2; ++it)
          vn[s2][it] = *(const u32x4*)(vbase + (size_t)slc[s2 * 32 + it * 16 + (lane >> 2)] * 512);
#pragma unroll
      for (int tt = 0; tt < 4; ++tt) {
        const u8* kp = kbase + (size_t)slc[tt * 16 + i16] * 512;
        kn[tt][0] = *(const u32x2*)kp; kn[tt][1] = *(const u32x2*)(kp + 32);
      }
    } else if (u + 1 < 4) {
      u16* sln = slw + ((u + 1) & 1) * 256;
      __builtin_amdgcn_wave_barrier();
      *(u32x2*)(sln + 4 * lane) = selr;
      __builtin_amdgcn_fence(__ATOMIC_RELEASE, "wavefront");
      __builtin_amdgcn_wave_barrier();
      __builtin_amdgcn_fence(__ATOMIC_ACQUIRE, "wavefront");
      if (u + 2 < 4) selr = *(const u32x2*)(p.SEL + (size_t)(m + 2) * 256 + 4 * lane);
#pragma unroll
      for (int s2 = 0; s2 < 2; ++s2)
#pragma unroll
        for (int it = 0; it < 2; ++it)
          vn[s2][it] = *(const u32x4*)(vbase + (size_t)sln[s2 * 32 + it * 16 + (lane >> 2)] * 512);
#pragma unroll
      for (int tt = 0; tt < 4; ++tt) {
        const u8* kp = kbase + (size_t)sln[tt * 16 + i16] * 512;
        kn[tt][0] = *(const u32x2*)kp; kn[tt][1] = *(const u32x2*)(kp + 32);
      }
      const u16* qp = p.P + (size_t)(m + 1) * NCOL + C_DQ + (g * 4 + (i16 & 3)) * 64 + g4 * 8;
      bn0 = i16 < 4 ? *(const bf16x8*)(qp) : zf;
      bn1 = i16 < 4 ? *(const bf16x8*)(qp + 32) : zf;
    }
    __builtin_amdgcn_sched_barrier(0);
    f32x4 lg[4];
    float cmax = -3.0e38f;
#pragma unroll
    for (int tt = 0; tt < 4; ++tt) {
      f32x4 cc = {0.f, 0.f, 0.f, 0.f};
      cc = __builtin_amdgcn_mfma_f32_16x16x32_bf16(fp8x8_to_bf16x8(kc[tt][0]), bq0, cc, 0, 0, 0);
      cc = __builtin_amdgcn_mfma_f32_16x16x32_bf16(fp8x8_to_bf16x8(kc[tt][1]), bq1, cc, 0, 0, 0);
#pragma unroll
      for (int r = 0; r < 4; ++r) {
        int ks = (c * 4 + tt) * 16 + 4 * g4 + r;
        float v = ks < nsel ? cc[r] : -3.0e38f;
        lg[tt][r] = v; cmax = fmaxf(cmax, v);
      }
    }
    cmax = fmaxf(cmax, __shfl_xor(cmax, 16)); cmax = fmaxf(cmax, __shfl_xor(cmax, 32));
    float mnew = fmaxf(mrun, cmax);
    float alpha = __expf((mrun - mnew) * DSA_SCALE);
    mrun = mnew;
    bf16x8 pa[2];
    float psum = 0.f;
#pragma unroll
    for (int s2 = 0; s2 < 2; ++s2) {
#pragma unroll
      for (int r = 0; r < 4; ++r) {
        float e0 = __expf((lg[2 * s2][r] - mnew) * DSA_SCALE);
        float e1 = __expf((lg[2 * s2 + 1][r] - mnew) * DSA_SCALE);
        psum += e0 + e1;
        pa[s2][r] = (short)f2bf(e0); pa[s2][4 + r] = (short)f2bf(e1);
      }
    }
    lrun = lrun * alpha + psum;
    float al[4];
#pragma unroll
    for (int r = 0; r < 4; ++r) al[r] = __shfl(alpha, r);
#pragma unroll
    for (int dt = 0; dt < 4; ++dt)
#pragma unroll
      for (int r = 0; r < 4; ++r) oacc[dt][r] *= al[r];
#pragma unroll
    for (int s2 = 0; s2 < 2; ++s2) {
      __builtin_amdgcn_wave_barrier();
#pragma unroll
      for (int it = 0; it < 2; ++it) {
        u32 a0, a1, a2, a3, b0, b1, b2, b3;
        fp8x4_to_bf16(vc[s2][it][0], a0, a1); fp8x4_to_bf16(vc[s2][it][1], a2, a3);
        fp8x4_to_bf16(vc[s2][it][2], b0, b1); fp8x4_to_bf16(vc[s2][it][3], b2, b3);
        u32x4 w0 = {a0, a1, a2, a3}, w1 = {b0, b1, b2, b3};
        u16* vd = vs + (it * 16 + (lane >> 2)) * 64 + (lane & 3) * 16;
        *(u32x4*)vd = w0; *(u32x4*)(vd + 8) = w1;
      }
      __builtin_amdgcn_fence(__ATOMIC_RELEASE, "wavefront");
      __builtin_amdgcn_wave_barrier();
      __builtin_amdgcn_fence(__ATOMIC_ACQUIRE, "wavefront");
#pragma unroll
      for (int dt = 0; dt < 4; ++dt) {
        int q = i16 >> 2, pq = i16 & 3;
        const u16* a0 = vs + (4 * g4 + q) * 64 + dt * 16 + 4 * pq;
        const u16* a1 = vs + (16 + 4 * g4 + q) * 64 + dt * 16 + 4 * pq;
        s16x4 lo = __builtin_bit_cast(s16x4, __builtin_amdgcn_ds_read_tr16_b64_v4i16((lds_v4p)(a0)));
        s16x4 hi = __builtin_bit_cast(s16x4, __builtin_amdgcn_ds_read_tr16_b64_v4i16((lds_v4p)(a1)));
        bf16x8 bv = {lo[0], lo[1], lo[2], lo[3], hi[0], hi[1], hi[2], hi[3]};
        oacc[dt] = __builtin_amdgcn_mfma_f32_16x16x32_bf16(pa[s2], bv, oacc[dt], 0, 0, 0);
      }
    }
#pragma unroll
    for (int tt = 0; tt < 4; ++tt) { kc[tt][0] = kn[tt][0]; kc[tt][1] = kn[tt][1]; }
#pragma unroll
    for (int s2 = 0; s2 < 2; ++s2) { vc[s2][0] = vn[s2][0]; vc[s2][1] = vn[s2][1]; }
    if (c == nchunk - 1) {
      float sum = lrun;
      sum += __shfl_xor(sum, 16); sum += __shfl_xor(sum, 32);
      float inv[4];
#pragma unroll
      for (int r = 0; r < 4; ++r) inv[r] = 1.f / __shfl(sum, r);
      __builtin_amdgcn_wave_barrier();
      if (lane < 16) {
#pragma unroll
        for (int r = 0; r < 4; ++r)
#pragma unroll
          for (int dt = 0; dt < 4; ++dt) vs[r * 64 + dt * 16 + lane] = f2bf(oacc[dt][r] * inv[r]);
      }
      __builtin_amdgcn_fence(__ATOMIC_RELEASE, "wavefront");
      __builtin_amdgcn_wave_barrier();
      __builtin_amdgcn_fence(__ATOMIC_ACQUIRE, "wavefront");
      if (lane < 32 && !dry) {
        size_t o = (size_t)m * NCOL + g * 256 + lane * 8;
        u32x4 ov = *(const u32x4*)(vs + lane * 8);
        u32x4 zv = *(const u32x4*)(p.P + o + C_DZ);
        u32x4 rv;
#pragma unroll
        for (int k = 0; k < 4; ++k) {
          float o0 = bf2f((u16)(ov[k] & 0xffff)), o1 = bf2f((u16)(ov[k] >> 16));
          float z0 = bf2f((u16)(zv[k] & 0xffff)), z1 = bf2f((u16)(zv[k] >> 16));
          rv[k] = pack2(o0 * siluf_(z0), o1 * siluf_(z1));
        }
        *(u32x4*)(p.P + o + C_DQ) = rv;
      }
      __builtin_amdgcn_wave_barrier();

      mrun = -3.0e38f; lrun = 0.f;
#pragma unroll
      for (int dt = 0; dt < 4; ++dt) oacc[dt] = f32x4{0.f, 0.f, 0.f, 0.f};
      bq0 = bn0; bq1 = bn1;
      c = 0; ++u;
    } else ++c;
  }
}

__device__ __forceinline__ void phase_att(const Params& p, int pass, char* lds, bool dry, unsigned xcc) {
  const int tid = TIDX, lane = tid & 63, w = tid >> 6;
  u16* sl = (u16*)lds + w * 512;
  u16* vs = (u16*)(lds + 4096) + w * (32 * 64);
  int* item = (int*)(lds + 4096 + 4 * 4096);
  const int ngroups = 1024 + (pass == 1 ? 32 : 0);
  unsigned* ctr = p.bar + XCD_BAR_WORDS + (dry ? 16 : 0) + pass * 4;
  int gsel = (int)(xcc & 3u);
  int tries = 0;
  while (tries < 4) {
    __syncthreads();
    if (tid == 0) *item = (int)atomicAdd(&ctr[gsel], 1u);
    __syncthreads();
    int it = *item;
    if (it >= ngroups) { gsel = (gsel + 1) & 3; ++tries; continue; }
    int row0, nsel; const u8* kv;
    if (it < 1024) {
      int c = it >> 2;
      row0 = 16 + 16 * it; int n = 80 + 64 * c; nsel = n < 256 ? n : 256;
      kv = p.KV8P;
    } else {
      int sb = it - 1024;
      row0 = SEQP + 16 * sb; nsel = 256;
      kv = p.KV8S + (size_t)sb * NKEYS_S * 512;
    }
    att_item(p, row0 + 4 * w, gsel, nsel, kv, sl, vs, dry);
  }
}

__device__ __forceinline__ void phase_dsa(const Params& p, int pass, char* lds, bool dry) {
  int ntiles = 512 + (pass == 1 ? 32 : 0);
  for (int t = blockIdx.x; t < ntiles; t += gridDim.x) {
    DTile T;
    if (t < 512) {
      int c = t >> 2, qq = t & 3;
      int chh = 255 - c, cl = c;
      T.qrow0 = 16 + 64 * chh + 16 * qq; T.nkeys0 = 80 + 64 * chh;
      T.qrow1 = 16 + 64 * cl + 16 * qq;  T.nkeys1 = 80 + 64 * cl;
      T.ki = p.KI; T.ki_stride = 64;
      T.kv = nullptr; T.kv_stride = 0;
    } else {
      int sb = t - 512;
      T.qrow0 = SEQP + 16 * sb; T.nkeys0 = NKEYS_S;
      T.qrow1 = SEQP + 16 * sb; T.nkeys1 = 0;
      T.ki = p.KIS + (size_t)sb * NKEYS_S * 64; T.ki_stride = 64;
      T.kv = nullptr; T.kv_stride = 0;
    }
    dsa_tile(p, T, lds, dry);
  }
}

template <int BR>
__device__ __forceinline__ void merge_half(const Params& p, int R, int m0, int n0, char* ldsc, bool dry) {
  const int tid = TIDX, lane = tid & 63, w = tid >> 6, wm = w >> 1, wn = w & 1;
  u16* lds = (u16*)ldsc;
  f32x16 acc[2][2];
#pragma unroll
  for (int i = 0; i < 2; ++i)
#pragma unroll
    for (int j = 0; j < 2; ++j)
#pragma unroll
      for (int r = 0; r < 16; ++r) acc[i][j][r] = 0.f;
  gemm_core(p.P + (BR == 0 ? C_GV : C_DQ), NCOL, m0, R, BR == 0 ? p.WglaT : p.WdsaT, DM, n0, DM, acc, lds);
#pragma unroll
  for (int tm = 0; tm < 2; ++tm)
#pragma unroll
    for (int tn = 0; tn < 2; ++tn)
#pragma unroll
      for (int r = 0; r < 16; ++r)
        lds[ACC_ROW(wm, tm, r, lane) * ES + ACC_COL(wn, tn, lane)] = f2bf(acc[tm][tn][r]);
  __syncthreads();
  const int ch = tid & 15;
  float gb[8];
#pragma unroll
  for (int k = 0; k < 8; ++k) gb[k] = p.gate_b[(BR == 0 ? 0 : DM) + n0 + ch * 8 + k];
#pragma unroll
  for (int i = 0; i < 8; ++i) {
    int row = (tid >> 4) + 16 * i;
    if (m0 + row < R && !dry) {
      size_t o = (size_t)(m0 + row) * NCOL + n0 + ch * 8;
      uint4 yv = *(const uint4*)(lds + row * ES + ch * 8);
      uint4 mv = *(const uint4*)(p.P + o + (BR == 0 ? C_MA : C_MB));
      uint4 pv = make_uint4(0, 0, 0, 0);
      if (BR == 1) pv = *(const uint4*)(p.P + o + C_MA);
      u32 yw[4] = {yv.x, yv.y, yv.z, yv.w}, mw[4] = {mv.x, mv.y, mv.z, mv.w}, pw[4] = {pv.x, pv.y, pv.z, pv.w}, ow[4];
#pragma unroll
      for (int k = 0; k < 4; ++k) {
        float y0 = bf2f((u16)(yw[k] & 0xffff)), y1 = bf2f((u16)(yw[k] >> 16));
        float g0 = sigmoidf_(bf2f((u16)(mw[k] & 0xffff)) + gb[2 * k]), g1 = sigmoidf_(bf2f((u16)(mw[k] >> 16)) + gb[2 * k + 1]);
        float r0 = g0 * y0, r1 = g1 * y1;
        if (BR == 1) { r0 += bf2f((u16)(pw[k] & 0xffff)); r1 += bf2f((u16)(pw[k] >> 16)); }
        ow[k] = pack2(r0, r1);
      }
      *(uint4*)(p.P + o + C_MA) = make_uint4(ow[0], ow[1], ow[2], ow[3]);
    }
  }
  __syncthreads();
}
__device__ __forceinline__ void phase_merge(const Params& p, int pass, char* lds, bool dry) {
  int R = pass_rows(pass);
  int mt = (R + 127) >> 7;
  unsigned* ctr = p.bar + XCD_BAR_WORDS + 72 + (dry ? 8 : 0) + pass;
  for (int t = dq_next(ctr, lds); t < mt * 8; t = dq_next(ctr, lds)) {
    int tn_ = t & 7, tm_ = t >> 3;
    int m0 = tm_ * 128, n0 = tn_ * 128;
    merge_half<0>(p, R, m0, n0, lds, dry);
    merge_half<1>(p, R, m0, n0, lds, dry);
  }
}

__device__ __forceinline__ void phase_out(const Params& p, int pass, char* lds) {
  int R = pass_rows(pass), r0 = pass_row0(pass);
  int mt = (R + 127) >> 7;
  int lane = TIDX & 63, w = TIDX >> 6, wm = w >> 1, wn = w & 1;
  unsigned* ctr = p.bar + XCD_BAR_WORDS + 88 + pass;
  for (int t = dq_next(ctr, lds); t < mt * 8; t = dq_next(ctr, lds)) {
    int tn_ = t & 7, tm_ = t >> 3;
    int m0 = tm_ * 128, n0 = tn_ * 128;
    f32x16 acc[2][2];
#pragma unroll
    for (int i = 0; i < 2; ++i)
#pragma unroll
      for (int j = 0; j < 2; ++j)
#pragma unroll
        for (int r = 0; r < 16; ++r) acc[i][j][r] = 0.f;
    gemm_core(p.P + C_MA, NCOL, m0, R, p.WoutT, DM, n0, DM, acc, (u16*)lds);
#pragma unroll
    for (int tm = 0; tm < 2; ++tm)
#pragma unroll
      for (int r = 0; r < 16; ++r) {
        int m = m0 + ACC_ROW(wm, tm, r, lane);
        if (m < R) {
          int gr = r0 + m;
          float* y = yrow_ptr(p, gr);
          if (y) {
            const float* x = xrow_ptr(p, gr);
            float mu = p.STATS[gr * 2], rstd = p.STATS[gr * 2 + 1];
#pragma unroll
            for (int tn = 0; tn < 2; ++tn) {
              int n = n0 + ACC_COL(wn, tn, lane);
              float hh = (x[n] - mu) * rstd * p.ln_in_g[n] + p.ln_in_b[n];
              y[n] = ALPHA_F * hh + acc[tm][tn][r];
            }
          }
        }
      }
  }
}

__device__ __forceinline__ void phase_ln_out(const Params& p, int pass, bool dry) {
  int R = pass_rows(pass), r0 = pass_row0(pass);
  int wave = TIDX >> 6, lane = TIDX & 63;
  for (int m = blockIdx.x * 4 + wave; m < R; m += gridDim.x * 4) {
    float* y = yrow_ptr(p, r0 + m);
    if (!y) continue;
    float4 v[4];
    float s = 0.f;
#pragma unroll
    for (int i = 0; i < 4; ++i) { v[i] = *(const float4*)(y + i * 256 + lane * 4); s += v[i].x + v[i].y + v[i].z + v[i].w; }
    float mu = wave_sum(s) * (1.f / DM);
    float q = 0.f;
#pragma unroll
    for (int i = 0; i < 4; ++i) {
      float a = v[i].x - mu, b = v[i].y - mu, c = v[i].z - mu, d = v[i].w - mu;
      q += a * a + b * b + c * c + d * d;
    }
    float rstd = rsqrtf(wave_sum(q) * (1.f / DM) + NORM_EPS);
#pragma unroll
    for (int i = 0; i < 4; ++i) {
      int c = i * 256 + lane * 4;
      float4 g = *(const float4*)(p.ln_g + c), b = *(const float4*)(p.ln_b + c);
      float4 o;
      o.x = (v[i].x - mu) * rstd * g.x + b.x; o.y = (v[i].y - mu) * rstd * g.y + b.y;
      o.z = (v[i].z - mu) * rstd * g.z + b.z; o.w = (v[i].w - mu) * rstd * g.w + b.w;
      if (!dry) *(float4*)(y + c) = o;
    }
  }
}

#define LDS_BYTES 77824
#define NPHASE 9
#ifndef PHASE_MASK
#define PHASE_MASK 0x7ff
#endif
#define EN(x) (((PHASE_MASK) >> (x)) & 1)
__device__ __forceinline__ void run_phase(const Params& p, int pass, int ph, char* lds, bool dry = false, unsigned xcc = 0) {
  switch (ph) {
    case 0: if (EN(0)) { if (pass == 0) phase_prep(p, lds); phase_ln_in(p, pass); } break;
    case 1: if (EN(1)) phase_gemm1(p, pass, lds, xcc); break;
    case 2: if (EN(2)) phase_tok(p, pass, lds, dry); break;
    case 3: if (EN(3)) phase_u(p, pass, lds); break;
    case 4: if (EN(4)) phase_scan(p, pass, dry); break;
    case 5: if (EN(5)) phase_dsa(p, pass, lds, dry); break;
    case 9: if (EN(9)) phase_o(p, pass, lds, dry); break;
    case 10: if (EN(10)) phase_att(p, pass, lds, dry, xcc); break;
    case 6: if (EN(6)) phase_merge(p, pass, lds, dry); break;
    case 7: if (EN(7)) phase_out(p, pass, lds); break;
    case 8: if (EN(8)) phase_ln_out(p, pass, dry); break;
  }
}

#if ONE_LAUNCH
#ifndef PROBE_BAR2
#define PROBE_BAR2 0
#endif
#define XBAR do { xcd_barrier(xb); if (PROBE_BAR2) xcd_barrier(xb); } while (0)
#ifndef PROBE_REP
#define PROBE_REP 0
#endif
#define RUNP(ph) do { if ((PROBE_REP >> (ph)) & 1) run_phase(p, pass, ph, lds, true, xb.x); run_phase(p, pass, ph, lds, false, xb.x); } while (0)
__global__ void __launch_bounds__(256, 2) fwd_kernel(Params p) {
  __shared__ __attribute__((aligned(16))) char lds[LDS_BYTES];
  __shared__ uint4 xb_words;
  cg::grid_group grid = cg::this_grid();
  if (threadIdx.x == 0) xb_words = make_uint4(0u, 0u, 0u, 0u);
  __syncthreads();
  XcdBarrier xb = xcd_barrier_post(p.bar, (volatile LAS unsigned*)&xb_words);
#pragma unroll 1
  for (int pass = 0; pass < 2; ++pass) {
    RUNP(0);
    if (pass == 0) grid.sync(); else XBAR;
    RUNP(1); XBAR;
    RUNP(2); XBAR;
    RUNP(3); XBAR;
    RUNP(4); XBAR;
    RUNP(5);
    RUNP(9); XBAR;
    RUNP(10); XBAR;
    RUNP(6); XBAR;
    RUNP(7); XBAR;
    RUNP(8);
  }
}
#else
template <int PH>
__global__ void __launch_bounds__(256, 2) phase_kernel(Params p, int pass) {
  __shared__ __attribute__((aligned(16))) char lds[LDS_BYTES];
  run_phase(p, pass, PH, lds, false, xb_xcc_id());
}
#endif

static inline size_t align_up(size_t x) { return (x + 255) & ~(size_t)255; }

extern "C" void kernel_launch(void* const* d_in, const int* in_sizes, int n_in, void* d_out, int out_size,
                              void* d_ws, size_t ws_size, hipStream_t stream) {
  Params p{};
  const float* const* in = (const float* const*)d_in;
  p.x_prompt = in[0]; p.x_sample = in[1]; p.cache_k = in[2]; p.cache_v = in[3]; p.cache_idx_k = in[4];
  p.state_gla = in[5]; p.meta = in[6]; p.ln_in_g = in[7]; p.ln_in_b = in[8]; p.w_in = in[9]; p.gla_w2 = in[10];
  p.gla_gate_b = in[11]; p.gla_norm_g = in[12]; p.idx_kn_g = in[13]; p.idx_kn_b = in[14]; p.w_gla = in[15];
  p.w_dsa = in[16]; p.gate_b = in[17]; p.w_out = in[18]; p.ln_g = in[19]; p.ln_b = in[20];
  float* o = (float*)d_out;
  p.y_prompt = o; o += (size_t)2 * 16384 * 1024;
  p.y_sample = o; o += (size_t)32 * 16 * 1024;
  p.k_prompt = o; o += (size_t)2 * SEQP * 256;
  p.v_prompt = o; o += (size_t)2 * SEQP * 256;
  p.idx_k_prompt = o; o += (size_t)2 * SEQP * 64;
  p.gla_prompt = o; o += (size_t)2 * 131072;
  p.k_sample = o; o += (size_t)512 * 256;
  p.v_sample = o; o += (size_t)512 * 256;
  p.idx_k_sample = o; o += (size_t)512 * 64;
  p.gla_sample = o; o += (size_t)32 * 131072;
  char* wsp = (char*)d_ws;
  size_t off = 0;
  auto take = [&](size_t bytes) { char* r = wsp + off; off = align_up(off + bytes); return r; };
  p.WinT = (u16*)take((size_t)NCOL * DM * 2);
  p.WglaT = (u16*)take((size_t)DM * DM * 2);
  p.WdsaT = (u16*)take((size_t)DM * DM * 2);
  p.WoutT = (u16*)take((size_t)DM * DM * 2);
  p.H = (u16*)take((size_t)RPMAX * DM * 2);
  p.P = (u16*)take((size_t)(RPMAX + 8) * NCOL * 2);
  p.KI = (u16*)take((size_t)RPMAX * 64 * 2);
  p.US = (u16*)take((size_t)289 * 131072 * 2);
  p.KV8S = (u8*)take((size_t)32 * NKEYS_S * 512);
  p.KV8P = (u8*)take((size_t)SEQP * 512);
  p.KIS = (u16*)take((size_t)32 * NKEYS_S * 64 * 2);
  p.SEL = (u16*)take((size_t)RPMAX * 256 * 2);
  p.STATS = (float*)take((size_t)NROWS * 2 * 4);
  p.PS = (float*)take((size_t)RPMAX * 128 * 4);
  p.DEC = (float*)take((size_t)289 * 512 * 4);
  p.bar = (unsigned*)take((size_t)(XCD_BAR_WORDS + 128) * 4);
  if (off > ws_size) { fprintf(stderr, "workspace too small: need %zu have %zu\n", off, ws_size); return; }
#if ONE_LAUNCH
  static int grid_blocks = 0;
  if (!grid_blocks) {
    int dev = 0, cus = 0, per_cu = 0;
    hipGetDevice(&dev);
    hipDeviceGetAttribute(&cus, hipDeviceAttributeMultiprocessorCount, dev);
    hipOccupancyMaxActiveBlocksPerMultiprocessor(&per_cu, fwd_kernel, 256, 0);
    per_cu = 2;
    grid_blocks = cus * per_cu;
  }
  (void)hipMemsetAsync(p.bar, 0, (size_t)(XCD_BAR_WORDS + 128) * 4, stream);
  void* args[] = {&p};
  hipError_t e = hipLaunchCooperativeKernel((void*)fwd_kernel, dim3(grid_blocks), dim3(256), args, 0, stream);
  if (e != hipSuccess) fprintf(stderr, "cooperative launch failed: %s (grid %d)\n", hipGetErrorString(e), grid_blocks);
#else
  (void)hipMemsetAsync(p.bar, 0, (size_t)(XCD_BAR_WORDS + 128) * 4, stream);
  for (int pass = 0; pass < 2; ++pass) {
    phase_kernel<0><<<512, 256, 0, stream>>>(p, pass);
    phase_kernel<1><<<512, 256, 0, stream>>>(p, pass);
    phase_kernel<2><<<512, 256, 0, stream>>>(p, pass);
    phase_kernel<3><<<512, 256, 0, stream>>>(p, pass);
    phase_kernel<4><<<512, 256, 0, stream>>>(p, pass);
    phase_kernel<5><<<512, 256, 0, stream>>>(p, pass);
    phase_kernel<10><<<512, 256, 0, stream>>>(p, pass);
    phase_kernel<9><<<512, 256, 0, stream>>>(p, pass);
    phase_kernel<6><<<512, 256, 0, stream>>>(p, pass);
    phase_kernel<7><<<512, 256, 0, stream>>>(p, pass);
    phase_kernel<8><<<512, 256, 0, stream>>>(p, pass);
  }
#endif
}
```

```cpp
#include <hip/hip_runtime.h>
#include <hip/hip_bf16.h>
#include <hip/hip_cooperative_groups.h>
#include <stdint.h>
#include <stdio.h>
namespace cg = cooperative_groups;

typedef unsigned short u16;
typedef unsigned char u8;
typedef uint32_t u32;
typedef __attribute__((ext_vector_type(8))) short bf16x8;
typedef __attribute__((ext_vector_type(4))) short s16x4;
typedef __attribute__((ext_vector_type(4))) float f32x4;
typedef __attribute__((ext_vector_type(16))) float f32x16;
typedef short v4i16_t __attribute__((ext_vector_type(4)));
typedef __attribute__((ext_vector_type(4))) unsigned int u32x4;
typedef __attribute__((address_space(3))) v4i16_t* lds_v4p;

#ifndef ONE_LAUNCH
#define ONE_LAUNCH 1
#endif

#define DM 1024
#define SEQP 16400
#define NPROMPT_ROWS 32800
#define NROWS 33312
#define RPMAX 16912
#define NCOL 8320
#define C_GQ 0
#define C_GK 512
#define C_GV 1024
#define C_GR 2048
#define C_DQ 3072
#define C_DK 4096
#define C_DV 4352
#define C_IQ 4608
#define C_DZ 5120
#define C_MA 6144
#define C_MB 7168
#define C_SM 8192
#define NKEYS_S 2064
#define CAP 576
#define CLIMIT 544
#define CVN 9
#define NORM_EPS 1e-5f
#define ALPHA_F 1.189207115002721f
#define IDX_W_SCALE 0.04419417382415922f
#define GLA_QSCALE 0.08838834764831845f
#define DSA_SCALE 0.125f

struct Params {
  const float *x_prompt, *x_sample, *cache_k, *cache_v, *cache_idx_k, *state_gla, *meta, *ln_in_g, *ln_in_b,
      *w_in, *gla_w2, *gla_gate_b, *gla_norm_g, *idx_kn_g, *idx_kn_b, *w_gla, *w_dsa, *gate_b, *w_out, *ln_g, *ln_b;
  float *y_prompt, *y_sample, *k_prompt, *v_prompt, *idx_k_prompt, *gla_prompt, *k_sample, *v_sample, *idx_k_sample, *gla_sample;
  u16 *WinT, *WglaT, *WdsaT, *WoutT, *H, *P, *KI, *US, *KIS, *SEL;
  u8 *KV8S, *KV8P;
  float *STATS, *PS, *DEC;
  unsigned* bar;
};

#define XB_TMO      128
#define XB_XCNT(j)  (256  + 64 * (j))
#define XB_XSUB(j)  (1280 + 64 * (j))
#define XB_XGEN(j)  (2304 + 64 * (j))
#define XB_TOP      3328
#define XB_TOPGEN   3392
#define XCD_BAR_WORDS 3456
#define XB_SPIN_CAP (1u << 22)
#define LAS __attribute__((address_space(3)))
__device__ __forceinline__ unsigned xb_ld(unsigned* p)              { return __hip_atomic_load(p, __ATOMIC_RELAXED, __HIP_MEMORY_SCOPE_AGENT); }
__device__ __forceinline__ unsigned xb_add(unsigned* p, unsigned v) { return __hip_atomic_fetch_add(p, v, __ATOMIC_RELAXED, __HIP_MEMORY_SCOPE_AGENT); }
__device__ __forceinline__ unsigned xb_xcc_id() { return (unsigned)__builtin_amdgcn_s_getreg((3 << 11) | 20) & 0xFu; }
#define XB_SPIN(cond, bar) do { unsigned _sp = 0; while (cond) { __builtin_amdgcn_s_sleep(1); \
    if ((++_sp & 255u) == 0u) { if (xb_ld(&(bar)[XB_TMO])) break; if (_sp > XB_SPIN_CAP) { atomicAdd(&(bar)[XB_TMO], 1u); break; } } } } while (0)
struct XcdBarrier { unsigned* bar; unsigned x; volatile LAS unsigned* st; };
__device__ __forceinline__ XcdBarrier xcd_barrier_post(unsigned* bar, volatile LAS unsigned* st) {
    XcdBarrier b; b.bar = bar; b.x = xb_xcc_id(); b.st = st;
    if (threadIdx.x == 0) (void)xb_add(&bar[XB_XCNT(b.x)], 1u);
    return b;
}
__device__ __forceinline__ void xcd_barrier_complete(unsigned* bar, unsigned x, unsigned& nloc, unsigned& nx) {
    const unsigned G = gridDim.x * gridDim.y * gridDim.z;
    unsigned sum, cnt, mine, sp = 0u;
    for (;;) {
        sum = 0u; cnt = 0u; mine = 0u;
#pragma unroll
        for (unsigned j = 0; j < 16; ++j) { const unsigned c = xb_ld(&bar[XB_XCNT(j)]); sum += c; cnt += (c > 0u) ? 1u : 0u; mine = (j == x) ? c : mine; }
        if (sum == G) break;
        __builtin_amdgcn_s_sleep(1);
        if ((++sp & 255u) == 0u) { if (xb_ld(&bar[XB_TMO])) break; if (sp > XB_SPIN_CAP) { atomicAdd(&bar[XB_TMO], 1u); break; } }
    }
    nloc = mine > 0u ? mine : 1u; nx = cnt > 0u ? cnt : 1u;
}
__device__ __forceinline__ void xcd_barrier(const XcdBarrier& b) {
    asm volatile("s_waitcnt vmcnt(0)" ::: "memory");
    __syncthreads();
    if (threadIdx.x == 0) {
        unsigned* bar = b.bar;
        __builtin_amdgcn_s_waitcnt(0);
        unsigned nloc = b.st[0], nx = b.st[1];
        if (nloc == 0u) { xcd_barrier_complete(bar, b.x, nloc, nx); b.st[0] = nloc; b.st[1] = nx; }
        const unsigned old = xb_add(&bar[XB_XSUB(b.x)], 1u);
        const unsigned gen = old / nloc;
        if (old + 1u == (gen + 1u) * nloc) {
            __builtin_amdgcn_fence(__ATOMIC_RELEASE, "agent");
            asm volatile("s_waitcnt vmcnt(0)" ::: "memory");
            const unsigned og = xb_add(&bar[XB_TOP], 1u);
            const unsigned tg = og / nx;
            if (og + 1u == (tg + 1u) * nx) xb_add(&bar[XB_TOPGEN], 1u);
            else XB_SPIN(xb_ld(&bar[XB_TOPGEN]) == tg, bar);
            __builtin_amdgcn_fence(__ATOMIC_ACQUIRE, "agent");
            xb_add(&bar[XB_XGEN(b.x)], 1u);
            asm volatile("s_waitcnt vmcnt(0)" ::: "memory");
        } else {
            XB_SPIN(xb_ld(&bar[XB_XGEN(b.x)]) == gen, bar);
            __builtin_amdgcn_fence(__ATOMIC_ACQUIRE, "agent");
            asm volatile("s_waitcnt vmcnt(0)" ::: "memory");
        }
    }
    __syncthreads();
}

__device__ __forceinline__ int tid_opaque() { int t = threadIdx.x; asm volatile("" : "+v"(t)); return t; }
#define TIDX tid_opaque()
__device__ __forceinline__ u16 f2bf(float f) {
  u32 u = __float_as_uint(f);
  u += 0x7fffu + ((u >> 16) & 1u);
  return (u16)(u >> 16);
}
__device__ __forceinline__ float bf2f(u16 h) { return __uint_as_float(((u32)h) << 16); }
__device__ __forceinline__ u32 pack2(float a, float b) { return (u32)f2bf(a) | ((u32)f2bf(b) << 16); }
__device__ __forceinline__ float relu1(float x) { float r; asm("v_max_f32 %0, 0, %1" : "=v"(r) : "v"(x)); return r; }
__device__ __forceinline__ u32 cvt_pk_bf16(float lo, float hi) { u32 r; asm("v_cvt_pk_bf16_f32 %0, %1, %2" : "=v"(r) : "v"(lo), "v"(hi)); return r; }
__device__ __forceinline__ u32 pk4_fp8(float a, float b, float c, float d) {
  int r = __builtin_amdgcn_cvt_pk_fp8_f32(a, b, 0, false);
  r = __builtin_amdgcn_cvt_pk_fp8_f32(c, d, r, true);
  return (u32)r;
}
__device__ __forceinline__ void fp8x4_to_bf16(u32 x, u32& lo, u32& hi) {
  auto a = __builtin_amdgcn_cvt_pk_f32_fp8((int)x, false);
  auto b = __builtin_amdgcn_cvt_pk_f32_fp8((int)x, true);
  lo = cvt_pk_bf16(a[0], a[1]); hi = cvt_pk_bf16(b[0], b[1]);
}
__device__ __forceinline__ float sigmoidf_(float x) { return 1.f / (1.f + __expf(-x)); }
__device__ __forceinline__ float siluf_(float x) { return x / (1.f + __expf(-x)); }

__device__ __forceinline__ float wave_sum(float v) {
#pragma unroll
  for (int o = 32; o > 0; o >>= 1) v += __shfl_xor(v, o);
  return v;
}

__device__ __forceinline__ const float* xrow_ptr(const Params& p, int gr) {
  if (gr < NPROMPT_ROWS) {
    int b = gr / SEQP, pos = gr - b * SEQP;
    return pos < 16 ? p.meta + pos * DM : p.x_prompt + ((size_t)b * 16384 + (pos - 16)) * DM;
  }
  return p.x_sample + (size_t)(gr - NPROMPT_ROWS) * DM;
}
__device__ __forceinline__ float* yrow_ptr(const Params& p, int gr) {
  if (gr < NPROMPT_ROWS) {
    int b = gr / SEQP, pos = gr - b * SEQP;
    return pos < 16 ? nullptr : p.y_prompt + ((size_t)b * 16384 + (pos - 16)) * DM;
  }
  return p.y_sample + (size_t)(gr - NPROMPT_ROWS) * DM;
}

__device__ __forceinline__ int src_col(int n) {
  if (n < 2048) return n;
  if (n < 3072) return n - 2048 + 2064;
  if (n < 4096) return n - 3072 + 3088;
  if (n < 4352) return n - 4096 + 4112;
  if (n < 4608) return n - 4352 + 4368;
  if (n < 5120) return n - 4608 + 4624;
  if (n < 6144) return n - 5120 + 5208;
  if (n < 7168) return n - 6144 + 6232;
  if (n < 8192) return n - 7168 + 7256;
  if (n < 8256) return n - 8192 + 5136;
  if (n < 8272) return n - 8256 + 2048;
  if (n < 8280) return n - 8272 + 5200;
  return -1;
}

__device__ __forceinline__ int pass_row0(int pass) { return pass == 0 ? 0 : SEQP; }
__device__ __forceinline__ int pass_rows(int pass) { return pass == 0 ? SEQP : RPMAX; }
__device__ __forceinline__ int pass_nblk(int pass) { return pass == 0 ? 257 : 289; }
__device__ __forceinline__ void blk_info(int blk, int& row0, int& len) {
  if (blk < 257) { row0 = blk * 64; len = (blk == 256) ? 16 : 64; }
  else { row0 = SEQP + 16 * (blk - 257); len = 16; }
}

__device__ __forceinline__ int dq_next(unsigned* ctr, char* lds) {
  int* item = (int*)(lds + 77808);
  __syncthreads();
  if (TIDX == 0) *item = (int)atomicAdd(ctr, 1u);
  __syncthreads();
  return *item;
}

__device__ __forceinline__ void transpose_tile(const float* __restrict__ src, int nsrc, u16* __restrict__ dst, int k0, int n0, bool map, float* tile) {
  int tx = TIDX & 63, ty = TIDX >> 6;
  int sc = map ? src_col(n0 + tx) : (n0 + tx);
  for (int kk = ty; kk < 64; kk += 4) tile[kk * 65 + tx] = sc >= 0 ? src[(size_t)(k0 + kk) * nsrc + sc] : 0.f;
  __syncthreads();
  for (int nn = ty; nn < 64; nn += 4) dst[(size_t)(n0 + nn) * DM + k0 + tx] = f2bf(tile[tx * 65 + nn]);
  __syncthreads();
}

__device__ __forceinline__ void phase_prep(const Params& p, char* lds) {
  float* tile = (float*)lds;
  const int nt_in = 130 * 16;
  const int nt_all = nt_in + 3 * 256;
  for (int t = blockIdx.x; t < nt_all; t += gridDim.x) {
    if (t < nt_in) {
      transpose_tile(p.w_in, 8280, p.WinT, (t & 15) * 64, (t >> 4) * 64, true, tile);
    } else {
      int u = t - nt_in, w = u >> 8, r = u & 255;
      const float* s = w == 0 ? p.w_gla : (w == 1 ? p.w_dsa : p.w_out);
      u16* d = w == 0 ? p.WglaT : (w == 1 ? p.WdsaT : p.WoutT);
      transpose_tile(s, DM, d, (r & 15) * 64, (r >> 4) * 64, false, tile);
    }
  }
  const size_t nk4 = (size_t)32 * 2048 * 256 / 4;
  size_t stride = (size_t)gridDim.x * blockDim.x;
  for (size_t i = (size_t)blockIdx.x * blockDim.x + TIDX; i < nk4; i += stride) {
    size_t e = i * 4; size_t row = e >> 8; int c = (int)(e & 255);
    size_t sb = row >> 11, j = row & 2047;
    float4 kv = *(const float4*)(p.cache_k + e);
    float4 vv = *(const float4*)(p.cache_v + e);
    u8* o = p.KV8S + (sb * NKEYS_S + j) * 512 + (c >> 6) * 128 + (c & 63);
    *(u32*)o = pk4_fp8(kv.x, kv.y, kv.z, kv.w);
    *(u32*)(o + 64) = pk4_fp8(vv.x, vv.y, vv.z, vv.w);
  }
  const size_t ni4 = (size_t)32 * 2048 * 64 / 4;
  for (size_t i = (size_t)blockIdx.x * blockDim.x + TIDX; i < ni4; i += stride) {
    size_t e = i * 4; size_t row = e >> 6; int c = (int)(e & 63);
    size_t sb = row >> 11, j = row & 2047;
    float4 kv = *(const float4*)(p.cache_idx_k + e);
    *(uint2*)(p.KIS + (sb * NKEYS_S + j) * 64 + c) = make_uint2(pack2(kv.x, kv.y), pack2(kv.z, kv.w));
  }
}

__device__ __forceinline__ void phase_ln_in(const Params& p, int pass) {
  int R = pass_rows(pass), r0 = pass_row0(pass);
  int wave = TIDX >> 6, lane = TIDX & 63;
  for (int m = blockIdx.x * 4 + wave; m < R; m += gridDim.x * 4) {
    int gr = r0 + m;
    const float* x = xrow_ptr(p, gr);
    float4 v[4];
    float s = 0.f;
#pragma unroll
    for (int i = 0; i < 4; ++i) { v[i] = *(const float4*)(x + i * 256 + lane * 4); s += v[i].x + v[i].y + v[i].z + v[i].w; }
    float mu = wave_sum(s) * (1.f / DM);
    float q = 0.f;
#pragma unroll
    for (int i = 0; i < 4; ++i) {
      float a = v[i].x - mu, b = v[i].y - mu, c = v[i].z - mu, d = v[i].w - mu;
      q += a * a + b * b + c * c + d * d;
    }
    float rstd = rsqrtf(wave_sum(q) * (1.f / DM) + NORM_EPS);
#pragma unroll
    for (int i = 0; i < 4; ++i) {
      int c = i * 256 + lane * 4;
      float4 g = *(const float4*)(p.ln_in_g + c), b = *(const float4*)(p.ln_in_b + c);
      float h0 = (v[i].x - mu) * rstd * g.x + b.x, h1 = (v[i].y - mu) * rstd * g.y + b.y;
      float h2 = (v[i].z - mu) * rstd * g.z + b.z, h3 = (v[i].w - mu) * rstd * g.w + b.w;
      *(uint2*)(p.H + (size_t)m * DM + c) = make_uint2(pack2(h0, h1), pack2(h2, h3));
    }
    if (lane == 0) { p.STATS[gr * 2] = mu; p.STATS[gr * 2 + 1] = rstd; }
  }
}

#define GS 72
template <bool SWAP = false>
__device__ __forceinline__ void gemm_core(const u16* __restrict__ A, int lda, int m0, int mvalid,
                                          const u16* __restrict__ B, int ldb, int n0, int K,
                                          f32x16 (&acc)[2][2], u16* lds) {
  const int tid = TIDX, lane = tid & 63, w = tid >> 6, wm = w >> 1, wn = w & 1;
  u16* As = lds;
  u16* Bs = lds + 2 * 128 * GS;
  uint4 ra0, ra1, ra2, ra3, rb0, rb1, rb2, rb3;
  const int nk = K >> 6;
  const int lrow = tid >> 3, lch = tid & 7;
  const u16* ap[4]; const u16* bp[4];
#pragma unroll
  for (int i = 0; i < 4; ++i) {
    int ar = m0 + lrow + 32 * i; ar = ar < mvalid ? ar : mvalid - 1;
    ap[i] = A + (size_t)ar * lda + lch * 8;
    bp[i] = B + (size_t)(n0 + lrow + 32 * i) * ldb + lch * 8;
  }
#define GLOAD(kt) do { \
    ra0 = *(const uint4*)(ap[0] + (kt) * 64); ra1 = *(const uint4*)(ap[1] + (kt) * 64); \
    ra2 = *(const uint4*)(ap[2] + (kt) * 64); ra3 = *(const uint4*)(ap[3] + (kt) * 64); \
    rb0 = *(const uint4*)(bp[0] + (kt) * 64); rb1 = *(const uint4*)(bp[1] + (kt) * 64); \
    rb2 = *(const uint4*)(bp[2] + (kt) * 64); rb3 = *(const uint4*)(bp[3] + (kt) * 64); } while (0)
#define GSWRITE(buf) do { \
    u16* as_ = As + ((buf) * 128 + lrow) * GS + lch * 8; u16* bs_ = Bs + ((buf) * 128 + lrow) * GS + lch * 8; \
    *(uint4*)(as_) = ra0; *(uint4*)(as_ + 32 * GS) = ra1; *(uint4*)(as_ + 64 * GS) = ra2; *(uint4*)(as_ + 96 * GS) = ra3; \
    *(uint4*)(bs_) = rb0; *(uint4*)(bs_ + 32 * GS) = rb1; *(uint4*)(bs_ + 64 * GS) = rb2; *(uint4*)(bs_ + 96 * GS) = rb3; } while (0)
  GLOAD(0);
  GSWRITE(0);
  __syncthreads();
  for (int kt = 0; kt < nk; ++kt) {
    int buf = kt & 1;
    if (kt + 1 < nk) GLOAD(kt + 1);
    __builtin_amdgcn_sched_barrier(0);
    bf16x8 af[4][2], bf[4][2];
#pragma unroll
    for (int ks = 0; ks < 4; ++ks)
#pragma unroll
      for (int t = 0; t < 2; ++t) {
        af[ks][t] = *(const bf16x8*)(As + (buf * 128 + wm * 64 + t * 32 + (lane & 31)) * GS + ks * 16 + (lane >> 5) * 8);
        bf[ks][t] = *(const bf16x8*)(Bs + (buf * 128 + wn * 64 + t * 32 + (lane & 31)) * GS + ks * 16 + (lane >> 5) * 8);
      }
    __builtin_amdgcn_sched_barrier(0);
#pragma unroll
    for (int ks = 0; ks < 4; ++ks)
#pragma unroll
      for (int tm = 0; tm < 2; ++tm)
#pragma unroll
        for (int tn = 0; tn < 2; ++tn)
          acc[tm][tn] = SWAP ? __builtin_amdgcn_mfma_f32_32x32x16_bf16(bf[ks][tn], af[ks][tm], acc[tm][tn], 0, 0, 0)
                             : __builtin_amdgcn_mfma_f32_32x32x16_bf16(af[ks][tm], bf[ks][tn], acc[tm][tn], 0, 0, 0);
    __builtin_amdgcn_sched_barrier(0);
    if (kt + 1 < nk) GSWRITE(buf ^ 1);
    __syncthreads();
  }
}
#define ACC_ROW(wm, tm, r, lane) ((wm) * 64 + (tm) * 32 + ((r) & 3) + 8 * ((r) >> 2) + 4 * ((lane) >> 5))
#define ACC_COL(wn, tn, lane) ((wn) * 64 + (tn) * 32 + ((lane) & 31))

#define ES 136
__device__ __forceinline__ void store_tile_bf16(const f32x16 (&acc)[2][2], u16* lds, u16* __restrict__ dst, int ldd, int m0, int mvalid, int n0) {
  const int tid = TIDX, lane = tid & 63, w = tid >> 6, wm = w >> 1, wn = w & 1;
#pragma unroll
  for (int tm = 0; tm < 2; ++tm)
#pragma unroll
    for (int tn = 0; tn < 2; ++tn)
#pragma unroll
      for (int r = 0; r < 16; ++r)
        lds[ACC_ROW(wm, tm, r, lane) * ES + ACC_COL(wn, tn, lane)] = f2bf(acc[tm][tn][r]);
  __syncthreads();
#pragma unroll
  for (int i = 0; i < 8; ++i) {
    int c = tid + 256 * i, row = c >> 4, ch = c & 15;
    if (m0 + row < mvalid) *(uint4*)(dst + (size_t)(m0 + row) * ldd + n0 + ch * 8) = *(const uint4*)(lds + row * ES + ch * 8);
  }
  __syncthreads();
}

__device__ __forceinline__ void phase_gemm1(const Params& p, int pass, char* lds, unsigned xcc) {
  int R = pass_rows(pass), r0 = pass_row0(pass);
  int mt = (R + 127) >> 7;
  int lane = TIDX & 63, w = TIDX >> 6, wm = w >> 1, wn = w & 1;
  int* item = (int*)(lds + 77808);
  unsigned* ctr = p.bar + XCD_BAR_WORDS + 32 + pass * 8;
  int q = (int)(xcc & 7u), tries = 0;
  while (tries < 8) {
    __syncthreads();
    if (TIDX == 0) *item = (int)atomicAdd(&ctr[q], 1u);
    __syncthreads();
    int idx = *item;
    int nq = mt * 8 + (mt - q + 7) / 8;
    if (idx >= nq) { q = (q + 1) & 7; ++tries; continue; }
    int tm_, tn_;
    if (idx < mt * 8) { tm_ = idx >> 3; tn_ = q * 8 + (idx & 7); }
    else { tm_ = q + 8 * (idx - mt * 8); tn_ = 64; }
    int m0 = tm_ * 128, n0 = tn_ * 128;
    f32x16 acc[2][2];
#pragma unroll
    for (int i = 0; i < 2; ++i)
#pragma unroll
      for (int j = 0; j < 2; ++j)
#pragma unroll
        for (int r = 0; r < 16; ++r) acc[i][j][r] = 0.f;
    gemm_core<true>(p.H, DM, m0, R, p.WinT, DM, n0, DM, acc, (u16*)lds);
    int kind = 0;
    if (n0 >= C_DK && n0 < C_DV) kind = 1; else if (n0 >= C_DV && n0 < C_IQ) kind = 2; else if (n0 >= C_SM) kind = 3;
    const int half = lane >> 5;
#pragma unroll
    for (int tm = 0; tm < 2; ++tm) {
      int m = m0 + wm * 64 + tm * 32 + (lane & 31);
      if (kind != 3) {
#pragma unroll
        for (int tn = 0; tn < 2; ++tn)
#pragma unroll
          for (int gp = 0; gp < 2; ++gp) {
            u32 a0 = pack2(acc[tm][tn][8 * gp + 0], acc[tm][tn][8 * gp + 1]), a1 = pack2(acc[tm][tn][8 * gp + 2], acc[tm][tn][8 * gp + 3]);
            u32 b0 = pack2(acc[tm][tn][8 * gp + 4], acc[tm][tn][8 * gp + 5]), b1 = pack2(acc[tm][tn][8 * gp + 6], acc[tm][tn][8 * gp + 7]);
            auto s0 = __builtin_amdgcn_permlane32_swap(a0, b0, false, false);
            auto s1 = __builtin_amdgcn_permlane32_swap(a1, b1, false, false);
            int n = n0 + wn * 64 + tn * 32 + 8 * (2 * gp + half);
            if (m < R) *(uint4*)(p.P + (size_t)m * NCOL + n) = make_uint4(s0[0], s1[0], s0[1], s1[1]);
          }
      }
      if (kind != 0 && m < R) {
        int gr = r0 + m;
#pragma unroll
        for (int tn = 0; tn < 2; ++tn)
#pragma unroll
          for (int g = 0; g < 4; ++g) {
            int n = n0 + wn * 64 + tn * 32 + 8 * g + 4 * half;
            float4 v = make_float4(acc[tm][tn][4 * g + 0], acc[tm][tn][4 * g + 1], acc[tm][tn][4 * g + 2], acc[tm][tn][4 * g + 3]);
            if (kind == 3) {
              *(float4*)(p.PS + (size_t)m * 128 + (n - C_SM)) = v;
            } else {
              float* base = kind == 1 ? (gr < NPROMPT_ROWS ? p.k_prompt : p.k_sample) : (gr < NPROMPT_ROWS ? p.v_prompt : p.v_sample);
              int rr = gr < NPROMPT_ROWS ? gr : gr - NPROMPT_ROWS;
              *(float4*)(base + (size_t)rr * 256 + (n - (kind == 1 ? C_DK : C_DV))) = v;
            }
          }
      }
    }
  }
}

__device__ __forceinline__ void phase_tok(const Params& p, int pass, char* lds, bool dry) {
  float* glow = (float*)lds;
  int r0g = pass_row0(pass);
  int nblk = pass_nblk(pass);
  int tid = TIDX, lane = tid & 63, wave = tid >> 6;
  for (int tile = blockIdx.x; tile < nblk * 2; tile += gridDim.x) {
    int blk = tile >> 1, hf = tile & 1;
    int row0, len; blk_info(blk, row0, len);
    for (int t = wave; t < (hf == 0 ? len : 0); t += 4) {
      int m = row0 + t, gr = r0g + m;
      float x = p.PS[(size_t)m * 128 + lane];
      float mu = wave_sum(x) * (1.f / 64);
      float xc = x - mu;
      float var = wave_sum(xc * xc) * (1.f / 64);
      float y = xc * rsqrtf(var + NORM_EPS) * p.idx_kn_g[lane] + p.idx_kn_b[lane];
      u16 yb = f2bf(y);
      p.KI[(size_t)m * 64 + lane] = yb;
      if (gr < NPROMPT_ROWS) p.idx_k_prompt[(size_t)gr * 64 + lane] = y;
      else {
        int sr = gr - NPROMPT_ROWS; p.idx_k_sample[(size_t)sr * 64 + lane] = y;
        int sb = sr >> 4, tt = sr & 15;
        p.KIS[((size_t)sb * NKEYS_S + 2048 + tt) * 64 + lane] = yb;
      }
    }
    if (hf == 0) {
      u8* dst0 = blk < 257 ? p.KV8P + (size_t)row0 * 512 : p.KV8S + ((size_t)(blk - 257) * NKEYS_S + 2048) * 512;
      for (int i = tid; i < len * 64; i += 256) {
        int tt = i >> 6, c = (i & 63) * 4;
        const u16* src = p.P + (size_t)(row0 + tt) * NCOL + C_DK + c;
        uint2 kk = *(const uint2*)src, vv = *(const uint2*)(src + 256);
        u8* o = dst0 + (size_t)tt * 512 + (c >> 6) * 128 + (c & 63);
        *(u32*)o = pk4_fp8(bf2f((u16)(kk.x & 0xffff)), bf2f((u16)(kk.x >> 16)), bf2f((u16)(kk.y & 0xffff)), bf2f((u16)(kk.y >> 16)));
        *(u32*)(o + 64) = pk4_fp8(bf2f((u16)(vv.x & 0xffff)), bf2f((u16)(vv.x >> 16)), bf2f((u16)(vv.y & 0xffff)), bf2f((u16)(vv.y >> 16)));
      }
    }
    for (int i = tid; i < 64 * 16; i += 256) {
      int t = i >> 4, r = i & 15;
      glow[i] = t < len ? p.PS[(size_t)(row0 + t) * 128 + 64 + r] : 0.f;
    }
    __syncthreads();
    {
      const int ch = hf * 256 + tid;
      float w2[16];
#pragma unroll
      for (int r = 0; r < 16; ++r) w2[r] = p.gla_w2[r * 512 + ch];
      float bias = p.gla_gate_b[ch];
      float b = 0.f;
      for (int t0 = 0; t0 < len; t0 += 16) {
        u32 qr[16], kr[16];
#pragma unroll
        for (int j = 0; j < 16; ++j) {
          size_t o = (size_t)(row0 + t0 + j) * NCOL;
          qr[j] = 0u; kr[j] = 0u;
          if (t0 + j < len) { qr[j] = p.P[o + C_GQ + ch]; kr[j] = p.P[o + C_GK + ch]; }
        }
        __builtin_amdgcn_sched_barrier(0);
#pragma unroll
        for (int j = 0; j < 16; ++j) {
          const int t = t0 + j;
          if (t < len) {
            float x = bias;
#pragma unroll
            for (int r = 0; r < 16; ++r) x += glow[t * 16 + r] * w2[r];
            float ls = fminf(x, 0.f) - log1pf(expf(-fabsf(x)));
            b += ls * (1.f / 16.f);
            size_t o = (size_t)(row0 + t) * NCOL;
            float qv = bf2f((u16)qr[j]) * GLA_QSCALE * expf(b);
            float kv = bf2f((u16)kr[j]) * expf(-b);
            if (!dry) { p.P[o + C_GQ + ch] = f2bf(qv); p.P[o + C_GK + ch] = f2bf(kv); }
          }
        }
      }
      p.DEC[blk * 512 + ch] = expf(b);
    }
    __syncthreads();
  }
}

#define TS 72
template <int NIT>
__device__ __forceinline__ void stage_transposed(const u16* __restrict__ P, int row0, int len, int col0, u16* dst) {
  const int tid = TIDX, t = tid & 63, dc0 = tid >> 6;
  u32x4 v[NIT];
  const u16* src = P + (size_t)(row0 + (t < len ? t : 0)) * NCOL + col0;
#pragma unroll
  for (int i = 0; i < NIT; ++i) v[i] = *(const u32x4*)(src + (dc0 + 4 * i) * 8);
  __builtin_amdgcn_sched_barrier(0);
#pragma unroll
  for (int i = 0; i < NIT; ++i) {
    u32x4 x = v[i];
    if (t >= len) x = u32x4{0u, 0u, 0u, 0u};
    u16* d = dst + ((dc0 + 4 * i) * 8) * TS + t;
    d[0 * TS] = (u16)(x[0] & 0xffff); d[1 * TS] = (u16)(x[0] >> 16);
    d[2 * TS] = (u16)(x[1] & 0xffff); d[3 * TS] = (u16)(x[1] >> 16);
    d[4 * TS] = (u16)(x[2] & 0xffff); d[5 * TS] = (u16)(x[2] >> 16);
    d[6 * TS] = (u16)(x[3] & 0xffff); d[7 * TS] = (u16)(x[3] >> 16);
  }
}

__device__ __forceinline__ void phase_u(const Params& p, int pass, char* lds) {
  u16* KT = (u16*)lds;
  u16* VT = KT + 128 * TS;
  int nblk = pass_nblk(pass);
  int lane = TIDX & 63, w = TIDX >> 6;
  unsigned* ctr = p.bar + XCD_BAR_WORDS + 64 + pass;
  for (int t = dq_next(ctr, lds); t < nblk * 4; t = dq_next(ctr, lds)) {
    int blk = t >> 2, h = t & 3;
    int row0, len; blk_info(blk, row0, len);
    stage_transposed<4>(p.P, row0, len, C_GK + h * 128, KT);
    stage_transposed<8>(p.P, row0, len, C_GV + h * 256, VT);
    __syncthreads();
#pragma unroll
    for (int half = 0; half < 2; ++half) {
      f32x16 acc[2][2];
#pragma unroll
      for (int i = 0; i < 2; ++i)
#pragma unroll
        for (int j = 0; j < 2; ++j)
#pragma unroll
          for (int r = 0; r < 16; ++r) acc[i][j][r] = 0.f;
#pragma unroll
      for (int ks = 0; ks < 4; ++ks) {
        bf16x8 a[2], b[2];
#pragma unroll
        for (int tn = 0; tn < 2; ++tn) {
          a[tn] = *(const bf16x8*)(VT + (w * 64 + tn * 32 + (lane & 31)) * TS + ks * 16 + (lane >> 5) * 8);
          b[tn] = *(const bf16x8*)(KT + (half * 64 + tn * 32 + (lane & 31)) * TS + ks * 16 + (lane >> 5) * 8);
        }
#pragma unroll
        for (int tm = 0; tm < 2; ++tm)
#pragma unroll
          for (int tn = 0; tn < 2; ++tn)
            acc[tm][tn] = __builtin_amdgcn_mfma_f32_32x32x16_bf16(a[tm], b[tn], acc[tm][tn], 0, 0, 0);
      }
#pragma unroll
      for (int tn = 0; tn < 2; ++tn) {
        int d = half * 64 + tn * 32 + (lane & 31);
        float dec = p.DEC[blk * 512 + h * 128 + d];
#pragma unroll
        for (int tm = 0; tm < 2; ++tm)
#pragma unroll
          for (int r = 0; r < 16; ++r) {
            int e = w * 64 + tm * 32 + (r & 3) + 8 * (r >> 2) + 4 * (lane >> 5);
            p.US[((size_t)(blk * 4 + h) * 256 + e) * 128 + d] = f2bf(acc[tm][tn][r] * dec);
          }
      }
    }
    __syncthreads();
  }
}

__device__ __forceinline__ void phase_scan(const Params& p, int pass, bool dry) {
  int ntiles = 128 + (pass == 1 ? 32 * 128 : 0);
  for (int t = blockIdx.x; t < ntiles; t += gridDim.x) {
    bool samp = t >= 128;
    int sb = samp ? (t - 128) >> 7 : 0;
    int g4 = ((samp ? (t - 128) & 127 : t) << 8) + TIDX;
    int h = g4 >> 13, e = (g4 >> 5) & 255, d4 = (g4 & 31) * 4;
    float S[4];
    float* outp;
    int blk0, nb;
    if (!samp) {
      S[0] = S[1] = S[2] = S[3] = 0.f;
      outp = p.gla_prompt + (size_t)pass * 131072;
      blk0 = 0; nb = 257;
    } else {
      const float* st = p.state_gla + (size_t)sb * 131072;
#pragma unroll
      for (int j = 0; j < 4; ++j) S[j] = st[((size_t)(h * 128 + d4 + j)) * 256 + e];
      outp = p.gla_sample + (size_t)sb * 131072;
      blk0 = 257 + sb; nb = 1;
    }
    size_t eoff = (size_t)g4 * 4;
    for (int n0 = 0; n0 < nb; n0 += 8) {
      uint2 u[8]; float4 dc[8];
#pragma unroll
      for (int j = 0; j < 8; ++j) {
        int n = n0 + j; if (n < nb) {
          u[j] = *(const uint2*)(p.US + (size_t)(blk0 + n) * 131072 + eoff);
          dc[j] = *(const float4*)(p.DEC + (blk0 + n) * 512 + h * 128 + d4);
        }
      }
      __builtin_amdgcn_sched_barrier(0);
#pragma unroll
      for (int j = 0; j < 8; ++j) {
        int n = n0 + j; if (n < nb) {
          if (!dry) *(uint2*)(p.US + (size_t)(blk0 + n) * 131072 + eoff) = make_uint2(pack2(S[0], S[1]), pack2(S[2], S[3]));
          S[0] = dc[j].x * S[0] + bf2f((u16)(u[j].x & 0xffff));
          S[1] = dc[j].y * S[1] + bf2f((u16)(u[j].x >> 16));
          S[2] = dc[j].z * S[2] + bf2f((u16)(u[j].y & 0xffff));
          S[3] = dc[j].w * S[3] + bf2f((u16)(u[j].y >> 16));
        }
      }
    }
#pragma unroll
    for (int j = 0; j < 4; ++j) outp[((size_t)(h * 128 + d4 + j)) * 256 + e] = S[j];
  }
}

#define OS 264
__device__ __forceinline__ void phase_o(const Params& p, int pass, char* lds, bool dry) {
  u16* VT = (u16*)lds;
  u16* AS = VT + 256 * TS;
  u16* OT = VT;
  int nblk = pass_nblk(pass);
  int tid = TIDX, lane = tid & 63, w = tid >> 6;
  int* item = (int*)(lds + 77808);
  unsigned* ctr = p.bar + XCD_BAR_WORDS + 48 + (dry ? 8 : 0) + pass;
  for (;;) {
    __syncthreads();
    if (tid == 0) *item = (int)atomicAdd(ctr, 1u);
    __syncthreads();
    int t = *item;
    if (t >= nblk * 4) break;
    int blk = t >> 2, h = t & 3;
    int row0, len; blk_info(blk, row0, len);
    stage_transposed<8>(p.P, row0, len, C_GV + h * 256, VT);
    {
      int ti = w >> 1, tj = w & 1;
      f32x16 acc;
#pragma unroll
      for (int r = 0; r < 16; ++r) acc[r] = 0.f;
      if (tj <= ti) {
        int qi = ti * 32 + (lane & 31), kj = tj * 32 + (lane & 31);
        const u16* qp = p.P + (size_t)(row0 + (qi < len ? qi : 0)) * NCOL + C_GQ + h * 128 + (lane >> 5) * 8;
        const u16* kp = p.P + (size_t)(row0 + (kj < len ? kj : 0)) * NCOL + C_GK + h * 128 + (lane >> 5) * 8;
#pragma unroll
        for (int ks = 0; ks < 8; ++ks) {
          bf16x8 a = *(const bf16x8*)(qp + ks * 16), b = *(const bf16x8*)(kp + ks * 16);
          acc = __builtin_amdgcn_mfma_f32_32x32x16_bf16(a, b, acc, 0, 0, 0);
        }
      }
#pragma unroll
      for (int r = 0; r < 16; ++r) {
        int i = ti * 32 + (r & 3) + 8 * (r >> 2) + 4 * (lane >> 5), j = tj * 32 + (lane & 31);
        float v = (j <= i && i < len && j < len) ? acc[r] : 0.f;
        AS[i * TS + j] = f2bf(v);
      }
    }
    __syncthreads();
    f32x16 acc[2][2];
#pragma unroll
    for (int i = 0; i < 2; ++i)
#pragma unroll
      for (int j = 0; j < 2; ++j)
#pragma unroll
        for (int r = 0; r < 16; ++r) acc[i][j][r] = 0.f;
#pragma unroll
    for (int ks = 0; ks < 4; ++ks) {
      bf16x8 a[2], b[2];
#pragma unroll
      for (int x = 0; x < 2; ++x) {
        a[x] = *(const bf16x8*)(AS + (x * 32 + (lane & 31)) * TS + ks * 16 + (lane >> 5) * 8);
        b[x] = *(const bf16x8*)(VT + (w * 64 + x * 32 + (lane & 31)) * TS + ks * 16 + (lane >> 5) * 8);
      }
#pragma unroll
      for (int tm = 0; tm < 2; ++tm)
#pragma unroll
        for (int tn = 0; tn < 2; ++tn)
          acc[tm][tn] = __builtin_amdgcn_mfma_f32_32x32x16_bf16(a[tm], b[tn], acc[tm][tn], 0, 0, 0);
    }
    {
      const u16* Sp = p.US + (size_t)(blk * 4 + h) * 32768;
#pragma unroll
      for (int ks = 0; ks < 8; ++ks) {
        bf16x8 a[2], b[2];
#pragma unroll
        for (int x = 0; x < 2; ++x) {
          int qi = x * 32 + (lane & 31);
          bf16x8 z = {0, 0, 0, 0, 0, 0, 0, 0};
          a[x] = qi < len ? *(const bf16x8*)(p.P + (size_t)(row0 + qi) * NCOL + C_GQ + h * 128 + ks * 16 + (lane >> 5) * 8) : z;
          b[x] = *(const bf16x8*)(Sp + (size_t)(w * 64 + x * 32 + (lane & 31)) * 128 + ks * 16 + (lane >> 5) * 8);
        }
#pragma unroll
        for (int tm = 0; tm < 2; ++tm)
#pragma unroll
          for (int tn = 0; tn < 2; ++tn)
            acc[tm][tn] = __builtin_amdgcn_mfma_f32_32x32x16_bf16(a[tm], b[tn], acc[tm][tn], 0, 0, 0);
      }
    }
    __syncthreads();
#pragma unroll
    for (int tm = 0; tm < 2; ++tm)
#pragma unroll
      for (int tn = 0; tn < 2; ++tn)
#pragma unroll
        for (int r = 0; r < 16; ++r) {
          int i = tm * 32 + (r & 3) + 8 * (r >> 2) + 4 * (lane >> 5), e = w * 64 + tn * 32 + (lane & 31);
          OT[i * OS + e] = f2bf(acc[tm][tn][r]);
        }
    __syncthreads();
    {
      int i = tid >> 2, seg = tid & 3;
      float vals[64];
      float ss = 0.f;
#pragma unroll
      for (int c = 0; c < 8; ++c) {
        uint4 v = *(const uint4*)(OT + i * OS + seg * 64 + c * 8);
        u32 ww[4] = {v.x, v.y, v.z, v.w};
#pragma unroll
        for (int k = 0; k < 4; ++k) {
          float a = bf2f((u16)(ww[k] & 0xffff)), b = bf2f((u16)(ww[k] >> 16));
          vals[c * 8 + 2 * k] = a; vals[c * 8 + 2 * k + 1] = b; ss += a * a + b * b;
        }
      }
      ss += __shfl_xor(ss, 1); ss += __shfl_xor(ss, 2);
      float rstd = rsqrtf(ss * (1.f / 256) + NORM_EPS);
      if (i < len && !dry) {
        size_t o = (size_t)(row0 + i) * NCOL;
#pragma unroll
        for (int c = 0; c < 8; ++c) {
          int e = seg * 64 + c * 8;
          uint4 gr = *(const uint4*)(p.P + o + C_GR + h * 256 + e);
          u32 gw[4] = {gr.x, gr.y, gr.z, gr.w};
          u32 ow[4];
#pragma unroll
          for (int k = 0; k < 4; ++k) {
            float g0 = bf2f((u16)(gw[k] & 0xffff)), g1 = bf2f((u16)(gw[k] >> 16));
            float y0 = vals[c * 8 + 2 * k] * rstd * p.gla_norm_g[e + 2 * k] * siluf_(g0);
            float y1 = vals[c * 8 + 2 * k + 1] * rstd * p.gla_norm_g[e + 2 * k + 1] * siluf_(g1);
            ow[k] = pack2(y0, y1);
          }
          *(uint4*)(p.P + o + C_GV + h * 256 + e) = make_uint4(ow[0], ow[1], ow[2], ow[3]);
        }
      }
    }
    __syncthreads();
  }
}

struct DTile {
  int qrow0, qrow1;
  int nkeys0, nkeys1;
  const u16* ki; int ki_stride;
  const u16* kv; int kv_stride;
};

__device__ __forceinline__ u32 score_key(float s, int keyidx) {
  u32 u = __float_as_uint(s);
  u ^= (u32)(((int)u) >> 31) | 0x80000000u;
  return (u & 0xFFFF8000u) | (u32)(32767 - keyidx);
}

__device__ __forceinline__ void compact(u32* cand, int n, int hi, int& newcnt, u32& newthr) {
  int lane = TIDX & 63;
  u32 v[CVN];
#pragma unroll
  for (int e = 0; e < CVN; ++e) { int idx = lane + 64 * e; v[e] = idx < n ? cand[idx] : 0u; }
  u32 prefix = 0;
  for (int bit = 31; bit >= 0; --bit) {
    u32 trial = prefix | (1u << bit);
    int c = 0;
#pragma unroll
    for (int e = 0; e < CVN; ++e) c += __popcll(__ballot(v[e] >= trial));
    if (c >= 256) { prefix = trial; if (c <= hi) break; }
  }
  int base = 0;
  unsigned long long lt = (1ull << lane) - 1ull;
#pragma unroll
  for (int e = 0; e < CVN; ++e) {
    bool keep = v[e] >= prefix && prefix != 0;
    unsigned long long m = __ballot(keep);
    int pos = base + __popcll(m & lt);
    if (keep) cand[pos] = v[e];
    base += __popcll(m);
  }
  newcnt = base; newthr = prefix - 1u;
}

__device__ __forceinline__ void dsa_tile(const Params& p, const DTile& T, char* lds, bool dry) {
  u32* cand = (u32*)lds;
  u16* kst = (u16*)(lds + 32 * CAP * 4);
  const int tid = TIDX, lane = tid & 63, w = tid >> 6, half = lane >> 5;
  bf16x8 afr[2][4];
  bf16x8 aW[2][2];
#pragma unroll
  for (int rt = 0; rt < 2; ++rt) {
    bool act = (rt == 0 ? T.nkeys0 : T.nkeys1) > 0;
    int qr = (act && rt == 1) ? T.qrow1 : T.qrow0;
    int m = qr + 4 * w + ((lane & 31) >> 3);
    const u16* ap = p.P + (size_t)m * NCOL + C_IQ + (lane & 7) * 64 + half * 8;
#pragma unroll
    for (int ks = 0; ks < 4; ++ks) afr[rt][ks] = *(const bf16x8*)(ap + ks * 16);
    const int rho = lane & 31;
    const bool vrow = (rho & ~5) == 0;
    const int qi = 2 * (rho & 1) + ((rho >> 2) & 1);
    float4 w4 = *(const float4*)(p.PS + (size_t)(qr + 4 * w + qi) * 128 + 80 + 4 * half);
    u32 lo = pack2(w4.x * IDX_W_SCALE, w4.y * IDX_W_SCALE), hi = pack2(w4.z * IDX_W_SCALE, w4.w * IDX_W_SCALE);
#pragma unroll
    for (int sx = 0; sx < 2; ++sx) {
      bool on = vrow && (qi >> 1) == sx;
      u32x4 wd = {0u, 0u, 0u, 0u};
      if (on && (qi & 1) == 0) { wd[0] = lo; wd[1] = hi; }
      if (on && (qi & 1) == 1) { wd[2] = lo; wd[3] = hi; }
      aW[rt][sx] = __builtin_bit_cast(bf16x8, wd);
    }
  }
  u32 thr[2][2]; int cnt[2][2];
#pragma unroll
  for (int rt = 0; rt < 2; ++rt)
#pragma unroll
    for (int pp = 0; pp < 2; ++pp) { thr[rt][pp] = 0u; cnt[rt][pp] = 0; }
  const int NH = T.nkeys0, NL = T.nkeys1;
  const int nkt = (NH + 63) >> 6;
  const unsigned long long lt = (1ull << lane) - 1ull;
#define SCORE(ACC, RT, K0, KEY0, KEY1, M0, M1) do { \
    const int N_ = (RT) == 0 ? NH : NL; \
    M0 = 0ull; M1 = 0ull; KEY0 = 0u; KEY1 = 0u; \
    if ((K0) < N_) { \
      const int keyidx = (K0) + (lane & 31); \
      const bool valid = keyidx < N_; \
      u32x4 xa_ = {cvt_pk_bf16(relu1(ACC[0]), relu1(ACC[1])), cvt_pk_bf16(relu1(ACC[2]), relu1(ACC[3])), \
                   cvt_pk_bf16(relu1(ACC[4]), relu1(ACC[5])), cvt_pk_bf16(relu1(ACC[6]), relu1(ACC[7]))}; \
      u32x4 xb_ = {cvt_pk_bf16(relu1(ACC[8]), relu1(ACC[9])), cvt_pk_bf16(relu1(ACC[10]), relu1(ACC[11])), \
                   cvt_pk_bf16(relu1(ACC[12]), relu1(ACC[13])), cvt_pk_bf16(relu1(ACC[14]), relu1(ACC[15]))}; \
      f32x16 s2_; \
      _Pragma("unroll") for (int r_ = 0; r_ < 16; ++r_) s2_[r_] = 0.f; \
      s2_ = __builtin_amdgcn_mfma_f32_32x32x16_bf16(aW[RT][0], __builtin_bit_cast(bf16x8, xa_), s2_, 0, 0, 0); \
      s2_ = __builtin_amdgcn_mfma_f32_32x32x16_bf16(aW[RT][1], __builtin_bit_cast(bf16x8, xb_), s2_, 0, 0, 0); \
      KEY0 = score_key(s2_[0], keyidx); \
      KEY1 = score_key(s2_[1], keyidx); \
      M0 = __ballot(valid && KEY0 > thr[RT][0]); \
      M1 = __ballot(valid && KEY1 > thr[RT][1]); \
    } } while (0)
#define APPEND(RT, PP, KEY, M) do { \
    if (M) { \
      bool pass = (M >> lane) & 1ull; \
      pass = pass && (KEY > thr[RT][PP]); \
      unsigned long long m = __ballot(pass); \
      u32 mh = half ? (u32)(m >> 32) : (u32)m; \
      int slot = (RT) * 16 + 4 * w + 2 * (PP) + half; \
      int pos = cnt[RT][PP] + __popc(mh & (u32)(lt >> (half * 32))); \
      if (pass) cand[slot * CAP + pos] = KEY; \
      cnt[RT][PP] += __popc(mh); \
      unsigned long long over = __ballot(cnt[RT][PP] > CLIMIT); \
      if (over) { \
        _Pragma("unroll") \
        for (int hh = 0; hh < 2; ++hh) { \
          if ((u32)(over >> (hh * 32)) != 0u) { \
            int sl = (RT) * 16 + 4 * w + 2 * (PP) + hh; \
            int n = __shfl(cnt[RT][PP], hh * 32); \
            int nc; u32 nt; \
            compact(cand + sl * CAP, n, 320, nc, nt); \
            if (half == hh) { cnt[RT][PP] = nc; thr[RT][PP] = nt; } \
          } \
        } \
      } \
    } } while (0)
  bf16x8 nA[4], nB[4];
#define BLOAD(kt) do { \
    int ka_ = (kt) * 64 + (lane & 31), kb_ = ka_ + 32; \
    ka_ = ka_ < NH ? ka_ : NH - 1; kb_ = kb_ < NH ? kb_ : NH - 1; \
    const u16* pa_ = T.ki + (size_t)ka_ * T.ki_stride + half * 8; \
    const u16* pb_ = T.ki + (size_t)kb_ * T.ki_stride + half * 8; \
    _Pragma("unroll") for (int ks = 0; ks < 4; ++ks) { nA[ks] = *(const bf16x8*)(pa_ + ks * 16); nB[ks] = *(const bf16x8*)(pb_ + ks * 16); } } while (0)
  BLOAD(0);
#pragma unroll 1
  for (int kt = 0; kt < nkt; ++kt) {
    const int k0a = kt * 64, k0b = kt * 64 + 32;
    bf16x8 bA[4], bB[4];
#pragma unroll
    for (int ks = 0; ks < 4; ++ks) { bA[ks] = nA[ks]; bB[ks] = nB[ks]; }
    if (kt + 1 < nkt) BLOAD(kt + 1);
    __builtin_amdgcn_sched_barrier(0);
    f32x16 aH0, aL0, aH1, aL1;
#pragma unroll
    for (int r = 0; r < 16; ++r) { aH0[r] = 0.f; aL0[r] = 0.f; aH1[r] = 0.f; aL1[r] = 0.f; }
    const bool lact = k0a < NL;
#pragma unroll
    for (int ks = 0; ks < 4; ++ks) {
      aH0 = __builtin_amdgcn_mfma_f32_32x32x16_bf16(afr[0][ks], bA[ks], aH0, 0, 0, 0);
      aH1 = __builtin_amdgcn_mfma_f32_32x32x16_bf16(afr[0][ks], bB[ks], aH1, 0, 0, 0);
    }
    if (lact) {
#pragma unroll
      for (int ks = 0; ks < 4; ++ks) {
        aL0 = __builtin_amdgcn_mfma_f32_32x32x16_bf16(afr[1][ks], bA[ks], aL0, 0, 0, 0);
        aL1 = __builtin_amdgcn_mfma_f32_32x32x16_bf16(afr[1][ks], bB[ks], aL1, 0, 0, 0);
      }
    }
    u32 kH0a, kH0b, kH1a, kH1b, kL0a, kL0b, kL1a, kL1b;
    unsigned long long mH0a, mH0b, mH1a, mH1b, mL0a, mL0b, mL1a, mL1b;
    SCORE(aH0, 0, k0a, kH0a, kH0b, mH0a, mH0b);
    SCORE(aH1, 0, k0b, kH1a, kH1b, mH1a, mH1b);
    SCORE(aL0, 1, k0a, kL0a, kL0b, mL0a, mL0b);
    SCORE(aL1, 1, k0b, kL1a, kL1b, mL1a, mL1b);
    if (mH0a | mH0b | mH1a | mH1b | mL0a | mL0b | mL1a | mL1b) {
      APPEND(0, 0, kH0a, mH0a); APPEND(0, 1, kH0b, mH0b);
      APPEND(0, 0, kH1a, mH1a); APPEND(0, 1, kH1b, mH1b);
      APPEND(1, 0, kL0a, mL0a); APPEND(1, 1, kL0b, mL0b);
      APPEND(1, 0, kL1a, mL1a); APPEND(1, 1, kL1b, mL1b);
    }
  }
  int* nselp = (int*)(lds + 32 * CAP * 4);
#pragma unroll
  for (int rt = 0; rt < 2; ++rt)
#pragma unroll
    for (int pp = 0; pp < 2; ++pp)
#pragma unroll
      for (int hh = 0; hh < 2; ++hh) {
        int sl = rt * 16 + 4 * w + 2 * pp + hh;
        int n = __shfl(cnt[rt][pp], hh * 32);
        if (n > 256) { int nc; u32 nt; compact(cand + sl * CAP, n, 256, nc, nt); n = nc; }
        if (lane == 0) nselp[sl] = n;
      }
#pragma unroll 1
  for (int qq = 0; qq < 8; ++qq) {
    int rt = qq >> 2, qi = qq & 3;
    if ((rt == 0 ? T.nkeys0 : T.nkeys1) == 0) continue;
    int sl = rt * 16 + 4 * w + qi;
    int nsel = nselp[sl];
    const u32* cq = cand + sl * CAP;
    int m = (rt == 0 ? T.qrow0 : T.qrow1) + 4 * w + qi;
    u32 k0 = 4 * lane + 0 < nsel ? 32767u - (cq[4 * lane + 0] & 0x7fffu) : 0u;
    u32 k1 = 4 * lane + 1 < nsel ? 32767u - (cq[4 * lane + 1] & 0x7fffu) : 0u;
    u32 k2 = 4 * lane + 2 < nsel ? 32767u - (cq[4 * lane + 2] & 0x7fffu) : 0u;
    u32 k3 = 4 * lane + 3 < nsel ? 32767u - (cq[4 * lane + 3] & 0x7fffu) : 0u;
    if (!dry) *(uint2*)(p.SEL + (size_t)m * 256 + 4 * lane) = make_uint2(k0 | (k1 << 16), k2 | (k3 << 16));
  }
  __syncthreads();
}

typedef __attribute__((ext_vector_type(2))) unsigned int u32x2;
__device__ __forceinline__ bf16x8 fp8x8_to_bf16x8(u32x2 x) {
  u32 a0, a1, a2, a3;
  fp8x4_to_bf16(x[0], a0, a1);
  fp8x4_to_bf16(x[1], a2, a3);
  u32x4 r = {a0, a1, a2, a3};
  return __builtin_bit_cast(bf16x8, r);
}
__device__ __forceinline__ void att_unit(const Params& p, int m, int g, int nsel, const u8* __restrict__ kv,
                                         const u16* sl, u16* vs, bool dry) {
  const int lane = TIDX & 63, g4 = lane >> 4, i16 = lane & 15;
  bf16x8 bq0, bq1;
  {
    bf16x8 z = {0, 0, 0, 0, 0, 0, 0, 0};
    const u16* qp = p.P + (size_t)m * NCOL + C_DQ + (g * 4 + (i16 & 3)) * 64 + g4 * 8;
    bq0 = i16 < 4 ? *(const bf16x8*)(qp) : z;
    bq1 = i16 < 4 ? *(const bf16x8*)(qp + 32) : z;
  }
  const int npad = (nsel + 31) & ~31;
  const int nchunk = (npad + 63) >> 6;
  const u8* kbase = kv + g * 128 + g4 * 8;
  const u8* vbase = kv + g * 128 + 64 + (lane & 3) * 16;
  u32x2 kc[4][2], kn[4][2];
#pragma unroll
  for (int tt = 0; tt < 4; ++tt) {
    const u8* kp = kbase + (size_t)sl[tt * 16 + i16] * 512;
    kc[tt][0] = *(const u32x2*)kp; kc[tt][1] = *(const u32x2*)(kp + 32);
    kn[tt][0] = kc[tt][0]; kn[tt][1] = kc[tt][1];
  }
  u32x4 vc[2][2], vn[2][2];
#pragma unroll
  for (int s2 = 0; s2 < 2; ++s2)
#pragma unroll
    for (int it = 0; it < 2; ++it) {
      vc[s2][it] = *(const u32x4*)(vbase + (size_t)sl[s2 * 32 + it * 16 + (lane >> 2)] * 512);
      vn[s2][it] = vc[s2][it];
    }
  float mrun = -3.0e38f, lrun = 0.f;
  f32x4 oacc[4];
#pragma unroll
  for (int dt = 0; dt < 4; ++dt) oacc[dt] = f32x4{0.f, 0.f, 0.f, 0.f};
#pragma unroll 1
  for (int c = 0; c < nchunk; ++c) {
    if (c + 1 < nchunk) {
#pragma unroll
      for (int s2 = 0; s2 < 2; ++s2)
#pragma unroll
        for (int it = 0; it < 2; ++it)
          vn[s2][it] = *(const u32x4*)(vbase + (size_t)sl[(c + 1) * 64 + s2 * 32 + it * 16 + (lane >> 2)] * 512);
#pragma unroll
      for (int tt = 0; tt < 4; ++tt) {
        const u8* kp = kbase + (size_t)sl[(c + 1) * 64 + tt * 16 + i16] * 512;
        kn[tt][0] = *(const u32x2*)kp; kn[tt][1] = *(const u32x2*)(kp + 32);
      }
    }
    __builtin_amdgcn_sched_barrier(0);
    f32x4 lg[4];
    float cmax = -3.0e38f;
#pragma unroll
    for (int tt = 0; tt < 4; ++tt) {
      f32x4 cc = {0.f, 0.f, 0.f, 0.f};
      cc = __builtin_amdgcn_mfma_f32_16x16x32_bf16(fp8x8_to_bf16x8(kc[tt][0]), bq0, cc, 0, 0, 0);
      cc = __builtin_amdgcn_mfma_f32_16x16x32_bf16(fp8x8_to_bf16x8(kc[tt][1]), bq1, cc, 0, 0, 0);
#pragma unroll
      for (int r = 0; r < 4; ++r) {
        int ks = (c * 4 + tt) * 16 + 4 * g4 + r;
        float v = ks < nsel ? cc[r] : -3.0e38f;
        lg[tt][r] = v; cmax = fmaxf(cmax, v);
      }
    }
    cmax = fmaxf(cmax, __shfl_xor(cmax, 16)); cmax = fmaxf(cmax, __shfl_xor(cmax, 32));
    float mnew = fmaxf(mrun, cmax);
    float alpha = __expf((mrun - mnew) * DSA_SCALE);
    mrun = mnew;
    bf16x8 pa[2];
    float psum = 0.f;
#pragma unroll
    for (int s2 = 0; s2 < 2; ++s2) {
#pragma unroll
      for (int r = 0; r < 4; ++r) {
        float e0 = __expf((lg[2 * s2][r] - mnew) * DSA_SCALE);
        float e1 = __expf((lg[2 * s2 + 1][r] - mnew) * DSA_SCALE);
        psum += e0 + e1;
        pa[s2][r] = (short)f2bf(e0); pa[s2][4 + r] = (short)f2bf(e1);
      }
    }
    lrun = lrun * alpha + psum;
    float al[4];
#pragma unroll
    for (int r = 0; r < 4; ++r) al[r] = __shfl(alpha, r);
#pragma unroll
    for (int dt = 0; dt < 4; ++dt)
#pragma unroll
      for (int r = 0; r < 4; ++r) oacc[dt][r] *= al[r];
#pragma unroll
    for (int s2 = 0; s2 < 2; ++s2) {
      __builtin_amdgcn_wave_barrier();
#pragma unroll
      for (int it = 0; it < 2; ++it) {
        u32 a0, a1, a2, a3, b0, b1, b2, b3;
        fp8x4_to_bf16(vc[s2][it][0], a0, a1); fp8x4_to_bf16(vc[s2][it][1], a2, a3);
        fp8x4_to_bf16(vc[s2][it][2], b0, b1); fp8x4_to_bf16(vc[s2][it][3], b2, b3);
        u32x4 w0 = {a0, a1, a2, a3}, w1 = {b0, b1, b2, b3};
        u16* vd = vs + (it * 16 + (lane >> 2)) * 64 + (lane & 3) * 16;
        *(u32x4*)vd = w0; *(u32x4*)(vd + 8) = w1;
      }
      __builtin_amdgcn_fence(__ATOMIC_RELEASE, "wavefront");
      __builtin_amdgcn_wave_barrier();
      __builtin_amdgcn_fence(__ATOMIC_ACQUIRE, "wavefront");
#pragma unroll
      for (int dt = 0; dt < 4; ++dt) {
        int q = i16 >> 2, pq = i16 & 3;
        const u16* a0 = vs + (4 * g4 + q) * 64 + dt * 16 + 4 * pq;
        const u16* a1 = vs + (16 + 4 * g4 + q) * 64 + dt * 16 + 4 * pq;
        s16x4 lo = __builtin_bit_cast(s16x4, __builtin_amdgcn_ds_read_tr16_b64_v4i16((lds_v4p)(a0)));
        s16x4 hi = __builtin_bit_cast(s16x4, __builtin_amdgcn_ds_read_tr16_b64_v4i16((lds_v4p)(a1)));
        bf16x8 bv = {lo[0], lo[1], lo[2], lo[3], hi[0], hi[1], hi[2], hi[3]};
        oacc[dt] = __builtin_amdgcn_mfma_f32_16x16x32_bf16(pa[s2], bv, oacc[dt], 0, 0, 0);
      }
    }
#pragma unroll
    for (int tt = 0; tt < 4; ++tt) { kc[tt][0] = kn[tt][0]; kc[tt][1] = kn[tt][1]; }
#pragma unroll
    for (int s2 = 0; s2 < 2; ++s2) { vc[s2][0] = vn[s2][0]; vc[s2][1] = vn[s2][1]; }
  }
  float sum = lrun;
  sum += __shfl_xor(sum, 16); sum += __shfl_xor(sum, 32);
  float inv[4];
#pragma unroll
  for (int r = 0; r < 4; ++r) inv[r] = 1.f / __shfl(sum, r);
  if (lane < 16 && !dry) {
    size_t o = (size_t)m * NCOL;
#pragma unroll
    for (int r = 0; r < 4; ++r)
#pragma unroll
      for (int dt = 0; dt < 4; ++dt) {
        int col = (g * 4 + r) * 64 + dt * 16 + lane;
        float z = bf2f(p.P[o + C_DZ + col]);
        p.P[o + C_DQ + col] = f2bf(oacc[dt][r] * inv[r] * siluf_(z));
      }
  }
}

__device__ __forceinline__ void att_item(const Params& p, int m0, int g, int nsel, const u8* __restrict__ kv,
                                         u16* slw, u16* vs, bool dry) {
  const int lane = TIDX & 63, g4 = lane >> 4, i16 = lane & 15;
  const int npad = (nsel + 31) & ~31;
  const int nchunk = (npad + 63) >> 6;
  const u8* kbase = kv + g * 128 + g4 * 8;
  const u8* vbase = kv + g * 128 + 64 + (lane & 3) * 16;
  const bf16x8 zf = {0, 0, 0, 0, 0, 0, 0, 0};
  u32x2 selr = *(const u32x2*)(p.SEL + (size_t)m0 * 256 + 4 * lane);
  __builtin_amdgcn_wave_barrier();
  *(u32x2*)(slw + 4 * lane) = selr;
  __builtin_amdgcn_fence(__ATOMIC_RELEASE, "wavefront");
  __builtin_amdgcn_wave_barrier();
  __builtin_amdgcn_fence(__ATOMIC_ACQUIRE, "wavefront");
  selr = *(const u32x2*)(p.SEL + (size_t)(m0 + 1) * 256 + 4 * lane);
  bf16x8 bq0, bq1, bn0, bn1;
  {
    const u16* qp = p.P + (size_t)m0 * NCOL + C_DQ + (g * 4 + (i16 & 3)) * 64 + g4 * 8;
    bq0 = i16 < 4 ? *(const bf16x8*)(qp) : zf;
    bq1 = i16 < 4 ? *(const bf16x8*)(qp + 32) : zf;
    bn0 = bq0; bn1 = bq1;
  }
  u32x2 kc[4][2], kn[4][2];
  u32x4 vc[2][2], vn[2][2];
#pragma unroll
  for (int tt = 0; tt < 4; ++tt) {
    const u8* kp = kbase + (size_t)slw[tt * 16 + i16] * 512;
    kc[tt][0] = *(const u32x2*)kp; kc[tt][1] = *(const u32x2*)(kp + 32);
    kn[tt][0] = kc[tt][0]; kn[tt][1] = kc[tt][1];
  }
#pragma unroll
  for (int s2 = 0; s2 < 2; ++s2)
#pragma unroll
    for (int it = 0; it < 2; ++it) {
      vc[s2][it] = *(const u32x4*)(vbase + (size_t)slw[s2 * 32 + it * 16 + (lane >> 2)] * 512);
      vn[s2][it] = vc[s2][it];
    }
  float mrun = -3.0e38f, lrun = 0.f;
  f32x4 oacc[4];
#pragma unroll
  for (int dt = 0; dt < 4; ++dt) oacc[dt] = f32x4{0.f, 0.f, 0.f, 0.f};
  const int nt = 4 * nchunk;
  int u = 0, c = 0;
#pragma unroll 1
  for (int t = 0; t < nt; ++t) {
    const int m = m0 + u;
    if (c + 1 < nchunk) {
      const u16* slc = slw + (u & 1) * 256 + (c + 1) * 64;
#pragma unroll
      for (int s2 = 0; s2 < 2; ++s2)
#pragma unroll
        for (int it = 0; it < 2; ++it)
          vn[s2][it] = *(const u32x4*)(vbase + (size_t)slc[s2 * 32 + it * 16 + (lane >> 2)] * 512);
#pragma unroll
      for (int tt = 0; tt < 4; ++tt) {
        const u8* kp = kbase + (size_t)slc[tt * 16 + i16] * 512;
        kn[tt][0] = *(const u32x2*)kp; kn[tt][1] = *(const u32x2*)(kp + 32);
      }
    } else if (u + 1 < 4) {
      u16* sln = slw + ((u + 1) & 1) * 256;
      __builtin_amdgcn_wave_barrier();
      *(u32x2*)(sln + 4 * lane) = selr;
      __builtin_amdgcn_fence(__ATOMIC_RELEASE, "wavefront");
      __builtin_amdgcn_wave_barrier();
      __builtin_amdgcn_fence(__ATOMIC_ACQUIRE, "wavefront");
      if (u + 2 < 4) selr = *(const u32x2*)(p.SEL + (size_t)(m + 2) * 256 + 4 * lane);
#pragma unroll
      for (int s2 = 0; s2 < 2; ++s2)
#pragma unroll
        for (int it = 0; it < 2; ++it)
          vn[s2][it] = *(const u32x4*)(vbase + (size_t)sln[s2 * 32 + it * 16 + (lane >> 2)] * 512);
#pragma unroll
      for (int tt = 0; tt < 4; ++tt) {
        const u8* kp = kbase + (size_t)sln[tt * 16 + i16] * 512;
        kn[tt][0] = *(const u32x2*)kp; kn[tt][1] = *(const u32x2*)(kp + 32);
      }
      const u16* qp = p.P + (size_t)(m + 1) * NCOL + C_DQ + (g * 4 + (i16 & 3)) * 64 + g4 * 8;
      bn0 = i16 < 4 ? *(const bf16x8*)(qp) : zf;
      bn1 = i16 < 4 ? *(const bf16x8*)(qp + 32) : zf;
    }
    __builtin_amdgcn_sched_barrier(0);
    f32x4 lg[4];
    float cmax = -3.0e38f;
#pragma unroll
    for (int tt = 0; tt < 4; ++tt) {
      f32x4 cc = {0.f, 0.f, 0.f, 0.f};
      cc = __builtin_amdgcn_mfma_f32_16x16x32_bf16(fp8x8_to_bf16x8(kc[tt][0]), bq0, cc, 0, 0, 0);
      cc = __builtin_amdgcn_mfma_f32_16x16x32_bf16(fp8x8_to_bf16x8(kc[tt][1]), bq1, cc, 0, 0, 0);
#pragma unroll
      for (int r = 0; r < 4; ++r) {
        int ks = (c * 4 + tt) * 16 + 4 * g4 + r;
        float v = ks < nsel ? cc[r] : -3.0e38f;
        lg[tt][r] = v; cmax = fmaxf(cmax, v);
      }
    }
    cmax = fmaxf(cmax, __shfl_xor(cmax, 16)); cmax = fmaxf(cmax, __shfl_xor(cmax, 32));
    float mnew = fmaxf(mrun, cmax);
    float alpha = __expf((mrun - mnew) * DSA_SCALE);
    mrun = mnew;
    bf16x8 pa[2];
    float psum = 0.f;
#pragma unroll
    for (int s2 = 0; s2 < 2; ++s2) {
#pragma unroll
      for (int r = 0; r < 4; ++r) {
        float e0 = __expf((lg[2 * s2][r] - mnew) * DSA_SCALE);
        float e1 = __expf((lg[2 * s2 + 1][r] - mnew) * DSA_SCALE);
        psum += e0 + e1;
        pa[s2][r] = (short)f2bf(e0); pa[s2][4 + r] = (short)f2bf(e1);
      }
    }
    lrun = lrun * alpha + psum;
    float al[4];
#pragma unroll
    for (int r = 0; r < 4; ++r) al[r] = __shfl(alpha, r);
#pragma unroll
    for (int dt = 0; dt < 4; ++dt)
#pragma unroll
      for (int r = 0; r < 4; ++r) oacc[dt][r] *= al[r];
#pragma unroll
    for (int s2 = 0; s2 < 2; ++s2) {
      __builtin_amdgcn_wave_barrier();
#pragma unroll
      for (int it = 0; it < 2; ++it) {
        u32 a0, a1, a2, a3, b0, b1, b2, b3;
        fp8x4_to_bf16(vc[s2][it][0], a0, a1); fp8x4_to_bf16(vc[s2][it][1], a2, a3);
        fp8x4_to_bf16(vc[s2][it][2], b0, b1); fp8x4_to_bf16(vc[s2][it][3], b2, b3);
        u32x4 w0 = {a0, a1, a2, a3}, w1 = {b0, b1, b2, b3};
        u16* vd = vs + (it * 16 + (lane >> 2)) * 64 + (lane & 3) * 16;
        *(u32x4*)vd = w0; *(u32x4*)(vd + 8) = w1;
      }
      __builtin_amdgcn_fence(__ATOMIC_RELEASE, "wavefront");
      __builtin_amdgcn_wave_barrier();
      __builtin_amdgcn_fence(__ATOMIC_ACQUIRE, "wavefront");
#pragma unroll
      for (int dt = 0; dt < 4; ++dt) {
        int q = i16 >> 2, pq = i16 & 3;
        const u16* a0 = vs + (4 * g4 + q) * 64 + dt * 16 + 4 * pq;
        const u16* a1 = vs + (16 + 4 * g4 + q) * 64 + dt * 16 + 4 * pq;
        s16x4 lo = __builtin_bit_cast(s16x4, __builtin_amdgcn_ds_read_tr16_b64_v4i16((lds_v4p)(a0)));
        s16x4 hi = __builtin_bit_cast(s16x4, __builtin_amdgcn_ds_read_tr16_b64_v4i16((lds_v4p)(a1)));
        bf16x8 bv = {lo[0], lo[1], lo[2], lo[3], hi[0], hi[1], hi[2], hi[3]};
        oacc[dt] = __builtin_amdgcn_mfma_f32_16x16x32_bf16(pa[s2], bv, oacc[dt], 0, 0, 0);
      }
    }
#pragma unroll
    for (int tt = 0; tt < 4; ++tt) { kc[tt][0] = kn[tt][0]; kc[tt][1] = kn[tt][1]; }
#pragma unroll
    for (int s2 = 0; s2 < 2; ++s2) { vc[s2][0] = vn[s2][0]; vc[s2][1] = vn[s2][1]; }
    if (c == nchunk - 1) {
      float sum = lrun;
      sum += __shfl_xor(sum, 16); sum += __shfl_xor(sum, 32);
      float inv[4];
#pragma unroll
      for (int r = 0; r < 4; ++r) inv[r] = 1.f / __shfl(sum, r);
      __builtin_amdgcn_wave_barrier();
      if (lane < 16) {
#pragma unroll
        for (int r = 0; r < 4; ++r)
#pragma unroll
          for (int dt = 0; dt < 4; ++dt) vs[r * 64 + dt * 16 + lane] = f2bf(oacc[dt][r] * inv[r]);
      }
      __builtin_amdgcn_fence(__ATOMIC_RELEASE, "wavefront");
      __builtin_amdgcn_wave_barrier();
      __builtin_amdgcn_fence(__ATOMIC_ACQUIRE, "wavefront");
      if (lane < 32 && !dry) {
        size_t o = (size_t)m * NCOL + g * 256 + lane * 8;
        u32x4 ov = *(const u32x4*)(vs + lane * 8);
        u32x4 zv = *(const u32x4*)(p.P + o + C_DZ);
        u32x4 rv;
#pragma unroll
        for (int k = 0; k < 4; ++k) {
          float o0 = bf2f((u16)(ov[k] & 0xffff)), o1 = bf2f((u16)(ov[k] >> 16));
          float z0 = bf2f((u16)(zv[k] & 0xffff)), z1 = bf2f((u16)(zv[k] >> 16));
          rv[k] = pack2(o0 * siluf_(z0), o1 * siluf_(z1));
        }
        *(u32x4*)(p.P + o + C_DQ) = rv;
      }
      __builtin_amdgcn_wave_barrier();

      mrun = -3.0e38f; lrun = 0.f;
#pragma unroll
      for (int dt = 0; dt < 4; ++dt) oacc[dt] = f32x4{0.f, 0.f, 0.f, 0.f};
      bq0 = bn0; bq1 = bn1;
      c = 0; ++u;
    } else ++c;
  }
}

__device__ __forceinline__ void phase_att(const Params& p, int pass, char* lds, bool dry, unsigned xcc) {
  const int tid = TIDX, lane = tid & 63, w = tid >> 6;
  u16* sl = (u16*)lds + w * 512;
  u16* vs = (u16*)(lds + 4096) + w * (32 * 64);
  int* item = (int*)(lds + 4096 + 4 * 4096);
  const int ngroups = 1024 + (pass == 1 ? 32 : 0);
  unsigned* ctr = p.bar + XCD_BAR_WORDS + (dry ? 16 : 0) + pass * 4;
  int gsel = (int)(xcc & 3u);
  int tries = 0;
  while (tries < 4) {
    __syncthreads();
    if (tid == 0) *item = (int)atomicAdd(&ctr[gsel], 1u);
    __syncthreads();
    int it = *item;
    if (it >= ngroups) { gsel = (gsel + 1) & 3; ++tries; continue; }
    int row0, nsel; const u8* kv;
    if (it < 1024) {
      int c = it >> 2;
      row0 = 16 + 16 * it; int n = 80 + 64 * c; nsel = n < 256 ? n : 256;
      kv = p.KV8P;
    } else {
      int sb = it - 1024;
      row0 = SEQP + 16 * sb; nsel = 256;
      kv = p.KV8S + (size_t)sb * NKEYS_S * 512;
    }
    att_item(p, row0 + 4 * w, gsel, nsel, kv, sl, vs, dry);
  }
}

__device__ __forceinline__ void phase_dsa(const Params& p, int pass, char* lds, bool dry) {
  int ntiles = 512 + (pass == 1 ? 32 : 0);
  for (int t = blockIdx.x; t < ntiles; t += gridDim.x) {
    DTile T;
    if (t < 512) {
      int c = t >> 2, qq = t & 3;
      int chh = 255 - c, cl = c;
      T.qrow0 = 16 + 64 * chh + 16 * qq; T.nkeys0 = 80 + 64 * chh;
      T.qrow1 = 16 + 64 * cl + 16 * qq;  T.nkeys1 = 80 + 64 * cl;
      T.ki = p.KI; T.ki_stride = 64;
      T.kv = nullptr; T.kv_stride = 0;
    } else {
      int sb = t - 512;
      T.qrow0 = SEQP + 16 * sb; T.nkeys0 = NKEYS_S;
      T.qrow1 = SEQP + 16 * sb; T.nkeys1 = 0;
      T.ki = p.KIS + (size_t)sb * NKEYS_S * 64; T.ki_stride = 64;
      T.kv = nullptr; T.kv_stride = 0;
    }
    dsa_tile(p, T, lds, dry);
  }
}

template <int BR>
__device__ __forceinline__ void merge_half(const Params& p, int R, int m0, int n0, char* ldsc, bool dry) {
  const int tid = TIDX, lane = tid & 63, w = tid >> 6, wm = w >> 1, wn = w & 1;
  u16* lds = (u16*)ldsc;
  f32x16 acc[2][2];
#pragma unroll
  for (int i = 0; i < 2; ++i)
#pragma unroll
    for (int j = 0; j < 2; ++j)
#pragma unroll
      for (int r = 0; r < 16; ++r) acc[i][j][r] = 0.f;
  gemm_core(p.P + (BR == 0 ? C_GV : C_DQ), NCOL, m0, R, BR == 0 ? p.WglaT : p.WdsaT, DM, n0, DM, acc, lds);
#pragma unroll
  for (int tm = 0; tm < 2; ++tm)
#pragma unroll
    for (int tn = 0; tn < 2; ++tn)
#pragma unroll
      for (int r = 0; r < 16; ++r)
        lds[ACC_ROW(wm, tm, r, lane) * ES + ACC_COL(wn, tn, lane)] = f2bf(acc[tm][tn][r]);
  __syncthreads();
  const int ch = tid & 15;
  float gb[8];
#pragma unroll
  for (int k = 0; k < 8; ++k) gb[k] = p.gate_b[(BR == 0 ? 0 : DM) + n0 + ch * 8 + k];
#pragma unroll
  for (int i = 0; i < 8; ++i) {
    int row = (tid >> 4) + 16 * i;
    if (m0 + row < R && !dry) {
      size_t o = (size_t)(m0 + row) * NCOL + n0 + ch * 8;
      uint4 yv = *(const uint4*)(lds + row * ES + ch * 8);
      uint4 mv = *(const uint4*)(p.P + o + (BR == 0 ? C_MA : C_MB));
      uint4 pv = make_uint4(0, 0, 0, 0);
      if (BR == 1) pv = *(const uint4*)(p.P + o + C_MA);
      u32 yw[4] = {yv.x, yv.y, yv.z, yv.w}, mw[4] = {mv.x, mv.y, mv.z, mv.w}, pw[4] = {pv.x, pv.y, pv.z, pv.w}, ow[4];
#pragma unroll
      for (int k = 0; k < 4; ++k) {
        float y0 = bf2f((u16)(yw[k] & 0xffff)), y1 = bf2f((u16)(yw[k] >> 16));
        float g0 = sigmoidf_(bf2f((u16)(mw[k] & 0xffff)) + gb[2 * k]), g1 = sigmoidf_(bf2f((u16)(mw[k] >> 16)) + gb[2 * k + 1]);
        float r0 = g0 * y0, r1 = g1 * y1;
        if (BR == 1) { r0 += bf2f((u16)(pw[k] & 0xffff)); r1 += bf2f((u16)(pw[k] >> 16)); }
        ow[k] = pack2(r0, r1);
      }
      *(uint4*)(p.P + o + C_MA) = make_uint4(ow[0], ow[1], ow[2], ow[3]);
    }
  }
  __syncthreads();
}
__device__ __forceinline__ void phase_merge(const Params& p, int pass, char* lds, bool dry) {
  int R = pass_rows(pass);
  int mt = (R + 127) >> 7;
  unsigned* ctr = p.bar + XCD_BAR_WORDS + 72 + (dry ? 8 : 0) + pass;
  for (int t = dq_next(ctr, lds); t < mt * 8; t = dq_next(ctr, lds)) {
    int tn_ = t & 7, tm_ = t >> 3;
    int m0 = tm_ * 128, n0 = tn_ * 128;
    merge_half<0>(p, R, m0, n0, lds, dry);
    merge_half<1>(p, R, m0, n0, lds, dry);
  }
}

__device__ __forceinline__ void phase_out(const Params& p, int pass, char* lds) {
  int R = pass_rows(pass), r0 = pass_row0(pass);
  int mt = (R + 127) >> 7;
  int lane = TIDX & 63, w = TIDX >> 6, wm = w >> 1, wn = w & 1;
  unsigned* ctr = p.bar + XCD_BAR_WORDS + 88 + pass;
  for (int t = dq_next(ctr, lds); t < mt * 8; t = dq_next(ctr, lds)) {
    int tn_ = t & 7, tm_ = t >> 3;
    int m0 = tm_ * 128, n0 = tn_ * 128;
    f32x16 acc[2][2];
#pragma unroll
    for (int i = 0; i < 2; ++i)
#pragma unroll
      for (int j = 0; j < 2; ++j)
#pragma unroll
        for (int r = 0; r < 16; ++r) acc[i][j][r] = 0.f;
    gemm_core(p.P + C_MA, NCOL, m0, R, p.WoutT, DM, n0, DM, acc, (u16*)lds);
#pragma unroll
    for (int tm = 0; tm < 2; ++tm)
#pragma unroll
      for (int r = 0; r < 16; ++r) {
        int m = m0 + ACC_ROW(wm, tm, r, lane);
        if (m < R) {
          int gr = r0 + m;
          float* y = yrow_ptr(p, gr);
          if (y) {
            const float* x = xrow_ptr(p, gr);
            float mu = p.STATS[gr * 2], rstd = p.STATS[gr * 2 + 1];
#pragma unroll
            for (int tn = 0; tn < 2; ++tn) {
              int n = n0 + ACC_COL(wn, tn, lane);
              float hh = (x[n] - mu) * rstd * p.ln_in_g[n] + p.ln_in_b[n];
              y[n] = ALPHA_F * hh + acc[tm][tn][r];
            }
          }
        }
      }
  }
}

__device__ __forceinline__ void phase_ln_out(const Params& p, int pass, bool dry) {
  int R = pass_rows(pass), r0 = pass_row0(pass);
  int wave = TIDX >> 6, lane = TIDX & 63;
  for (int m = blockIdx.x * 4 + wave; m < R; m += gridDim.x * 4) {
    float* y = yrow_ptr(p, r0 + m);
    if (!y) continue;
    float4 v[4];
    float s = 0.f;
#pragma unroll
    for (int i = 0; i < 4; ++i) { v[i] = *(const float4*)(y + i * 256 + lane * 4); s += v[i].x + v[i].y + v[i].z + v[i].w; }
    float mu = wave_sum(s) * (1.f / DM);
    float q = 0.f;
#pragma unroll
    for (int i = 0; i < 4; ++i) {
      float a = v[i].x - mu, b = v[i].y - mu, c = v[i].z - mu, d = v[i].w - mu;
      q += a * a + b * b + c * c + d * d;
    }
    float rstd = rsqrtf(wave_sum(q) * (1.f / DM) + NORM_EPS);
#pragma unroll
    for (int i = 0; i < 4; ++i) {
      int c = i * 256 + lane * 4;
      float4 g = *(const float4*)(p.ln_g + c), b = *(const float4*)(p.ln_b + c);
      float4 o;
      o.x = (v[i].x - mu) * rstd * g.x + b.x; o.y = (v[i].y - mu) * rstd * g.y + b.y;
      o.z = (v[i].z - mu) * rstd * g.z + b.z; o.w = (v[i].w - mu) * rstd * g.w + b.w;
      if (!dry) *(float4*)(y + c) = o;
    }
  }
}

#define LDS_BYTES 77824
#define NPHASE 9
#ifndef PHASE_MASK
#define PHASE_MASK 0x7ff
#endif
#define EN(x) (((PHASE_MASK) >> (x)) & 1)
__device__ __forceinline__ void run_phase(const Params& p, int pass, int ph, char* lds, bool dry = false, unsigned xcc = 0) {
  switch (ph) {
    case 0: if (EN(0)) { if (pass == 0) phase_prep(p, lds); phase_ln_in(p, pass); } break;
    case 1: if (EN(1)) phase_gemm1(p, pass, lds, xcc); break;
    case 2: if (EN(2)) phase_tok(p, pass, lds, dry); break;
    case 3: if (EN(3)) phase_u(p, pass, lds); break;
    case 4: if (EN(4)) phase_scan(p, pass, dry); break;
    case 5: if (EN(5)) phase_dsa(p, pass, lds, dry); break;
    case 9: if (EN(9)) phase_o(p, pass, lds, dry); break;
    case 10: if (EN(10)) phase_att(p, pass, lds, dry, xcc); break;
    case 6: if (EN(6)) phase_merge(p, pass, lds, dry); break;
    case 7: if (EN(7)) phase_out(p, pass, lds); break;
    case 8: if (EN(8)) phase_ln_out(p, pass, dry); break;
  }
}

#if ONE_LAUNCH
#ifndef PROBE_BAR2
#define PROBE_BAR2 0
#endif
#define XBAR do { xcd_barrier(xb); if (PROBE_BAR2) xcd_barrier(xb); } while (0)
#ifndef PROBE_REP
#define PROBE_REP 0
#endif
#define RUNP(ph) do { if ((PROBE_REP >> (ph)) & 1) run_phase(p, pass, ph, lds, true, xb.x); run_phase(p, pass, ph, lds, false, xb.x); } while (0)
__global__ void __launch_bounds__(256, 2) fwd_kernel(Params p) {
  __shared__ __attribute__((aligned(16))) char lds[LDS_BYTES];
  __shared__ uint4 xb_words;
  cg::grid_group grid = cg::this_grid();
  if (threadIdx.x == 0) xb_words = make_uint4(0u, 0u, 0u, 0u);
  __syncthreads();
  XcdBarrier xb = xcd_barrier_post(p.bar, (volatile LAS unsigned*)&xb_words);
#pragma unroll 1
  for (int pass = 0; pass < 2; ++pass) {
    RUNP(0);
    if (pass == 0) grid.sync(); else XBAR;
    RUNP(1); XBAR;
    RUNP(2); XBAR;
    RUNP(3); XBAR;
    RUNP(4); XBAR;
    RUNP(5);
    RUNP(9); XBAR;
    RUNP(10); XBAR;
    RUNP(6); XBAR;
    RUNP(7); XBAR;
    RUNP(8);
  }
}
#else
template <int PH>
__global__ void __launch_bounds__(256, 2) phase_kernel(Params p, int pass) {
  __shared__ __attribute__((aligned(16))) char lds[LDS_BYTES];
  run_phase(p, pass, PH, lds, false, xb_xcc_id());
}
#endif

static inline size_t align_up(size_t x) { return (x + 255) & ~(size_t)255; }

extern "C" void kernel_launch(void* const* d_in, const int* in_sizes, int n_in, void* d_out, int out_size,
                              void* d_ws, size_t ws_size, hipStream_t stream) {
  Params p{};
  const float* const* in = (const float* const*)d_in;
  p.x_prompt = in[0]; p.x_sample = in[1]; p.cache_k = in[2]; p.cache_v = in[3]; p.cache_idx_k = in[4];
  p.state_gla = in[5]; p.meta = in[6]; p.ln_in_g = in[7]; p.ln_in_b = in[8]; p.w_in = in[9]; p.gla_w2 = in[10];
  p.gla_gate_b = in[11]; p.gla_norm_g = in[12]; p.idx_kn_g = in[13]; p.idx_kn_b = in[14]; p.w_gla = in[15];
  p.w_dsa = in[16]; p.gate_b = in[17]; p.w_out = in[18]; p.ln_g = in[19]; p.ln_b = in[20];
  float* o = (float*)d_out;
  p.y_prompt = o; o += (size_t)2 * 16384 * 1024;
  p.y_sample = o; o += (size_t)32 * 16 * 1024;
  p.k_prompt = o; o += (size_t)2 * SEQP * 256;
  p.v_prompt = o; o += (size_t)2 * SEQP * 256;
  p.idx_k_prompt = o; o += (size_t)2 * SEQP * 64;
  p.gla_prompt = o; o += (size_t)2 * 131072;
  p.k_sample = o; o += (size_t)512 * 256;
  p.v_sample = o; o += (size_t)512 * 256;
  p.idx_k_sample = o; o += (size_t)512 * 64;
  p.gla_sample = o; o += (size_t)32 * 131072;
  char* wsp = (char*)d_ws;
  size_t off = 0;
  auto take = [&](size_t bytes) { char* r = wsp + off; off = align_up(off + bytes); return r; };
  p.WinT = (u16*)take((size_t)NCOL * DM * 2);
  p.WglaT = (u16*)take((size_t)DM * DM * 2);
  p.WdsaT = (u16*)take((size_t)DM * DM * 2);
  p.WoutT = (u16*)take((size_t)DM * DM * 2);
  p.H = (u16*)take((size_t)RPMAX * DM * 2);
  p.P = (u16*)take((size_t)(RPMAX + 8) * NCOL * 2);
  p.KI = (u16*)take((size_t)RPMAX * 64 * 2);
  p.US = (u16*)take((size_t)289 * 131072 * 2);
  p.KV8S = (u8*)take((size_t)32 * NKEYS_S * 512);
  p.KV8P = (u8*)take((size_t)SEQP * 512);
  p.KIS = (u16*)take((size_t)32 * NKEYS_S * 64 * 2);
  p.SEL = (u16*)take((size_t)RPMAX * 256 * 2);
  p.STATS = (float*)take((size_t)NROWS * 2 * 4);
  p.PS = (float*)take((size_t)RPMAX * 128 * 4);
  p.DEC = (float*)take((size_t)289 * 512 * 4);
  p.bar = (unsigned*)take((size_t)(XCD_BAR_WORDS + 128) * 4);
  if (off > ws_size) { fprintf(stderr, "workspace too small: need %zu have %zu\n", off, ws_size); return; }
#if ONE_LAUNCH
  static int grid_blocks = 0;
  if (!grid_blocks) {
    int dev = 0, cus = 0, per_cu = 0;
    hipGetDevice(&dev);
    hipDeviceGetAttribute(&cus, hipDeviceAttributeMultiprocessorCount, dev);
    hipOccupancyMaxActiveBlocksPerMultiprocessor(&per_cu, fwd_kernel, 256, 0);
    per_cu = 2;
    grid_blocks = cus * per_cu;
  }
  (void)hipMemsetAsync(p.bar, 0, (size_t)(XCD_BAR_WORDS + 128) * 4, stream);
  void* args[] = {&p};
  hipError_t e = hipLaunchCooperativeKernel((void*)fwd_kernel, dim3(grid_blocks), dim3(256), args, 0, stream);
  if (e != hipSuccess) fprintf(stderr, "cooperative launch failed: %s (grid %d)\n", hipGetErrorString(e), grid_blocks);
#else
  (void)hipMemsetAsync(p.bar, 0, (size_t)(XCD_BAR_WORDS + 128) * 4, stream);
  for (int pass = 0; pass < 2; ++pass) {
    phase_kernel<0><<<512, 256, 0, stream>>>(p, pass);
    phase_kernel<1><<<512, 256, 0, stream>>>(p, pass);
    phase_kernel<2><<<512, 256, 0, stream>>>(p, pass);
    phase_kernel<3><<<512, 256, 0, stream>>>(p, pass);
    phase_kernel<4><<<512, 256, 0, stream>>>(p, pass);
    phase_kernel<5><<<512, 256, 0, stream>>>(p, pass);
    phase_kernel<10><<<512, 256, 0, stream>>>(p, pass);
    phase_kernel<9><<<512, 256, 0, stream>>>(p, pass);
    phase_kernel<6><<<512, 256, 0, stream>>>(p, pass);
    phase_kernel<7><<<512, 256, 0, stream>>>(p, pass);
    phase_kernel<8><<<512, 256, 0, stream>>>(p, pass);
  }
#endif
}
```

```cpp
#include <hip/hip_runtime.h>
#include <hip/hip_bf16.h>
#include <hip/hip_cooperative_groups.h>
#include <stdint.h>
#include <stdio.h>
namespace cg = cooperative_groups;

typedef unsigned short u16;
typedef unsigned char u8;
typedef uint32_t u32;
typedef __attribute__((ext_vector_type(8))) short bf16x8;
typedef __attribute__((ext_vector_type(4))) short s16x4;
typedef __attribute__((ext_vector_type(4))) float f32x4;
typedef __attribute__((ext_vector_type(16))) float f32x16;
typedef short v4i16_t __attribute__((ext_vector_type(4)));
typedef __attribute__((ext_vector_type(4))) unsigned int u32x4;
typedef __attribute__((address_space(3))) v4i16_t* lds_v4p;

#ifndef ONE_LAUNCH
#define ONE_LAUNCH 1
#endif

#define DM 1024
#define SEQP 16400
#define NPROMPT_ROWS 32800
#define NROWS 33312
#define RPMAX 16912
#define NCOL 8320
#define C_GQ 0
#define C_GK 512
#define C_GV 1024
#define C_GR 2048
#define C_DQ 3072
#define C_DK 4096
#define C_DV 4352
#define C_IQ 4608
#define C_DZ 5120
#define C_MA 6144
#define C_MB 7168
#define C_SM 8192
#define NKEYS_S 2064
#define CAP 576
#define CLIMIT 544
#define CVN 9
#define NORM_EPS 1e-5f
#define ALPHA_F 1.189207115002721f
#define IDX_W_SCALE 0.04419417382415922f
#define GLA_QSCALE 0.08838834764831845f
#define DSA_SCALE 0.125f

struct Params {
  const float *x_prompt, *x_sample, *cache_k, *cache_v, *cache_idx_k, *state_gla, *meta, *ln_in_g, *ln_in_b,
      *w_in, *gla_w2, *gla_gate_b, *gla_norm_g, *idx_kn_g, *idx_kn_b, *w_gla, *w_dsa, *gate_b, *w_out, *ln_g, *ln_b;
  float *y_prompt, *y_sample, *k_prompt, *v_prompt, *idx_k_prompt, *gla_prompt, *k_sample, *v_sample, *idx_k_sample, *gla_sample;
  u16 *WinT, *WglaT, *WdsaT, *WoutT, *H, *P, *KI, *US, *KIS, *SEL;
  u8 *KV8S, *KV8P;
  float *STATS, *PS, *DEC;
  unsigned* bar;
};

#define XB_TMO      128
#define XB_XCNT(j)  (256  + 64 * (j))
#define XB_XSUB(j)  (1280 + 64 * (j))
#define XB_XGEN(j)  (2304 + 64 * (j))
#define XB_TOP      3328
#define XB_TOPGEN   3392
#define XCD_BAR_WORDS 3456
#define XB_SPIN_CAP (1u << 22)
#define LAS __attribute__((address_space(3)))
__device__ __forceinline__ unsigned xb_ld(unsigned* p)              { return __hip_atomic_load(p, __ATOMIC_RELAXED, __HIP_MEMORY_SCOPE_AGENT); }
__device__ __forceinline__ unsigned xb_add(unsigned* p, unsigned v) { return __hip_atomic_fetch_add(p, v, __ATOMIC_RELAXED, __HIP_MEMORY_SCOPE_AGENT); }
__device__ __forceinline__ unsigned xb_xcc_id() { return (unsigned)__builtin_amdgcn_s_getreg((3 << 11) | 20) & 0xFu; }
#define XB_SPIN(cond, bar) do { unsigned _sp = 0; while (cond) { __builtin_amdgcn_s_sleep(1); \
    if ((++_sp & 255u) == 0u) { if (xb_ld(&(bar)[XB_TMO])) break; if (_sp > XB_SPIN_CAP) { atomicAdd(&(bar)[XB_TMO], 1u); break; } } } } while (0)
struct XcdBarrier { unsigned* bar; unsigned x; volatile LAS unsigned* st; };
__device__ __forceinline__ XcdBarrier xcd_barrier_post(unsigned* bar, volatile LAS unsigned* st) {
    XcdBarrier b; b.bar = bar; b.x = xb_xcc_id(); b.st = st;
    if (threadIdx.x == 0) (void)xb_add(&bar[XB_XCNT(b.x)], 1u);
    return b;
}
__device__ __forceinline__ void xcd_barrier_complete(unsigned* bar, unsigned x, unsigned& nloc, unsigned& nx) {
    const unsigned G = gridDim.x * gridDim.y * gridDim.z;
    unsigned sum, cnt, mine, sp = 0u;
    for (;;) {
        sum = 0u; cnt = 0u; mine = 0u;
#pragma unroll
        for (unsigned j = 0; j < 16; ++j) { const unsigned c = xb_ld(&bar[XB_XCNT(j)]); sum += c; cnt += (c > 0u) ? 1u : 0u; mine = (j == x) ? c : mine; }
        if (sum == G) break;
        __builtin_amdgcn_s_sleep(1);
        if ((++sp & 255u) == 0u) { if (xb_ld(&bar[XB_TMO])) break; if (sp > XB_SPIN_CAP) { atomicAdd(&bar[XB_TMO], 1u); break; } }
    }
    nloc = mine > 0u ? mine : 1u; nx = cnt > 0u ? cnt : 1u;
}
__device__ __forceinline__ void xcd_barrier(const XcdBarrier& b) {
    asm volatile("s_waitcnt vmcnt(0)" ::: "memory");
    __syncthreads();
    if (threadIdx.x == 0) {
        unsigned* bar = b.bar;
        __builtin_amdgcn_s_waitcnt(0);
        unsigned nloc = b.st[0], nx = b.st[1];
        if (nloc == 0u) { xcd_barrier_complete(bar, b.x, nloc, nx); b.st[0] = nloc; b.st[1] = nx; }
        const unsigned old = xb_add(&bar[XB_XSUB(b.x)], 1u);
        const unsigned gen = old / nloc;
        if (old + 1u == (gen + 1u) * nloc) {
            __builtin_amdgcn_fence(__ATOMIC_RELEASE, "agent");
            asm volatile("s_waitcnt vmcnt(0)" ::: "memory");
            const unsigned og = xb_add(&bar[XB_TOP], 1u);
            const unsigned tg = og / nx;
            if (og + 1u == (tg + 1u) * nx) xb_add(&bar[XB_TOPGEN], 1u);
            else XB_SPIN(xb_ld(&bar[XB_TOPGEN]) == tg, bar);
            __builtin_amdgcn_fence(__ATOMIC_ACQUIRE, "agent");
            xb_add(&bar[XB_XGEN(b.x)], 1u);
            asm volatile("s_waitcnt vmcnt(0)" ::: "memory");
        } else {
            XB_SPIN(xb_ld(&bar[XB_XGEN(b.x)]) == gen, bar);
            __builtin_amdgcn_fence(__ATOMIC_ACQUIRE, "agent");
            asm volatile("s_waitcnt vmcnt(0)" ::: "memory");
        }
    }
    __syncthreads();
}

__device__ __forceinline__ int tid_opaque() { int t = threadIdx.x; asm volatile("" : "+v"(t)); return t; }
#define TIDX tid_opaque()
__device__ __forceinline__ u16 f2bf(float f) {
  u32 u = __float_as_uint(f);
  u += 0x7fffu + ((u >> 16) & 1u);
  return (u16)(u >> 16);
}
__device__ __forceinline__ float bf2f(u16 h) { return __uint_as_float(((u32)h) << 16); }
__device__ __forceinline__ u32 pack2(float a, float b) { return (u32)f2bf(a) | ((u32)f2bf(b) << 16); }
__device__ __forceinline__ float relu1(float x) { float r; asm("v_max_f32 %0, 0, %1" : "=v"(r) : "v"(x)); return r; }
__device__ __forceinline__ u32 cvt_pk_bf16(float lo, float hi) { u32 r; asm("v_cvt_pk_bf16_f32 %0, %1, %2" : "=v"(r) : "v"(lo), "v"(hi)); return r; }
__device__ __forceinline__ u32 pk4_fp8(float a, float b, float c, float d) {
  int r = __builtin_amdgcn_cvt_pk_fp8_f32(a, b, 0, false);
  r = __builtin_amdgcn_cvt_pk_fp8_f32(c, d, r, true);
  return (u32)r;
}
__device__ __forceinline__ void fp8x4_to_bf16(u32 x, u32& lo, u32& hi) {
  auto a = __builtin_amdgcn_cvt_pk_f32_fp8((int)x, false);
  auto b = __builtin_amdgcn_cvt_pk_f32_fp8((int)x, true);
  lo = cvt_pk_bf16(a[0], a[1]); hi = cvt_pk_bf16(b[0], b[1]);
}
__device__ __forceinline__ float sigmoidf_(float x) { return 1.f / (1.f + __expf(-x)); }
__device__ __forceinline__ float siluf_(float x) { return x / (1.f + __expf(-x)); }

__device__ __forceinline__ float wave_sum(float v) {
#pragma unroll
  for (int o = 32; o > 0; o >>= 1) v += __shfl_xor(v, o);
  return v;
}

__device__ __forceinline__ const float* xrow_ptr(const Params& p, int gr) {
  if (gr < NPROMPT_ROWS) {
    int b = gr / SEQP, pos = gr - b * SEQP;
    return pos < 16 ? p.meta + pos * DM : p.x_prompt + ((size_t)b * 16384 + (pos - 16)) * DM;
  }
  return p.x_sample + (size_t)(gr - NPROMPT_ROWS) * DM;
}
__device__ __forceinline__ float* yrow_ptr(const Params& p, int gr) {
  if (gr < NPROMPT_ROWS) {
    int b = gr / SEQP, pos = gr - b * SEQP;
    return pos < 16 ? nullptr : p.y_prompt + ((size_t)b * 16384 + (pos - 16)) * DM;
  }
  return p.y_sample + (size_t)(gr - NPROMPT_ROWS) * DM;
}

__device__ __forceinline__ int src_col(int n) {
  if (n < 2048) return n;
  if (n < 3072) return n - 2048 + 2064;
  if (n < 4096) return n - 3072 + 3088;
  if (n < 4352) return n - 4096 + 4112;
  if (n < 4608) return n - 4352 + 4368;
  if (n < 5120) return n - 4608 + 4624;
  if (n < 6144) return n - 5120 + 5208;
  if (n < 7168) return n - 6144 + 6232;
  if (n < 8192) return n - 7168 + 7256;
  if (n < 8256) return n - 8192 + 5136;
  if (n < 8272) return n - 8256 + 2048;
  if (n < 8280) return n - 8272 + 5200;
  return -1;
}

__device__ __forceinline__ int pass_row0(int pass) { return pass == 0 ? 0 : SEQP; }
__device__ __forceinline__ int pass_rows(int pass) { return pass == 0 ? SEQP : RPMAX; }
__device__ __forceinline__ int pass_nblk(int pass) { return pass == 0 ? 257 : 289; }
__device__ __forceinline__ void blk_info(int blk, int& row0, int& len) {
  if (blk < 257) { row0 = blk * 64; len = (blk == 256) ? 16 : 64; }
  else { row0 = SEQP + 16 * (blk - 257); len = 16; }
}

__device__ __forceinline__ int dq_next(unsigned* ctr, char* lds) {
  int* item = (int*)(lds + 77808);
  __syncthreads();
  if (TIDX == 0) *item = (int)atomicAdd(ctr, 1u);
  __syncthreads();
  return *item;
}

__device__ __forceinline__ void transpose_tile(const float* __restrict__ src, int nsrc, u16* __restrict__ dst, int k0, int n0, bool map, float* tile) {
  int tx = TIDX & 63, ty = TIDX >> 6;
  int sc = map ? src_col(n0 + tx) : (n0 + tx);
  for (int kk = ty; kk < 64; kk += 4) tile[kk * 65 + tx] = sc >= 0 ? src[(size_t)(k0 + kk) * nsrc + sc] : 0.f;
  __syncthreads();
  for (int nn = ty; nn < 64; nn += 4) dst[(size_t)(n0 + nn) * DM + k0 + tx] = f2bf(tile[tx * 65 + nn]);
  __syncthreads();
}

__device__ __forceinline__ void phase_prep(const Params& p, char* lds) {
  float* tile = (float*)lds;
  const int nt_in = 130 * 16;
  const int nt_all = nt_in + 3 * 256;
  for (int t = blockIdx.x; t < nt_all; t += gridDim.x) {
    if (t < nt_in) {
      transpose_tile(p.w_in, 8280, p.WinT, (t & 15) * 64, (t >> 4) * 64, true, tile);
    } else {
      int u = t - nt_in, w = u >> 8, r = u & 255;
      const float* s = w == 0 ? p.w_gla : (w == 1 ? p.w_dsa : p.w_out);
      u16* d = w == 0 ? p.WglaT : (w == 1 ? p.WdsaT : p.WoutT);
      transpose_tile(s, DM, d, (r & 15) * 64, (r >> 4) * 64, false, tile);
    }
  }
  const size_t nk4 = (size_t)32 * 2048 * 256 / 4;
  size_t stride = (size_t)gridDim.x * blockDim.x;
  for (size_t i = (size_t)blockIdx.x * blockDim.x + TIDX; i < nk4; i += stride) {
    size_t e = i * 4; size_t row = e >> 8; int c = (int)(e & 255);
    size_t sb = row >> 11, j = row & 2047;
    float4 kv = *(const float4*)(p.cache_k + e);
    float4 vv = *(const float4*)(p.cache_v + e);
    u8* o = p.KV8S + (sb * NKEYS_S + j) * 512 + (c >> 6) * 128 + (c & 63);
    *(u32*)o = pk4_fp8(kv.x, kv.y, kv.z, kv.w);
    *(u32*)(o + 64) = pk4_fp8(vv.x, vv.y, vv.z, vv.w);
  }
  const size_t ni4 = (size_t)32 * 2048 * 64 / 4;
  for (size_t i = (size_t)blockIdx.x * blockDim.x + TIDX; i < ni4; i += stride) {
    size_t e = i * 4; size_t row = e >> 6; int c = (int)(e & 63);
    size_t sb = row >> 11, j = row & 2047;
    float4 kv = *(const float4*)(p.cache_idx_k + e);
    *(uint2*)(p.KIS + (sb * NKEYS_S + j) * 64 + c) = make_uint2(pack2(kv.x, kv.y), pack2(kv.z, kv.w));
  }
}

__device__ __forceinline__ void phase_ln_in(const Params& p, int pass) {
  int R = pass_rows(pass), r0 = pass_row0(pass);
  int wave = TIDX >> 6, lane = TIDX & 63;
  for (int m = blockIdx.x * 4 + wave; m < R; m += gridDim.x * 4) {
    int gr = r0 + m;
    const float* x = xrow_ptr(p, gr);
    float4 v[4];
    float s = 0.f;
#pragma unroll
    for (int i = 0; i < 4; ++i) { v[i] = *(const float4*)(x + i * 256 + lane * 4); s += v[i].x + v[i].y + v[i].z + v[i].w; }
    float mu = wave_sum(s) * (1.f / DM);
    float q = 0.f;
#pragma unroll
    for (int i = 0; i < 4; ++i) {
      float a = v[i].x - mu, b = v[i].y - mu, c = v[i].z - mu, d = v[i].w - mu;
      q += a * a + b * b + c * c + d * d;
    }
    float rstd = rsqrtf(wave_sum(q) * (1.f / DM) + NORM_EPS);
#pragma unroll
    for (int i = 0; i < 4; ++i) {
      int c = i * 256 + lane * 4;
      float4 g = *(const float4*)(p.ln_in_g + c), b = *(const float4*)(p.ln_in_b + c);
      float h0 = (v[i].x - mu) * rstd * g.x + b.x, h1 = (v[i].y - mu) * rstd * g.y + b.y;
      float h2 = (v[i].z - mu) * rstd * g.z + b.z, h3 = (v[i].w - mu) * rstd * g.w + b.w;
      *(uint2*)(p.H + (size_t)m * DM + c) = make_uint2(pack2(h0, h1), pack2(h2, h3));
    }
    if (lane == 0) { p.STATS[gr * 2] = mu; p.STATS[gr * 2 + 1] = rstd; }
  }
}

#define GS 72
template <bool SWAP = false>
__device__ __forceinline__ void gemm_core(const u16* __restrict__ A, int lda, int m0, int mvalid,
                                          const u16* __restrict__ B, int ldb, int n0, int K,
                                          f32x16 (&acc)[2][2], u16* lds) {
  const int tid = TIDX, lane = tid & 63, w = tid >> 6, wm = w >> 1, wn = w & 1;
  u16* As = lds;
  u16* Bs = lds + 2 * 128 * GS;
  uint4 ra0, ra1, ra2, ra3, rb0, rb1, rb2, rb3;
  const int nk = K >> 6;
  const int lrow = tid >> 3, lch = tid & 7;
  const u16* ap[4]; const u16* bp[4];
#pragma unroll
  for (int i = 0; i < 4; ++i) {
    int ar = m0 + lrow + 32 * i; ar = ar < mvalid ? ar : mvalid - 1;
    ap[i] = A + (size_t)ar * lda + lch * 8;
    bp[i] = B + (size_t)(n0 + lrow + 32 * i) * ldb + lch * 8;
  }
#define GLOAD(kt) do { \
    ra0 = *(const uint4*)(ap[0] + (kt) * 64); ra1 = *(const uint4*)(ap[1] + (kt) * 64); \
    ra2 = *(const uint4*)(ap[2] + (kt) * 64); ra3 = *(const uint4*)(ap[3] + (kt) * 64); \
    rb0 = *(const uint4*)(bp[0] + (kt) * 64); rb1 = *(const uint4*)(bp[1] + (kt) * 64); \
    rb2 = *(const uint4*)(bp[2] + (kt) * 64); rb3 = *(const uint4*)(bp[3] + (kt) * 64); } while (0)
#define GSWRITE(buf) do { \
    u16* as_ = As + ((buf) * 128 + lrow) * GS + lch * 8; u16* bs_ = Bs + ((buf) * 128 + lrow) * GS + lch * 8; \
    *(uint4*)(as_) = ra0; *(uint4*)(as_ + 32 * GS) = ra1; *(uint4*)(as_ + 64 * GS) = ra2; *(uint4*)(as_ + 96 * GS) = ra3; \
    *(uint4*)(bs_) = rb0; *(uint4*)(bs_ + 32 * GS) = rb1; *(uint4*)(bs_ + 64 * GS) = rb2; *(uint4*)(bs_ + 96 * GS) = rb3; } while (0)
  GLOAD(0);
  GSWRITE(0);
  __syncthreads();
  for (int kt = 0; kt < nk; ++kt) {
    int buf = kt & 1;
    if (kt + 1 < nk) GLOAD(kt + 1);
    __builtin_amdgcn_sched_barrier(0);
    bf16x8 af[4][2], bf[4][2];
#pragma unroll
    for (int ks = 0; ks < 4; ++ks)
#pragma unroll
      for (int t = 0; t < 2; ++t) {
        af[ks][t] = *(const bf16x8*)(As + (buf * 128 + wm * 64 + t * 32 + (lane & 31)) * GS + ks * 16 + (lane >> 5) * 8);
        bf[ks][t] = *(const bf16x8*)(Bs + (buf * 128 + wn * 64 + t * 32 + (lane & 31)) * GS + ks * 16 + (lane >> 5) * 8);
      }
    __builtin_amdgcn_sched_barrier(0);
#pragma unroll
    for (int ks = 0; ks < 4; ++ks)
#pragma unroll
      for (int tm = 0; tm < 2; ++tm)
#pragma unroll
        for (int tn = 0; tn < 2; ++tn)
          acc[tm][tn] = SWAP ? __builtin_amdgcn_mfma_f32_32x32x16_bf16(bf[ks][tn], af[ks][tm], acc[tm][tn], 0, 0, 0)
                             : __builtin_amdgcn_mfma_f32_32x32x16_bf16(af[ks][tm], bf[ks][tn], acc[tm][tn], 0, 0, 0);
    __builtin_amdgcn_sched_barrier(0);
    if (kt + 1 < nk) GSWRITE(buf ^ 1);
    __syncthreads();
  }
}
#define ACC_ROW(wm, tm, r, lane) ((wm) * 64 + (tm) * 32 + ((r) & 3) + 8 * ((r) >> 2) + 4 * ((lane) >> 5))
#define ACC_COL(wn, tn, lane) ((wn) * 64 + (tn) * 32 + ((lane) & 31))

#define ES 136
__device__ __forceinline__ void store_tile_bf16(const f32x16 (&acc)[2][2], u16* lds, u16* __restrict__ dst, int ldd, int m0, int mvalid, int n0) {
  const int tid = TIDX, lane = tid & 63, w = tid >> 6, wm = w >> 1, wn = w & 1;
#pragma unroll
  for (int tm = 0; tm < 2; ++tm)
#pragma unroll
    for (int tn = 0; tn < 2; ++tn)
#pragma unroll
      for (int r = 0; r < 16; ++r)
        lds[ACC_ROW(wm, tm, r, lane) * ES + ACC_COL(wn, tn, lane)] = f2bf(acc[tm][tn][r]);
  __syncthreads();
#pragma unroll
  for (int i = 0; i < 8; ++i) {
    int c = tid + 256 * i, row = c >> 4, ch = c & 15;
    if (m0 + row < mvalid) *(uint4*)(dst + (size_t)(m0 + row) * ldd + n0 + ch * 8) = *(const uint4*)(lds + row * ES + ch * 8);
  }
  __syncthreads();
}

__device__ __forceinline__ void phase_gemm1(const Params& p, int pass, char* lds, unsigned xcc) {
  int R = pass_rows(pass), r0 = pass_row0(pass);
  int mt = (R + 127) >> 7;
  int lane = TIDX & 63, w = TIDX >> 6, wm = w >> 1, wn = w & 1;
  int* item = (int*)(lds + 77808);
  unsigned* ctr = p.bar + XCD_BAR_WORDS + 32 + pass * 8;
  int q = (int)(xcc & 7u), tries = 0;
  while (tries < 8) {
    __syncthreads();
    if (TIDX == 0) *item = (int)atomicAdd(&ctr[q], 1u);
    __syncthreads();
    int idx = *item;
    int nq = mt * 8 + (mt - q + 7) / 8;
    if (idx >= nq) { q = (q + 1) & 7; ++tries; continue; }
    int tm_, tn_;
    if (idx < mt * 8) { tm_ = idx >> 3; tn_ = q * 8 + (idx & 7); }
    else { tm_ = q + 8 * (idx - mt * 8); tn_ = 64; }
    int m0 = tm_ * 128, n0 = tn_ * 128;
    f32x16 acc[2][2];
#pragma unroll
    for (int i = 0; i < 2; ++i)
#pragma unroll
      for (int j = 0; j < 2; ++j)
#pragma unroll
        for (int r = 0; r < 16; ++r) acc[i][j][r] = 0.f;
    gemm_core<true>(p.H, DM, m0, R, p.WinT, DM, n0, DM, acc, (u16*)lds);
    int kind = 0;
    if (n0 >= C_DK && n0 < C_DV) kind = 1; else if (n0 >= C_DV && n0 < C_IQ) kind = 2; else if (n0 >= C_SM) kind = 3;
    const int half = lane >> 5;
#pragma unroll
    for (int tm = 0; tm < 2; ++tm) {
      int m = m0 + wm * 64 + tm * 32 + (lane & 31);
      if (kind != 3) {
#pragma unroll
        for (int tn = 0; tn < 2; ++tn)
#pragma unroll
          for (int gp = 0; gp < 2; ++gp) {
            u32 a0 = pack2(acc[tm][tn][8 * gp + 0], acc[tm][tn][8 * gp + 1]), a1 = pack2(acc[tm][tn][8 * gp + 2], acc[tm][tn][8 * gp + 3]);
            u32 b0 = pack2(acc[tm][tn][8 * gp + 4], acc[tm][tn][8 * gp + 5]), b1 = pack2(acc[tm][tn][8 * gp + 6], acc[tm][tn][8 * gp + 7]);
            auto s0 = __builtin_amdgcn_permlane32_swap(a0, b0, false, false);
            auto s1 = __builtin_amdgcn_permlane32_swap(a1, b1, false, false);
            int n = n0 + wn * 64 + tn * 32 + 8 * (2 * gp + half);
            if (m < R) *(uint4*)(p.P + (size_t)m * NCOL + n) = make_uint4(s0[0], s1[0], s0[1], s1[1]);
          }
      }
      if (kind != 0 && m < R) {
        int gr = r0 + m;
#pragma unroll
        for (int tn = 0; tn < 2; ++tn)
#pragma unroll
          for (int g = 0; g < 4; ++g) {
            int n = n0 + wn * 64 + tn * 32 + 8 * g + 4 * half;
            float4 v = make_float4(acc[tm][tn][4 * g + 0], acc[tm][tn][4 * g + 1], acc[tm][tn][4 * g + 2], acc[tm][tn][4 * g + 3]);
            if (kind == 3) {
              *(float4*)(p.PS + (size_t)m * 128 + (n - C_SM)) = v;
            } else {
              float* base = kind == 1 ? (gr < NPROMPT_ROWS ? p.k_prompt : p.k_sample) : (gr < NPROMPT_ROWS ? p.v_prompt : p.v_sample);
              int rr = gr < NPROMPT_ROWS ? gr : gr - NPROMPT_ROWS;
              *(float4*)(base + (size_t)rr * 256 + (n - (kind == 1 ? C_DK : C_DV))) = v;
            }
          }
      }
    }
  }
}

__device__ __forceinline__ void phase_tok(const Params& p, int pass, char* lds, bool dry) {
  float* glow = (float*)lds;
  int r0g = pass_row0(pass);
  int nblk = pass_nblk(pass);
  int tid = TIDX, lane = tid & 63, wave = tid >> 6;
  for (int tile = blockIdx.x; tile < nblk * 2; tile += gridDim.x) {
    int blk = tile >> 1, hf = tile & 1;
    int row0, len; blk_info(blk, row0, len);
    for (int t = wave; t < (hf == 0 ? len : 0); t += 4) {
      int m = row0 + t, gr = r0g + m;
      float x = p.PS[(size_t)m * 128 + lane];
      float mu = wave_sum(x) * (1.f / 64);
      float xc = x - mu;
      float var = wave_sum(xc * xc) * (1.f / 64);
      float y = xc * rsqrtf(var + NORM_EPS) * p.idx_kn_g[lane] + p.idx_kn_b[lane];
      u16 yb = f2bf(y);
      p.KI[(size_t)m * 64 + lane] = yb;
      if (gr < NPROMPT_ROWS) p.idx_k_prompt[(size_t)gr * 64 + lane] = y;
      else {
        int sr = gr - NPROMPT_ROWS; p.idx_k_sample[(size_t)sr * 64 + lane] = y;
        int sb = sr >> 4, tt = sr & 15;
        p.KIS[((size_t)sb * NKEYS_S + 2048 + tt) * 64 + lane] = yb;
      }
    }
    if (hf == 0) {
      u8* dst0 = blk < 257 ? p.KV8P + (size_t)row0 * 512 : p.KV8S + ((size_t)(blk - 257) * NKEYS_S + 2048) * 512;
      for (int i = tid; i < len * 64; i += 256) {
        int tt = i >> 6, c = (i & 63) * 4;
        const u16* src = p.P + (size_t)(row0 + tt) * NCOL + C_DK + c;
        uint2 kk = *(const uint2*)src, vv = *(const uint2*)(src + 256);
        u8* o = dst0 + (size_t)tt * 512 + (c >> 6) * 128 + (c & 63);
        *(u32*)o = pk4_fp8(bf2f((u16)(kk.x & 0xffff)), bf2f((u16)(kk.x >> 16)), bf2f((u16)(kk.y & 0xffff)), bf2f((u16)(kk.y >> 16)));
        *(u32*)(o + 64) = pk4_fp8(bf2f((u16)(vv.x & 0xffff)), bf2f((u16)(vv.x >> 16)), bf2f((u16)(vv.y & 0xffff)), bf2f((u16)(vv.y >> 16)));
      }
    }
    for (int i = tid; i < 64 * 16; i += 256) {
      int t = i >> 4, r = i & 15;
      glow[i] = t < len ? p.PS[(size_t)(row0 + t) * 128 + 64 + r] : 0.f;
    }
    __syncthreads();
    {
      const int ch = hf * 256 + tid;
      float w2[16];
#pragma unroll
      for (int r = 0; r < 16; ++r) w2[r] = p.gla_w2[r * 512 + ch];
      float bias = p.gla_gate_b[ch];
      float b = 0.f;
      for (int t0 = 0; t0 < len; t0 += 16) {
        u32 qr[16], kr[16];
#pragma unroll
        for (int j = 0; j < 16; ++j) {
          size_t o = (size_t)(row0 + t0 + j) * NCOL;
          qr[j] = 0u; kr[j] = 0u;
          if (t0 + j < len) { qr[j] = p.P[o + C_GQ + ch]; kr[j] = p.P[o + C_GK + ch]; }
        }
        __builtin_amdgcn_sched_barrier(0);
#pragma unroll
        for (int j = 0; j < 16; ++j) {
          const int t = t0 + j;
          if (t < len) {
            float x = bias;
#pragma unroll
            for (int r = 0; r < 16; ++r) x += glow[t * 16 + r] * w2[r];
            float ls = fminf(x, 0.f) - log1pf(expf(-fabsf(x)));
            b += ls * (1.f / 16.f);
            size_t o = (size_t)(row0 + t) * NCOL;
            float qv = bf2f((u16)qr[j]) * GLA_QSCALE * expf(b);
            float kv = bf2f((u16)kr[j]) * expf(-b);
            if (!dry) { p.P[o + C_GQ + ch] = f2bf(qv); p.P[o + C_GK + ch] = f2bf(kv); }
          }
        }
      }
      p.DEC[blk * 512 + ch] = expf(b);
    }
    __syncthreads();
  }
}

#define TS 72
template <int NIT>
__device__ __forceinline__ void stage_transposed(const u16* __restrict__ P, int row0, int len, int col0, u16* dst) {
  const int tid = TIDX, t = tid & 63, dc0 = tid >> 6;
  u32x4 v[NIT];
  const u16* src = P + (size_t)(row0 + (t < len ? t : 0)) * NCOL + col0;
#pragma unroll
  for (int i = 0; i < NIT; ++i) v[i] = *(const u32x4*)(src + (dc0 + 4 * i) * 8);
  __builtin_amdgcn_sched_barrier(0);
#pragma unroll
  for (int i = 0; i < NIT; ++i) {
    u32x4 x = v[i];
    if (t >= len) x = u32x4{0u, 0u, 0u, 0u};
    u16* d = dst + ((dc0 + 4 * i) * 8) * TS + t;
    d[0 * TS] = (u16)(x[0] & 0xffff); d[1 * TS] = (u16)(x[0] >> 16);
    d[2 * TS] = (u16)(x[1] & 0xffff); d[3 * TS] = (u16)(x[1] >> 16);
    d[4 * TS] = (u16)(x[2] & 0xffff); d[5 * TS] = (u16)(x[2] >> 16);
    d[6 * TS] = (u16)(x[3] & 0xffff); d[7 * TS] = (u16)(x[3] >> 16);
  }
}

__device__ __forceinline__ void phase_u(const Params& p, int pass, char* lds) {
  u16* KT = (u16*)lds;
  u16* VT = KT + 128 * TS;
  int nblk = pass_nblk(pass);
  int lane = TIDX & 63, w = TIDX >> 6;
  unsigned* ctr = p.bar + XCD_BAR_WORDS + 64 + pass;
  for (int t = dq_next(ctr, lds); t < nblk * 4; t = dq_next(ctr, lds)) {
    int blk = t >> 2, h = t & 3;
    int row0, len; blk_info(blk, row0, len);
    stage_transposed<4>(p.P, row0, len, C_GK + h * 128, KT);
    stage_transposed<8>(p.P, row0, len, C_GV + h * 256, VT);
    __syncthreads();
#pragma unroll
    for (int half = 0; half < 2; ++half) {
      f32x16 acc[2][2];
#pragma unroll
      for (int i = 0; i < 2; ++i)
#pragma unroll
        for (int j = 0; j < 2; ++j)
#pragma unroll
          for (int r = 0; r < 16; ++r) acc[i][j][r] = 0.f;
#pragma unroll
      for (int ks = 0; ks < 4; ++ks) {
        bf16x8 a[2], b[2];
#pragma unroll
        for (int tn = 0; tn < 2; ++tn) {
          a[tn] = *(const bf16x8*)(VT + (w * 64 + tn * 32 + (lane & 31)) * TS + ks * 16 + (lane >> 5) * 8);
          b[tn] = *(const bf16x8*)(KT + (half * 64 + tn * 32 + (lane & 31)) * TS + ks * 16 + (lane >> 5) * 8);
        }
#pragma unroll
        for (int tm = 0; tm < 2; ++tm)
#pragma unroll
          for (int tn = 0; tn < 2; ++tn)
            acc[tm][tn] = __builtin_amdgcn_mfma_f32_32x32x16_bf16(a[tm], b[tn], acc[tm][tn], 0, 0, 0);
      }
#pragma unroll
      for (int tn = 0; tn < 2; ++tn) {
        int d = half * 64 + tn * 32 + (lane & 31);
        float dec = p.DEC[blk * 512 + h * 128 + d];
#pragma unroll
        for (int tm = 0; tm < 2; ++tm)
#pragma unroll
          for (int r = 0; r < 16; ++r) {
            int e = w * 64 + tm * 32 + (r & 3) + 8 * (r >> 2) + 4 * (lane >> 5);
            p.US[((size_t)(blk * 4 + h) * 256 + e) * 128 + d] = f2bf(acc[tm][tn][r] * dec);
          }
      }
    }
    __syncthreads();
  }
}

__device__ __forceinline__ void phase_scan(const Params& p, int pass, bool dry) {
  int ntiles = 128 + (pass == 1 ? 32 * 128 : 0);
  for (int t = blockIdx.x; t < ntiles; t += gridDim.x) {
    bool samp = t >= 128;
    int sb = samp ? (t - 128) >> 7 : 0;
    int g4 = ((samp ? (t - 128) & 127 : t) << 8) + TIDX;
    int h = g4 >> 13, e = (g4 >> 5) & 255, d4 = (g4 & 31) * 4;
    float S[4];
    float* outp;
    int blk0, nb;
    if (!samp) {
      S[0] = S[1] = S[2] = S[3] = 0.f;
      outp = p.gla_prompt + (size_t)pass * 131072;
      blk0 = 0; nb = 257;
    } else {
      const float* st = p.state_gla + (size_t)sb * 131072;
#pragma unroll
      for (int j = 0; j < 4; ++j) S[j] = st[((size_t)(h * 128 + d4 + j)) * 256 + e];
      outp = p.gla_sample + (size_t)sb * 131072;
      blk0 = 257 + sb; nb = 1;
    }
    size_t eoff = (size_t)g4 * 4;
    for (int n0 = 0; n0 < nb; n0 += 8) {
      uint2 u[8]; float4 dc[8];
#pragma unroll
      for (int j = 0; j < 8; ++j) {
        int n = n0 + j; if (n < nb) {
          u[j] = *(const uint2*)(p.US + (size_t)(blk0 + n) * 131072 + eoff);
          dc[j] = *(const float4*)(p.DEC + (blk0 + n) * 512 + h * 128 + d4);
        }
      }
      __builtin_amdgcn_sched_barrier(0);
#pragma unroll
      for (int j = 0; j < 8; ++j) {
        int n = n0 + j; if (n < nb) {
          if (!dry) *(uint2*)(p.US + (size_t)(blk0 + n) * 131072 + eoff) = make_uint2(pack2(S[0], S[1]), pack2(S[2], S[3]));
          S[0] = dc[j].x * S[0] + bf2f((u16)(u[j].x & 0xffff));
          S[1] = dc[j].y * S[1] + bf2f((u16)(u[j].x >> 16));
          S[2] = dc[j].z * S[2] + bf2f((u16)(u[j].y & 0xffff));
          S[3] = dc[j].w * S[3] + bf2f((u16)(u[j].y >> 16));
        }
      }
    }
#pragma unroll
    for (int j = 0; j < 4; ++j) outp[((size_t)(h * 128 + d4 + j)) * 256 + e] = S[j];
  }
}

#define OS 264
__device__ __forceinline__ void phase_o(const Params& p, int pass, char* lds, bool dry) {
  u16* VT = (u16*)lds;
  u16* AS = VT + 256 * TS;
  u16* OT = VT;
  int nblk = pass_nblk(pass);
  int tid = TIDX, lane = tid & 63, w = tid >> 6;
  int* item = (int*)(lds + 77808);
  unsigned* ctr = p.bar + XCD_BAR_WORDS + 48 + (dry ? 8 : 0) + pass;
  for (;;) {
    __syncthreads();
    if (tid == 0) *item = (int)atomicAdd(ctr, 1u);
    __syncthreads();
    int t = *item;
    if (t >= nblk * 4) break;
    int blk = t >> 2, h = t & 3;
    int row0, len; blk_info(blk, row0, len);
    stage_transposed<8>(p.P, row0, len, C_GV + h * 256, VT);
    {
      int ti = w >> 1, tj = w & 1;
      f32x16 acc;
#pragma unroll
      for (int r = 0; r < 16; ++r) acc[r] = 0.f;
      if (tj <= ti) {
        int qi = ti * 32 + (lane & 31), kj = tj * 32 + (lane & 31);
        const u16* qp = p.P + (size_t)(row0 + (qi < len ? qi : 0)) * NCOL + C_GQ + h * 128 + (lane >> 5) * 8;
        const u16* kp = p.P + (size_t)(row0 + (kj < len ? kj : 0)) * NCOL + C_GK + h * 128 + (lane >> 5) * 8;
#pragma unroll
        for (int ks = 0; ks < 8; ++ks) {
          bf16x8 a = *(const bf16x8*)(qp + ks * 16), b = *(const bf16x8*)(kp + ks * 16);
          acc = __builtin_amdgcn_mfma_f32_32x32x16_bf16(a, b, acc, 0, 0, 0);
        }
      }
#pragma unroll
      for (int r = 0; r < 16; ++r) {
        int i = ti * 32 + (r & 3) + 8 * (r >> 2) + 4 * (lane >> 5), j = tj * 32 + (lane & 31);
        float v = (j <= i && i < len && j < len) ? acc[r] : 0.f;
        AS[i * TS + j] = f2bf(v);
      }
    }
    __syncthreads();
    f32x16 acc[2][2];
#pragma unroll
    for (int i = 0; i < 2; ++i)
#pragma unroll
      for (int j = 0; j < 2; ++j)
#pragma unroll
        for (int r = 0; r < 16; ++r) acc[i][j][r] = 0.f;
#pragma unroll
    for (int ks = 0; ks < 4; ++ks) {
      bf16x8 a[2], b[2];
#pragma unroll
      for (int x = 0; x < 2; ++x) {
        a[x] = *(const bf16x8*)(AS + (x * 32 + (lane & 31)) * TS + ks * 16 + (lane >> 5) * 8);
        b[x] = *(const bf16x8*)(VT + (w * 64 + x * 32 + (lane & 31)) * TS + ks * 16 + (lane >> 5) * 8);
      }
#pragma unroll
      for (int tm = 0; tm < 2; ++tm)
#pragma unroll
        for (int tn = 0; tn < 2; ++tn)
          acc[tm][tn] = __builtin_amdgcn_mfma_f32_32x32x16_bf16(a[tm], b[tn], acc[tm][tn], 0, 0, 0);
    }
    {
      const u16* Sp = p.US + (size_t)(blk * 4 + h) * 32768;
#pragma unroll
      for (int ks = 0; ks < 8; ++ks) {
        bf16x8 a[2], b[2];
#pragma unroll
        for (int x = 0; x < 2; ++x) {
          int qi = x * 32 + (lane & 31);
          bf16x8 z = {0, 0, 0, 0, 0, 0, 0, 0};
          a[x] = qi < len ? *(const bf16x8*)(p.P + (size_t)(row0 + qi) * NCOL + C_GQ + h * 128 + ks * 16 + (lane >> 5) * 8) : z;
          b[x] = *(const bf16x8*)(Sp + (size_t)(w * 64 + x * 32 + (lane & 31)) * 128 + ks * 16 + (lane >> 5) * 8);
        }
#pragma unroll
        for (int tm = 0; tm < 2; ++tm)
#pragma unroll
          for (int tn = 0; tn < 2; ++tn)
            acc[tm][tn] = __builtin_amdgcn_mfma_f32_32x32x16_bf16(a[tm], b[tn], acc[tm][tn], 0, 0, 0);
      }
    }
    __syncthreads();
#pragma unroll
    for (int tm = 0; tm < 2; ++tm)
#pragma unroll
      for (int tn = 0; tn < 2; ++tn)
#pragma unroll
        for (int r = 0; r < 16; ++r) {
          int i = tm * 32 + (r & 3) + 8 * (r >> 2) + 4 * (lane >> 5), e = w * 64 + tn * 32 + (lane & 31);
          OT[i * OS + e] = f2bf(acc[tm][tn][r]);
        }
    __syncthreads();
    {
      int i = tid >> 2, seg = tid & 3;
      float vals[64];
      float ss = 0.f;
#pragma unroll
      for (int c = 0; c < 8; ++c) {
        uint4 v = *(const uint4*)(OT + i * OS + seg * 64 + c * 8);
        u32 ww[4] = {v.x, v.y, v.z, v.w};
#pragma unroll
        for (int k = 0; k < 4; ++k) {
          float a = bf2f((u16)(ww[k] & 0xffff)), b = bf2f((u16)(ww[k] >> 16));
          vals[c * 8 + 2 * k] = a; vals[c * 8 + 2 * k + 1] = b; ss += a * a + b * b;
        }
      }
      ss += __shfl_xor(ss, 1); ss += __shfl_xor(ss, 2);
      float rstd = rsqrtf(ss * (1.f / 256) + NORM_EPS);
      if (i < len && !dry) {
        size_t o = (size_t)(row0 + i) * NCOL;
#pragma unroll
        for (int c = 0; c < 8; ++c) {
          int e = seg * 64 + c * 8;
          uint4 gr = *(const uint4*)(p.P + o + C_GR + h * 256 + e);
          u32 gw[4] = {gr.x, gr.y, gr.z, gr.w};
          u32 ow[4];
#pragma unroll
          for (int k = 0; k < 4; ++k) {
            float g0 = bf2f((u16)(gw[k] & 0xffff)), g1 = bf2f((u16)(gw[k] >> 16));
            float y0 = vals[c * 8 + 2 * k] * rstd * p.gla_norm_g[e + 2 * k] * siluf_(g0);
            float y1 = vals[c * 8 + 2 * k + 1] * rstd * p.gla_norm_g[e + 2 * k + 1] * siluf_(g1);
            ow[k] = pack2(y0, y1);
          }
          *(uint4*)(p.P + o + C_GV + h * 256 + e) = make_uint4(ow[0], ow[1], ow[2], ow[3]);
        }
      }
    }
    __syncthreads();
  }
}

struct DTile {
  int qrow0, qrow1;
  int nkeys0, nkeys1;
  const u16* ki; int ki_stride;
  const u16* kv; int kv_stride;
};

__device__ __forceinline__ u32 score_key(float s, int keyidx) {
  u32 u = __float_as_uint(s);
  u ^= (u32)(((int)u) >> 31) | 0x80000000u;
  return (u & 0xFFFF8000u) | (u32)(32767 - keyidx);
}

__device__ __forceinline__ void compact(u32* cand, int n, int hi, int& newcnt, u32& newthr) {
  int lane = TIDX & 63;
  u32 v[CVN];
#pragma unroll
  for (int e = 0; e < CVN; ++e) { int idx = lane + 64 * e; v[e] = idx < n ? cand[idx] : 0u; }
  u32 prefix = 0;
  for (int bit = 31; bit >= 0; --bit) {
    u32 trial = prefix | (1u << bit);
    int c = 0;
#pragma unroll
    for (int e = 0; e < CVN; ++e) c += __popcll(__ballot(v[e] >= trial));
    if (c >= 256) { prefix = trial; if (c <= hi) break; }
  }
  int base = 0;
  unsigned long long lt = (1ull << lane) - 1ull;
#pragma unroll
  for (int e = 0; e < CVN; ++e) {
    bool keep = v[e] >= prefix && prefix != 0;
    unsigned long long m = __ballot(keep);
    int pos = base + __popcll(m & lt);
    if (keep) cand[pos] = v[e];
    base += __popcll(m);
  }
  newcnt = base; newthr = prefix - 1u;
}

__device__ __forceinline__ void dsa_tile(const Params& p, const DTile& T, char* lds, bool dry) {
  u32* cand = (u32*)lds;
  u16* kst = (u16*)(lds + 32 * CAP * 4);
  const int tid = TIDX, lane = tid & 63, w = tid >> 6, half = lane >> 5;
  bf16x8 afr[2][4];
  bf16x8 aW[2][2];
#pragma unroll
  for (int rt = 0; rt < 2; ++rt) {
    bool act = (rt == 0 ? T.nkeys0 : T.nkeys1) > 0;
    int qr = (act && rt == 1) ? T.qrow1 : T.qrow0;
    int m = qr + 4 * w + ((lane & 31) >> 3);
    const u16* ap = p.P + (size_t)m * NCOL + C_IQ + (lane & 7) * 64 + half * 8;
#pragma unroll
    for (int ks = 0; ks < 4; ++ks) afr[rt][ks] = *(const bf16x8*)(ap + ks * 16);
    const int rho = lane & 31;
    const bool vrow = (rho & ~5) == 0;
    const int qi = 2 * (rho & 1) + ((rho >> 2) & 1);
    float4 w4 = *(const float4*)(p.PS + (size_t)(qr + 4 * w + qi) * 128 + 80 + 4 * half);
    u32 lo = pack2(w4.x * IDX_W_SCALE, w4.y * IDX_W_SCALE), hi = pack2(w4.z * IDX_W_SCALE, w4.w * IDX_W_SCALE);
#pragma unroll
    for (int sx = 0; sx < 2; ++sx) {
      bool on = vrow && (qi >> 1) == sx;
      u32x4 wd = {0u, 0u, 0u, 0u};
      if (on && (qi & 1) == 0) { wd[0] = lo; wd[1] = hi; }
      if (on && (qi & 1) == 1) { wd[2] = lo; wd[3] = hi; }
      aW[rt][sx] = __builtin_bit_cast(bf16x8, wd);
    }
  }
  u32 thr[2][2]; int cnt[2][2];
#pragma unroll
  for (int rt = 0; rt < 2; ++rt)
#pragma unroll
    for (int pp = 0; pp < 2; ++pp) { thr[rt][pp] = 0u; cnt[rt][pp] = 0; }
  const int NH = T.nkeys0, NL = T.nkeys1;
  const int nkt = (NH + 63) >> 6;
  const unsigned long long lt = (1ull << lane) - 1ull;
#define SCORE(ACC, RT, K0, KEY0, KEY1, M0, M1) do { \
    const int N_ = (RT) == 0 ? NH : NL; \
    M0 = 0ull; M1 = 0ull; KEY0 = 0u; KEY1 = 0u; \
    if ((K0) < N_) { \
      const int keyidx = (K0) + (lane & 31); \
      const bool valid = keyidx < N_; \
      u32x4 xa_ = {cvt_pk_bf16(relu1(ACC[0]), relu1(ACC[1])), cvt_pk_bf16(relu1(ACC[2]), relu1(ACC[3])), \
                   cvt_pk_bf16(relu1(ACC[4]), relu1(ACC[5])), cvt_pk_bf16(relu1(ACC[6]), relu1(ACC[7]))}; \
      u32x4 xb_ = {cvt_pk_bf16(relu1(ACC[8]), relu1(ACC[9])), cvt_pk_bf16(relu1(ACC[10]), relu1(ACC[11])), \
                   cvt_pk_bf16(relu1(ACC[12]), relu1(ACC[13])), cvt_pk_bf16(relu1(ACC[14]), relu1(ACC[15]))}; \
      f32x16 s2_; \
      _Pragma("unroll") for (int r_ = 0; r_ < 16; ++r_) s2_[r_] = 0.f; \
      s2_ = __builtin_amdgcn_mfma_f32_32x32x16_bf16(aW[RT][0], __builtin_bit_cast(bf16x8, xa_), s2_, 0, 0, 0); \
      s2_ = __builtin_amdgcn_mfma_f32_32x32x16_bf16(aW[RT][1], __builtin_bit_cast(bf16x8, xb_), s2_, 0, 0, 0); \
      KEY0 = score_key(s2_[0], keyidx); \
      KEY1 = score_key(s2_[1], keyidx); \
      M0 = __ballot(valid && KEY0 > thr[RT][0]); \
      M1 = __ballot(valid && KEY1 > thr[RT][1]); \
    } } while (0)
#define APPEND(RT, PP, KEY, M) do { \
    if (M) { \
      bool pass = (M >> lane) & 1ull; \
      pass = pass && (KEY > thr[RT][PP]); \
      unsigned long long m = __ballot(pass); \
      u32 mh = half ? (u32)(m >> 32) : (u32)m; \
      int slot = (RT) * 16 + 4 * w + 2 * (PP) + half; \
      int pos = cnt[RT][PP] + __popc(mh & (u32)(lt >> (half * 32))); \
      if (pass) cand[slot * CAP + pos] = KEY; \
      cnt[RT][PP] += __popc(mh); \
      unsigned long long over = __ballot(cnt[RT][PP] > CLIMIT); \
      if (over) { \
        _Pragma("unroll") \
        for (int hh = 0; hh < 2; ++hh) { \
          if ((u32)(over >> (hh * 32)) != 0u) { \
            int sl = (RT) * 16 + 4 * w + 2 * (PP) + hh; \
            int n = __shfl(cnt[RT][PP], hh * 32); \
            int nc; u32 nt; \
            compact(cand + sl * CAP, n, 320, nc, nt); \
            if (half == hh) { cnt[RT][PP] = nc; thr[RT][PP] = nt; } \
          } \
        } \
      } \
    } } while (0)
  bf16x8 nA[4], nB[4];
#define BLOAD(kt) do { \
    int ka_ = (kt) * 64 + (lane & 31), kb_ = ka_ + 32; \
    ka_ = ka_ < NH ? ka_ : NH - 1; kb_ = kb_ < NH ? kb_ : NH - 1; \
    const u16* pa_ = T.ki + (size_t)ka_ * T.ki_stride + half * 8; \
    const u16* pb_ = T.ki + (size_t)kb_ * T.ki_stride + half * 8; \
    _Pragma("unroll") for (int ks = 0; ks < 4; ++ks) { nA[ks] = *(const bf16x8*)(pa_ + ks * 16); nB[ks] = *(const bf16x8*)(pb_ + ks * 16); } } while (0)
  BLOAD(0);
#pragma unroll 1
  for (int kt = 0; kt < nkt; ++kt) {
    const int k0a = kt * 64, k0b = kt * 64 + 32;
    bf16x8 bA[4], bB[4];
#pragma unroll
    for (int ks = 0; ks < 4; ++ks) { bA[ks] = nA[ks]; bB[ks] = nB[ks]; }
    if (kt + 1 < nkt) BLOAD(kt + 1);
    __builtin_amdgcn_sched_barrier(0);
    f32x16 aH0, aL0, aH1, aL1;
#pragma unroll
    for (int r = 0; r < 16; ++r) { aH0[r] = 0.f; aL0[r] = 0.f; aH1[r] = 0.f; aL1[r] = 0.f; }
    const bool lact = k0a < NL;
#pragma unroll
    for (int ks = 0; ks < 4; ++ks) {
      aH0 = __builtin_amdgcn_mfma_f32_32x32x16_bf16(afr[0][ks], bA[ks], aH0, 0, 0, 0);
      aH1 = __builtin_amdgcn_mfma_f32_32x32x16_bf16(afr[0][ks], bB[ks], aH1, 0, 0, 0);
    }
    if (lact) {
#pragma unroll
      for (int ks = 0; ks < 4; ++ks) {
        aL0 = __builtin_amdgcn_mfma_f32_32x32x16_bf16(afr[1][ks], bA[ks], aL0, 0, 0, 0);
        aL1 = __builtin_amdgcn_mfma_f32_32x32x16_bf16(afr[1][ks], bB[ks], aL1, 0, 0, 0);
      }
    }
    u32 kH0a, kH0b, kH1a, kH1b, kL0a, kL0b, kL1a, kL1b;
    unsigned long long mH0a, mH0b, mH1a, mH1b, mL0a, mL0b, mL1a, mL1b;
    SCORE(aH0, 0, k0a, kH0a, kH0b, mH0a, mH0b);
    SCORE(aH1, 0, k0b, kH1a, kH1b, mH1a, mH1b);
    SCORE(aL0, 1, k0a, kL0a, kL0b, mL0a, mL0b);
    SCORE(aL1, 1, k0b, kL1a, kL1b, mL1a, mL1b);
    if (mH0a | mH0b | mH1a | mH1b | mL0a | mL0b | mL1a | mL1b) {
      APPEND(0, 0, kH0a, mH0a); APPEND(0, 1, kH0b, mH0b);
      APPEND(0, 0, kH1a, mH1a); APPEND(0, 1, kH1b, mH1b);
      APPEND(1, 0, kL0a, mL0a); APPEND(1, 1, kL0b, mL0b);
      APPEND(1, 0, kL1a, mL1a); APPEND(1, 1, kL1b, mL1b);
    }
  }
  int* nselp = (int*)(lds + 32 * CAP * 4);
#pragma unroll
  for (int rt = 0; rt < 2; ++rt)
#pragma unroll
    for (int pp = 0; pp < 2; ++pp)
#pragma unroll
      for (int hh = 0; hh < 2; ++hh) {
        int sl = rt * 16 + 4 * w + 2 * pp + hh;
        int n = __shfl(cnt[rt][pp], hh * 32);
        if (n > 256) { int nc; u32 nt; compact(cand + sl * CAP, n, 256, nc, nt); n = nc; }
        if (lane == 0) nselp[sl] = n;
      }
#pragma unroll 1
  for (int qq = 0; qq < 8; ++qq) {
    int rt = qq >> 2, qi = qq & 3;
    if ((rt == 0 ? T.nkeys0 : T.nkeys1) == 0) continue;
    int sl = rt * 16 + 4 * w + qi;
    int nsel = nselp[sl];
    const u32* cq = cand + sl * CAP;
    int m = (rt == 0 ? T.qrow0 : T.qrow1) + 4 * w + qi;
    u32 k0 = 4 * lane + 0 < nsel ? 32767u - (cq[4 * lane + 0] & 0x7fffu) : 0u;
    u32 k1 = 4 * lane + 1 < nsel ? 32767u - (cq[4 * lane + 1] & 0x7fffu) : 0u;
    u32 k2 = 4 * lane + 2 < nsel ? 32767u - (cq[4 * lane + 2] & 0x7fffu) : 0u;
    u32 k3 = 4 * lane + 3 < nsel ? 32767u - (cq[4 * lane + 3] & 0x7fffu) : 0u;
    if (!dry) *(uint2*)(p.SEL + (size_t)m * 256 + 4 * lane) = make_uint2(k0 | (k1 << 16), k2 | (k3 << 16));
  }
  __syncthreads();
}

typedef __attribute__((ext_vector_type(2))) unsigned int u32x2;
__device__ __forceinline__ bf16x8 fp8x8_to_bf16x8(u32x2 x) {
  u32 a0, a1, a2, a3;
  fp8x4_to_bf16(x[0], a0, a1);
  fp8x4_to_bf16(x[1], a2, a3);
  u32x4 r = {a0, a1, a2, a3};
  return __builtin_bit_cast(bf16x8, r);
}
__device__ __forceinline__ void att_unit(const Params& p, int m, int g, int nsel, const u8* __restrict__ kv,
                                         const u16* sl, u16* vs, bool dry) {
  const int lane = TIDX & 63, g4 = lane >> 4, i16 = lane & 15;
  bf16x8 bq0, bq1;
  {
    bf16x8 z = {0, 0, 0, 0, 0, 0, 0, 0};
    const u16* qp = p.P + (size_t)m * NCOL + C_DQ + (g * 4 + (i16 & 3)) * 64 + g4 * 8;
    bq0 = i16 < 4 ? *(const bf16x8*)(qp) : z;
    bq1 = i16 < 4 ? *(const bf16x8*)(qp + 32) : z;
  }
  const int npad = (nsel + 31) & ~31;
  const int nchunk = (npad + 63) >> 6;
  const u8* kbase = kv + g * 128 + g4 * 8;
  const u8* vbase = kv + g * 128 + 64 + (lane & 3) * 16;
  u32x2 kc[4][2], kn[4][2];
#pragma unroll
  for (int tt = 0; tt < 4; ++tt) {
    const u8* kp = kbase + (size_t)sl[tt * 16 + i16] * 512;
    kc[tt][0] = *(const u32x2*)kp; kc[tt][1] = *(const u32x2*)(kp + 32);
    kn[tt][0] = kc[tt][0]; kn[tt][1] = kc[tt][1];
  }
  u32x4 vc[2][2], vn[2][2];
#pragma unroll
  for (int s2 = 0; s2 < 2; ++s2)
#pragma unroll
    for (int it = 0; it < 2; ++it) {
      vc[s2][it] = *(const u32x4*)(vbase + (size_t)sl[s2 * 32 + it * 16 + (lane >> 2)] * 512);
      vn[s2][it] = vc[s2][it];
    }
  float mrun = -3.0e38f, lrun = 0.f;
  f32x4 oacc[4];
#pragma unroll
  for (int dt = 0; dt < 4; ++dt) oacc[dt] = f32x4{0.f, 0.f, 0.f, 0.f};
#pragma unroll 1
  for (int c = 0; c < nchunk; ++c) {
    if (c + 1 < nchunk) {
#pragma unroll
      for (int s2 = 0; s2 < 2; ++s2)
#pragma unroll
        for (int it = 0; it < 2; ++it)
          vn[s2][it] = *(const u32x4*)(vbase + (size_t)sl[(c + 1) * 64 + s2 * 32 + it * 16 + (lane >> 2)] * 512);
#pragma unroll
      for (int tt = 0; tt < 4; ++tt) {
        const u8* kp = kbase + (size_t)sl[(c + 1) * 64 + tt * 16 + i16] * 512;
        kn[tt][0] = *(const u32x2*)kp; kn[tt][1] = *(const u32x2*)(kp + 32);
      }
    }
    __builtin_amdgcn_sched_barrier(0);
    f32x4 lg[4];
    float cmax = -3.0e38f;
#pragma unroll
    for (int tt = 0; tt < 4; ++tt) {
      f32x4 cc = {0.f, 0.f, 0.f, 0.f};
      cc = __builtin_amdgcn_mfma_f32_16x16x32_bf16(fp8x8_to_bf16x8(kc[tt][0]), bq0, cc, 0, 0, 0);
      cc = __builtin_amdgcn_mfma_f32_16x16x32_bf16(fp8x8_to_bf16x8(kc[tt][1]), bq1, cc, 0, 0, 0);
#pragma unroll
      for (int r = 0; r < 4; ++r) {
        int ks = (c * 4 + tt) * 16 + 4 * g4 + r;
        float v = ks < nsel ? cc[r] : -3.0e38f;
        lg[tt][r] = v; cmax = fmaxf(cmax, v);
      }
    }
    cmax = fmaxf(cmax, __shfl_xor(cmax, 16)); cmax = fmaxf(cmax, __shfl_xor(cmax, 32));
    float mnew = fmaxf(mrun, cmax);
    float alpha = __expf((mrun - mnew) * DSA_SCALE);
    mrun = mnew;
    bf16x8 pa[2];
    float psum = 0.f;
#pragma unroll
    for (int s2 = 0; s2 < 2; ++s2) {
#pragma unroll
      for (int r = 0; r < 4; ++r) {
        float e0 = __expf((lg[2 * s2][r] - mnew) * DSA_SCALE);
        float e1 = __expf((lg[2 * s2 + 1][r] - mnew) * DSA_SCALE);
        psum += e0 + e1;
        pa[s2][r] = (short)f2bf(e0); pa[s2][4 + r] = (short)f2bf(e1);
      }
    }
    lrun = lrun * alpha + psum;
    float al[4];
#pragma unroll
    for (int r = 0; r < 4; ++r) al[r] = __shfl(alpha, r);
#pragma unroll
    for (int dt = 0; dt < 4; ++dt)
#pragma unroll
      for (int r = 0; r < 4; ++r) oacc[dt][r] *= al[r];
#pragma unroll
    for (int s2 = 0; s2 < 2; ++s2) {
      __builtin_amdgcn_wave_barrier();
#pragma unroll
      for (int it = 0; it < 2; ++it) {
        u32 a0, a1, a2, a3, b0, b1, b2, b3;
        fp8x4_to_bf16(vc[s2][it][0], a0, a1); fp8x4_to_bf16(vc[s2][it][1], a2, a3);
        fp8x4_to_bf16(vc[s2][it][2], b0, b1); fp8x4_to_bf16(vc[s2][it][3], b2, b3);
        u32x4 w0 = {a0, a1, a2, a3}, w1 = {b0, b1, b2, b3};
        u16* vd = vs + (it * 16 + (lane >> 2)) * 64 + (lane & 3) * 16;
        *(u32x4*)vd = w0; *(u32x4*)(vd + 8) = w1;
      }
      __builtin_amdgcn_fence(__ATOMIC_RELEASE, "wavefront");
      __builtin_amdgcn_wave_barrier();
      __builtin_amdgcn_fence(__ATOMIC_ACQUIRE, "wavefront");
#pragma unroll
      for (int dt = 0; dt < 4; ++dt) {
        int q = i16 >> 2, pq = i16 & 3;
        const u16* a0 = vs + (4 * g4 + q) * 64 + dt * 16 + 4 * pq;
        const u16* a1 = vs + (16 + 4 * g4 + q) * 64 + dt * 16 + 4 * pq;
        s16x4 lo = __builtin_bit_cast(s16x4, __builtin_amdgcn_ds_read_tr16_b64_v4i16((lds_v4p)(a0)));
        s16x4 hi = __builtin_bit_cast(s16x4, __builtin_amdgcn_ds_read_tr16_b64_v4i16((lds_v4p)(a1)));
        bf16x8 bv = {lo[0], lo[1], lo[2], lo[3], hi[0], hi[1], hi[2], hi[3]};
        oacc[dt] = __builtin_amdgcn_mfma_f32_16x16x32_bf16(pa[s2], bv, oacc[dt], 0, 0, 0);
      }
    }
#pragma unroll
    for (int tt = 0; tt < 4; ++tt) { kc[tt][0] = kn[tt][0]; kc[tt][1] = kn[tt][1]; }
#pragma unroll
    for (int s2 = 0; s2 < 2; ++s2) { vc[s2][0] = vn[s2][0]; vc[s2][1] = vn[s2][1]; }
  }
  float sum = lrun;
  sum += __shfl_xor(sum, 16); sum += __shfl_xor(sum, 32);
  float inv[4];
#pragma unroll
  for (int r = 0; r < 4; ++r) inv[r] = 1.f / __shfl(sum, r);
  if (lane < 16 && !dry) {
    size_t o = (size_t)m * NCOL;
#pragma unroll
    for (int r = 0; r < 4; ++r)
#pragma unroll
      for (int dt = 0; dt < 4; ++dt) {
        int col = (g * 4 + r) * 64 + dt * 16 + lane;
        float z = bf2f(p.P[o + C_DZ + col]);
        p.P[o + C_DQ + col] = f2bf(oacc[dt][r] * inv[r] * siluf_(z));
      }
  }
}

__device__ __forceinline__ void att_item(const Params& p, int m0, int g, int nsel, const u8* __restrict__ kv,
                                         u16* slw, u16* vs, bool dry) {
  const int lane = TIDX & 63, g4 = lane >> 4, i16 = lane & 15;
  const int npad = (nsel + 31) & ~31;
  const int nchunk = (npad + 63) >> 6;
  const u8* kbase = kv + g * 128 + g4 * 8;
  const u8* vbase = kv + g * 128 + 64 + (lane & 3) * 16;
  const bf16x8 zf = {0, 0, 0, 0, 0, 0, 0, 0};
  u32x2 selr = *(const u32x2*)(p.SEL + (size_t)m0 * 256 + 4 * lane);
  __builtin_amdgcn_wave_barrier();
  *(u32x2*)(slw + 4 * lane) = selr;
  __builtin_amdgcn_fence(__ATOMIC_RELEASE, "wavefront");
  __builtin_amdgcn_wave_barrier();
  __builtin_amdgcn_fence(__ATOMIC_ACQUIRE, "wavefront");
  selr = *(const u32x2*)(p.SEL + (size_t)(m0 + 1) * 256 + 4 * lane);
  bf16x8 bq0, bq1, bn0, bn1;
  {
    const u16* qp = p.P + (size_t)m0 * NCOL + C_DQ + (g * 4 + (i16 & 3)) * 64 + g4 * 8;
    bq0 = i16 < 4 ? *(const bf16x8*)(qp) : zf;
    bq1 = i16 < 4 ? *(const bf16x8*)(qp + 32) : zf;
    bn0 = bq0; bn1 = bq1;
  }
  u32x2 kc[4][2], kn[4][2];
  u32x4 vc[2][2], vn[2][2];
#pragma unroll
  for (int tt = 0; tt < 4; ++tt) {
    const u8* kp = kbase + (size_t)slw[tt * 16 + i16] * 512;
    kc[tt][0] = *(const u32x2*)kp; kc[tt][1] = *(const u32x2*)(kp + 32);
    kn[tt][0] = kc[tt][0]; kn[tt][1] = kc[tt][1];
  }
#pragma unroll
  for (int s2 = 0; s2 < 2; ++s2)
#pragma unroll
    for (int it = 0; it < 2; ++it) {
      vc[s2][it] = *(const u32x4*)(vbase + (size_t)slw[s2 * 32 + it * 16 + (lane >> 2)] * 512);
      vn[s2][it] = vc[s2][it];
    }
  float mrun = -3.0e38f, lrun = 0.f;
  f32x4 oacc[4];
#pragma unroll
  for (int dt = 0; dt < 4; ++dt) oacc[dt] = f32x4{0.f, 0.f, 0.f, 0.f};
  const int nt = 4 * nchunk;
  int u = 0, c = 0;
#pragma unroll 1
  for (int t = 0; t < nt; ++t) {
    const int m = m0 + u;
    if (c + 1 < nchunk) {
      const u16* slc = slw + (u & 1) * 256 + (c + 1) * 64;
#pragma unroll
      for (int s2 = 0; s2 < 2; ++s2)
#pragma unroll
        for (int it = 0; it < 2; ++it)
          vn[s2][it] = *(const u32x4*)(vbase + (size_t)slc[s2 * 32 + it * 16 + (lane >> 2)] * 512);
#pragma unroll
      for (int tt = 0; tt < 4; ++tt) {
        const u8* kp = kbase + (size_t)slc[tt * 16 + i16] * 512;
        kn[tt][0] = *(const u32x2*)kp; kn[tt][1] = *(const u32x2*)(kp + 32);
      }
    } else if (u + 1 < 4) {
      u16* sln = slw + ((u + 1) & 1) * 256;
      __builtin_amdgcn_wave_barrier();
      *(u32x2*)(sln + 4 * lane) = selr;
      __builtin_amdgcn_fence(__ATOMIC_RELEASE, "wavefront");
      __builtin_amdgcn_wave_barrier();
      __builtin_amdgcn_fence(__ATOMIC_ACQUIRE, "wavefront");
      if (u + 2 < 4) selr = *(const u32x2*)(p.SEL + (size_t)(m + 2) * 256 + 4 * lane);
#pragma unroll
      for (int s2 = 0; s2 < 2; ++s2)
#pragma unroll
        for (int it = 0; it < 2; ++it)
          vn[s2][it] = *(const u32x4*)(vbase + (size_t)sln[s2 * 32 + it * 16 + (lane >> 2)] * 512);
#pragma unroll
      for (int tt = 0; tt < 4; ++tt) {
        const u8* kp = kbase + (size_t)sln[tt * 16 + i16] * 512;
        kn[tt][0] = *(const u32x2*)kp; kn[tt][1] = *(const u32x2*)(kp + 32);
      }
      const u16* qp = p.P + (size_t)(m + 1) * NCOL + C_DQ + (g * 4 + (i16 & 3)) * 64 + g4 * 8;
      bn0 = i16 < 4 ? *(const bf16x8*)(qp) : zf;
      bn1 = i16 < 4 ? *(const bf16x8*)(qp + 32) : zf;
    }
    __builtin_amdgcn_sched_barrier(0);
    f32x4 lg[4];
    float cmax = -3.0e38f;
#pragma unroll
    for (int tt = 0; tt < 4; ++tt) {
      f32x4 cc = {0.f, 0.f, 0.f, 0.f};
      cc = __builtin_amdgcn_mfma_f32_16x16x32_bf16(fp8x8_to_bf16x8(kc[tt][0]), bq0, cc, 0, 0, 0);
      cc = __builtin_amdgcn_mfma_f32_16x16x32_bf16(fp8x8_to_bf16x8(kc[tt][1]), bq1, cc, 0, 0, 0);
#pragma unroll
      for (int r = 0; r < 4; ++r) {
        int ks = (c * 4 + tt) * 16 + 4 * g4 + r;
        float v = ks < nsel ? cc[r] : -3.0e38f;
        lg[tt][r] = v; cmax = fmaxf(cmax, v);
      }
    }
    cmax = fmaxf(cmax, __shfl_xor(cmax, 16)); cmax = fmaxf(cmax, __shfl_xor(cmax, 32));
    float mnew = fmaxf(mrun, cmax);
    float alpha = __expf((mrun - mnew) * DSA_SCALE);
    mrun = mnew;
    bf16x8 pa[2];
    float psum = 0.f;
#pragma unroll
    for (int s2 = 0; s2 < 2; ++s2) {
#pragma unroll
      for (int r = 0; r < 4; ++r) {
        float e0 = __expf((lg[2 * s2][r] - mnew) * DSA_SCALE);
        float e1 = __expf((lg[2 * s2 + 1][r] - mnew) * DSA_SCALE);
        psum += e0 + e1;
        pa[s2][r] = (short)f2bf(e0); pa[s2][4 + r] = (short)f2bf(e1);
      }
    }
    lrun = lrun * alpha + psum;
    float al[4];
#pragma unroll
    for (int r = 0; r < 4; ++r) al[r] = __shfl(alpha, r);
#pragma unroll
    for (int dt = 0; dt < 4; ++dt)
#pragma unroll
      for (int r = 0; r < 4; ++r) oacc[dt][r] *= al[r];
#pragma unroll
    for (int s2 = 0; s2 < 2; ++s2) {
      __builtin_amdgcn_wave_barrier();
#pragma unroll
      for (int it = 0; it < 2; ++it) {
        u32 a0, a1, a2, a3, b0, b1, b2, b3;
        fp8x4_to_bf16(vc[s2][it][0], a0, a1); fp8x4_to_bf16(vc[s2][it][1], a2, a3);
        fp8x4_to_bf16(vc[s2][it][2], b0, b1); fp8x4_to_bf16(vc[s2][it][3], b2, b3);
        u32x4 w0 = {a0, a1, a2, a3}, w1 = {b0, b1, b2, b3};
        u16* vd = vs + (it * 16 + (lane >> 2)) * 64 + (lane & 3) * 16;
        *(u32x4*)vd = w0; *(u32x4*)(vd + 8) = w1;
      }
      __builtin_amdgcn_fence(__ATOMIC_RELEASE, "wavefront");
      __builtin_amdgcn_wave_barrier();
      __builtin_amdgcn_fence(__ATOMIC_ACQUIRE, "wavefront");
#pragma unroll
      for (int dt = 0; dt < 4; ++dt) {
        int q = i16 >> 2, pq = i16 & 3;
        const u16* a0 = vs + (4 * g4 + q) * 64 + dt * 16 + 4 * pq;
        const u16* a1 = vs + (16 + 4 * g4 + q) * 64 + dt * 16 + 4 * pq;
        s16x4 lo = __builtin_bit_cast(s16x4, __builtin_amdgcn_ds_read_tr16_b64_v4i16((lds_v4p)(a0)));
        s16x4 hi = __builtin_bit_cast(s16x4, __builtin_amdgcn_ds_read_tr16_b64_v4i16((lds_v4p)(a1)));
        bf16x8 bv = {lo[0], lo[1], lo[2], lo[3], hi[0], hi[1], hi[2], hi[3]};
        oacc[dt] = __builtin_amdgcn_mfma_f32_16x16x32_bf16(pa[s2], bv, oacc[dt], 0, 0, 0);
      }
    }
#pragma unroll
    for (int tt = 0; tt < 4; ++tt) { kc[tt][0] = kn[tt][0]; kc[tt][1] = kn[tt][1]; }
#pragma unroll
    for (int s2 = 0; s2 < 2; ++s2) { vc[s2][0] = vn[s2][0]; vc[s2][1] = vn[s2][1]; }
    if (c == nchunk - 1) {
      float sum = lrun;
      sum += __shfl_xor(sum, 16); sum += __shfl_xor(sum, 32);
      float inv[4];
#pragma unroll
      for (int r = 0; r < 4; ++r) inv[r] = 1.f / __shfl(sum, r);
      __builtin_amdgcn_wave_barrier();
      if (lane < 16) {
#pragma unroll
        for (int r = 0; r < 4; ++r)
#pragma unroll
          for (int dt = 0; dt < 4; ++dt) vs[r * 64 + dt * 16 + lane] = f2bf(oacc[dt][r] * inv[r]);
      }
      __builtin_amdgcn_fence(__ATOMIC_RELEASE, "wavefront");
      __builtin_amdgcn_wave_barrier();
      __builtin_amdgcn_fence(__ATOMIC_ACQUIRE, "wavefront");
      if (lane < 32 && !dry) {
        size_t o = (size_t)m * NCOL + g * 256 + lane * 8;
        u32x4 ov = *(const u32x4*)(vs + lane * 8);
        u32x4 zv = *(const u32x4*)(p.P + o + C_DZ);
        u32x4 rv;
#pragma unroll
        for (int k = 0; k < 4; ++k) {
          float o0 = bf2f((u16)(ov[k] & 0xffff)), o1 = bf2f((u16)(ov[k] >> 16));
          float z0 = bf2f((u16)(zv[k] & 0xffff)), z1 = bf2f((u16)(zv[k] >> 16));
          rv[k] = pack2(o0 * siluf_(z0), o1 * siluf_(z1));
        }
        *(u32x4*)(p.P + o + C_DQ) = rv;
      }
      __builtin_amdgcn_wave_barrier();

      mrun = -3.0e38f; lrun = 0.f;
#pragma unroll
      for (int dt = 0; dt < 4; ++dt) oacc[dt] = f32x4{0.f, 0.f, 0.f, 0.f};
      bq0 = bn0; bq1 = bn1;
      c = 0; ++u;
    } else ++c;
  }
}

__device__ __forceinline__ void phase_att(const Params& p, int pass, char* lds, bool dry, unsigned xcc) {
  const int tid = TIDX, lane = tid & 63, w = tid >> 6;
  u16* sl = (u16*)lds + w * 512;
  u16* vs = (u16*)(lds + 4096) + w * (32 * 64);
  int* item = (int*)(lds + 4096 + 4 * 4096);
  const int ngroups = 1024 + (pass == 1 ? 32 : 0);
  unsigned* ctr = p.bar + XCD_BAR_WORDS + (dry ? 16 : 0) + pass * 4;
  int gsel = (int)(xcc & 3u);
  int tries = 0;
  while (tries < 4) {
    __syncthreads();
    if (tid == 0) *item = (int)atomicAdd(&ctr[gsel], 1u);
    __syncthreads();
    int it = *item;
    if (it >= ngroups) { gsel = (gsel + 1) & 3; ++tries; continue; }
    int row0, nsel; const u8* kv;
    if (it < 1024) {
      int c = it >> 2;
      row0 = 16 + 16 * it; int n = 80 + 64 * c; nsel = n < 256 ? n : 256;
      kv = p.KV8P;
    } else {
      int sb = it - 1024;
      row0 = SEQP + 16 * sb; nsel = 256;
      kv = p.KV8S + (size_t)sb * NKEYS_S * 512;
    }
    att_item(p, row0 + 4 * w, gsel, nsel, kv, sl, vs, dry);
  }
}

__device__ __forceinline__ void phase_dsa(const Params& p, int pass, char* lds, bool dry) {
  int ntiles = 512 + (pass == 1 ? 32 : 0);
  for (int t = blockIdx.x; t < ntiles; t += gridDim.x) {
    DTile T;
    if (t < 512) {
      int c = t >> 2, qq = t & 3;
      int chh = 255 - c, cl = c;
      T.qrow0 = 16 + 64 * chh + 16 * qq; T.nkeys0 = 80 + 64 * chh;
      T.qrow1 = 16 + 64 * cl + 16 * qq;  T.nkeys1 = 80 + 64 * cl;
      T.ki = p.KI; T.ki_stride = 64;
      T.kv = nullptr; T.kv_stride = 0;
    } else {
      int sb = t - 512;
      T.qrow0 = SEQP + 16 * sb; T.nkeys0 = NKEYS_S;
      T.qrow1 = SEQP + 16 * sb; T.nkeys1 = 0;
      T.ki = p.KIS + (size_t)sb * NKEYS_S * 64; T.ki_stride = 64;
      T.kv = nullptr; T.kv_stride = 0;
    }
    dsa_tile(p, T, lds, dry);
  }
}

template <int BR>
__device__ __forceinline__ void merge_half(const Params& p, int R, int m0, int n0, char* ldsc, bool dry) {
  const int tid = TIDX, lane = tid & 63, w = tid >> 6, wm = w >> 1, wn = w & 1;
  u16* lds = (u16*)ldsc;
  f32x16 acc[2][2];
#pragma unroll
  for (int i = 0; i < 2; ++i)
#pragma unroll
    for (int j = 0; j < 2; ++j)
#pragma unroll
      for (int r = 0; r < 16; ++r) acc[i][j][r] = 0.f;
  gemm_core(p.P + (BR == 0 ? C_GV : C_DQ), NCOL, m0, R, BR == 0 ? p.WglaT : p.WdsaT, DM, n0, DM, acc, lds);
#pragma unroll
  for (int tm = 0; tm < 2; ++tm)
#pragma unroll
    for (int tn = 0; tn < 2; ++tn)
#pragma unroll
      for (int r = 0; r < 16; ++r)
        lds[ACC_ROW(wm, tm, r, lane) * ES + ACC_COL(wn, tn, lane)] = f2bf(acc[tm][tn][r]);
  __syncthreads();
  const int ch = tid & 15;
  float gb[8];
#pragma unroll
  for (int k = 0; k < 8; ++k) gb[k] = p.gate_b[(BR == 0 ? 0 : DM) + n0 + ch * 8 + k];
  u32x4 mvv[8], pvv[8];
#pragma unroll
  for (int i = 0; i < 8; ++i) {
    int row = (tid >> 4) + 16 * i;
    mvv[i] = u32x4{0u, 0u, 0u, 0u}; pvv[i] = u32x4{0u, 0u, 0u, 0u};
    if (m0 + row < R) {
      size_t o = (size_t)(m0 + row) * NCOL + n0 + ch * 8;
      mvv[i] = *(const u32x4*)(p.P + o + (BR == 0 ? C_MA : C_MB));
      if (BR == 1) pvv[i] = *(const u32x4*)(p.P + o + C_MA);
    }
  }
  __builtin_amdgcn_sched_barrier(0);
#pragma unroll
  for (int i = 0; i < 8; ++i) {
    int row = (tid >> 4) + 16 * i;
    if (m0 + row < R && !dry) {
      size_t o = (size_t)(m0 + row) * NCOL + n0 + ch * 8;
      u32x4 yv = *(const u32x4*)(lds + row * ES + ch * 8);
      u32x4 ow;
#pragma unroll
      for (int k = 0; k < 4; ++k) {
        float y0 = bf2f((u16)(yv[k] & 0xffff)), y1 = bf2f((u16)(yv[k] >> 16));
        float g0 = sigmoidf_(bf2f((u16)(mvv[i][k] & 0xffff)) + gb[2 * k]), g1 = sigmoidf_(bf2f((u16)(mvv[i][k] >> 16)) + gb[2 * k + 1]);
        float r0 = g0 * y0, r1 = g1 * y1;
        if (BR == 1) { r0 += bf2f((u16)(pvv[i][k] & 0xffff)); r1 += bf2f((u16)(pvv[i][k] >> 16)); }
        ow[k] = pack2(r0, r1);
      }
      *(u32x4*)(p.P + o + C_MA) = ow;
    }
  }
  __syncthreads();
}
__device__ __forceinline__ void phase_merge(const Params& p, int pass, char* lds, bool dry) {
  int R = pass_rows(pass);
  int mt = (R + 127) >> 7;
  unsigned* ctr = p.bar + XCD_BAR_WORDS + 72 + (dry ? 8 : 0) + pass;
  for (int t = dq_next(ctr, lds); t < mt * 8; t = dq_next(ctr, lds)) {
    int tn_ = t & 7, tm_ = t >> 3;
    int m0 = tm_ * 128, n0 = tn_ * 128;
    merge_half<0>(p, R, m0, n0, lds, dry);
    merge_half<1>(p, R, m0, n0, lds, dry);
  }
}

__device__ __forceinline__ void phase_out(const Params& p, int pass, char* lds) {
  int R = pass_rows(pass), r0 = pass_row0(pass);
  int mt = (R + 127) >> 7;
  int lane = TIDX & 63, w = TIDX >> 6, wm = w >> 1, wn = w & 1;
  unsigned* ctr = p.bar + XCD_BAR_WORDS + 88 + pass;
  for (int t = dq_next(ctr, lds); t < mt * 8; t = dq_next(ctr, lds)) {
    int tn_ = t & 7, tm_ = t >> 3;
    int m0 = tm_ * 128, n0 = tn_ * 128;
    f32x16 acc[2][2];
#pragma unroll
    for (int i = 0; i < 2; ++i)
#pragma unroll
      for (int j = 0; j < 2; ++j)
#pragma unroll
        for (int r = 0; r < 16; ++r) acc[i][j][r] = 0.f;
    gemm_core(p.P + C_MA, NCOL, m0, R, p.WoutT, DM, n0, DM, acc, (u16*)lds);
    float lg_[2], lb_[2];
#pragma unroll
    for (int tn = 0; tn < 2; ++tn) { int n = n0 + ACC_COL(wn, tn, lane); lg_[tn] = p.ln_in_g[n]; lb_[tn] = p.ln_in_b[n]; }
#pragma unroll
    for (int tm = 0; tm < 2; ++tm) {
      float xv[16][2], mu_[16], rs_[16];
#pragma unroll
      for (int r = 0; r < 16; ++r) {
        int m = m0 + ACC_ROW(wm, tm, r, lane);
        xv[r][0] = 0.f; xv[r][1] = 0.f; mu_[r] = 0.f; rs_[r] = 0.f;
        if (m < R) {
          int gr = r0 + m;
          const float* x = xrow_ptr(p, gr);
          mu_[r] = p.STATS[gr * 2]; rs_[r] = p.STATS[gr * 2 + 1];
          xv[r][0] = x[n0 + ACC_COL(wn, 0, lane)]; xv[r][1] = x[n0 + ACC_COL(wn, 1, lane)];
        }
      }
      __builtin_amdgcn_sched_barrier(0);
#pragma unroll
      for (int r = 0; r < 16; ++r) {
        int m = m0 + ACC_ROW(wm, tm, r, lane);
        if (m < R) {
          float* y = yrow_ptr(p, r0 + m);
          if (y) {
#pragma unroll
            for (int tn = 0; tn < 2; ++tn) {
              float hh = (xv[r][tn] - mu_[r]) * rs_[r] * lg_[tn] + lb_[tn];
              y[n0 + ACC_COL(wn, tn, lane)] = ALPHA_F * hh + acc[tm][tn][r];
            }
          }
        }
      }
    }
  }
}

__device__ __forceinline__ void phase_ln_out(const Params& p, int pass, bool dry) {
  int R = pass_rows(pass), r0 = pass_row0(pass);
  int wave = TIDX >> 6, lane = TIDX & 63;
  for (int m = blockIdx.x * 4 + wave; m < R; m += gridDim.x * 4) {
    float* y = yrow_ptr(p, r0 + m);
    if (!y) continue;
    float4 v[4];
    float s = 0.f;
#pragma unroll
    for (int i = 0; i < 4; ++i) { v[i] = *(const float4*)(y + i * 256 + lane * 4); s += v[i].x + v[i].y + v[i].z + v[i].w; }
    float mu = wave_sum(s) * (1.f / DM);
    float q = 0.f;
#pragma unroll
    for (int i = 0; i < 4; ++i) {
      float a = v[i].x - mu, b = v[i].y - mu, c = v[i].z - mu, d = v[i].w - mu;
      q += a * a + b * b + c * c + d * d;
    }
    float rstd = rsqrtf(wave_sum(q) * (1.f / DM) + NORM_EPS);
#pragma unroll
    for (int i = 0; i < 4; ++i) {
      int c = i * 256 + lane * 4;
      float4 g = *(const float4*)(p.ln_g + c), b = *(const float4*)(p.ln_b + c);
      float4 o;
      o.x = (v[i].x - mu) * rstd * g.x + b.x; o.y = (v[i].y - mu) * rstd * g.y + b.y;
      o.z = (v[i].z - mu) * rstd * g.z + b.z; o.w = (v[i].w - mu) * rstd * g.w + b.w;
      if (!dry) *(float4*)(y + c) = o;
    }
  }
}

#define LDS_BYTES 77824
#define NPHASE 9
#ifndef PHASE_MASK
#define PHASE_MASK 0x7ff
#endif
#define EN(x) (((PHASE_MASK) >> (x)) & 1)
__device__ __forceinline__ void run_phase(const Params& p, int pass, int ph, char* lds, bool dry = false, unsigned xcc = 0) {
  switch (ph) {
    case 0: if (EN(0)) { if (pass == 0) phase_prep(p, lds); phase_ln_in(p, pass); } break;
    case 1: if (EN(1)) phase_gemm1(p, pass, lds, xcc); break;
    case 2: if (EN(2)) phase_tok(p, pass, lds, dry); break;
    case 3: if (EN(3)) phase_u(p, pass, lds); break;
    case 4: if (EN(4)) phase_scan(p, pass, dry); break;
    case 5: if (EN(5)) phase_dsa(p, pass, lds, dry); break;
    case 9: if (EN(9)) phase_o(p, pass, lds, dry); break;
    case 10: if (EN(10)) phase_att(p, pass, lds, dry, xcc); break;
    case 6: if (EN(6)) phase_merge(p, pass, lds, dry); break;
    case 7: if (EN(7)) phase_out(p, pass, lds); break;
    case 8: if (EN(8)) phase_ln_out(p, pass, dry); break;
  }
}

#if ONE_LAUNCH
#ifndef PROBE_BAR2
#define PROBE_BAR2 0
#endif
#define XBAR do { xcd_barrier(xb); if (PROBE_BAR2) xcd_barrier(xb); } while (0)
#ifndef PROBE_REP
#define PROBE_REP 0
#endif
#define RUNP(ph) do { if ((PROBE_REP >> (ph)) & 1) run_phase(p, pass, ph, lds, true, xb.x); run_phase(p, pass, ph, lds, false, xb.x); } while (0)
__global__ void __launch_bounds__(256, 2) fwd_kernel(Params p) {
  __shared__ __attribute__((aligned(16))) char lds[LDS_BYTES];
  __shared__ uint4 xb_words;
  cg::grid_group grid = cg::this_grid();
  if (threadIdx.x == 0) xb_words = make_uint4(0u, 0u, 0u, 0u);
  __syncthreads();
  XcdBarrier xb = xcd_barrier_post(p.bar, (volatile LAS unsigned*)&xb_words);
#pragma unroll 1
  for (int pass = 0; pass < 2; ++pass) {
    RUNP(0);
    if (pass == 0) grid.sync(); else XBAR;
    RUNP(1); XBAR;
    RUNP(2); XBAR;
    RUNP(3); XBAR;
    RUNP(4); XBAR;
    RUNP(5);
    RUNP(9); XBAR;
    RUNP(10); XBAR;
    RUNP(6); XBAR;
    RUNP(7); XBAR;
    RUNP(8);
  }
}
#else
template <int PH>
__global__ void __launch_bounds__(256, 2) phase_kernel(Params p, int pass) {
  __shared__ __attribute__((aligned(16))) char lds[LDS_BYTES];
  run_phase(p, pass, PH, lds, false, xb_xcc_id());
}
#endif

static inline size_t align_up(size_t x) { return (x + 255) & ~(size_t)255; }

extern "C" void kernel_launch(void* const* d_in, const int* in_sizes, int n_in, void* d_out, int out_size,
                              void* d_ws, size_t ws_size, hipStream_t stream) {
  Params p{};
  const float* const* in = (const float* const*)d_in;
  p.x_prompt = in[0]; p.x_sample = in[1]; p.cache_k = in[2]; p.cache_v = in[3]; p.cache_idx_k = in[4];
  p.state_gla = in[5]; p.meta = in[6]; p.ln_in_g = in[7]; p.ln_in_b = in[8]; p.w_in = in[9]; p.gla_w2 = in[10];
  p.gla_gate_b = in[11]; p.gla_norm_g = in[12]; p.idx_kn_g = in[13]; p.idx_kn_b = in[14]; p.w_gla = in[15];
  p.w_dsa = in[16]; p.gate_b = in[17]; p.w_out = in[18]; p.ln_g = in[19]; p.ln_b = in[20];
  float* o = (float*)d_out;
  p.y_prompt = o; o += (size_t)2 * 16384 * 1024;
  p.y_sample = o; o += (size_t)32 * 16 * 1024;
  p.k_prompt = o; o += (size_t)2 * SEQP * 256;
  p.v_prompt = o; o += (size_t)2 * SEQP * 256;
  p.idx_k_prompt = o; o += (size_t)2 * SEQP * 64;
  p.gla_prompt = o; o += (size_t)2 * 131072;
  p.k_sample = o; o += (size_t)512 * 256;
  p.v_sample = o; o += (size_t)512 * 256;
  p.idx_k_sample = o; o += (size_t)512 * 64;
  p.gla_sample = o; o += (size_t)32 * 131072;
  char* wsp = (char*)d_ws;
  size_t off = 0;
  auto take = [&](size_t bytes) { char* r = wsp + off; off = align_up(off + bytes); return r; };
  p.WinT = (u16*)take((size_t)NCOL * DM * 2);
  p.WglaT = (u16*)take((size_t)DM * DM * 2);
  p.WdsaT = (u16*)take((size_t)DM * DM * 2);
  p.WoutT = (u16*)take((size_t)DM * DM * 2);
  p.H = (u16*)take((size_t)RPMAX * DM * 2);
  p.P = (u16*)take((size_t)(RPMAX + 8) * NCOL * 2);
  p.KI = (u16*)take((size_t)RPMAX * 64 * 2);
  p.US = (u16*)take((size_t)289 * 131072 * 2);
  p.KV8S = (u8*)take((size_t)32 * NKEYS_S * 512);
  p.KV8P = (u8*)take((size_t)SEQP * 512);
  p.KIS = (u16*)take((size_t)32 * NKEYS_S * 64 * 2);
  p.SEL = (u16*)take((size_t)RPMAX * 256 * 2);
  p.STATS = (float*)take((size_t)NROWS * 2 * 4);
  p.PS = (float*)take((size_t)RPMAX * 128 * 4);
  p.DEC = (float*)take((size_t)289 * 512 * 4);
  p.bar = (unsigned*)take((size_t)(XCD_BAR_WORDS + 128) * 4);
  if (off > ws_size) { fprintf(stderr, "workspace too small: need %zu have %zu\n", off, ws_size); return; }
#if ONE_LAUNCH
  static int grid_blocks = 0;
  if (!grid_blocks) {
    int dev = 0, cus = 0, per_cu = 0;
    hipGetDevice(&dev);
    hipDeviceGetAttribute(&cus, hipDeviceAttributeMultiprocessorCount, dev);
    hipOccupancyMaxActiveBlocksPerMultiprocessor(&per_cu, fwd_kernel, 256, 0);
    per_cu = 2;
    grid_blocks = cus * per_cu;
  }
  (void)hipMemsetAsync(p.bar, 0, (size_t)(XCD_BAR_WORDS + 128) * 4, stream);
  void* args[] = {&p};
  hipError_t e = hipLaunchCooperativeKernel((void*)fwd_kernel, dim3(grid_blocks), dim3(256), args, 0, stream);
  if (e != hipSuccess) fprintf(stderr, "cooperative launch failed: %s (grid %d)\n", hipGetErrorString(e), grid_blocks);
#else
  (void)hipMemsetAsync(p.bar, 0, (size_t)(XCD_BAR_WORDS + 128) * 4, stream);
  for (int pass = 0; pass < 2; ++pass) {
    phase_kernel<0><<<512, 256, 0, stream>>>(p, pass);
    phase_kernel<1><<<512, 256, 0, stream>>>(p, pass);
    phase_kernel<2><<<512, 256, 0, stream>>>(p, pass);
    phase_kernel<3><<<512, 256, 0, stream>>>(p, pass);
    phase_kernel<4><<<512, 256, 0, stream>>>(p, pass);
    phase_kernel<5><<<512, 256, 0, stream>>>(p, pass);
    phase_kernel<10><<<512, 256, 0, stream>>>(p, pass);
    phase_kernel<9><<<512, 256, 0, stream>>>(p, pass);
    phase_kernel<6><<<512, 256, 0, stream>>>(p, pass);
    phase_kernel<7><<<512, 256, 0, stream>>>(p, pass);
    phase_kernel<8><<<512, 256, 0, stream>>>(p, pass);
  }
#endif
}
```

```cpp
#include <hip/hip_runtime.h>
#include <hip/hip_bf16.h>
#include <hip/hip_cooperative_groups.h>
#include <stdint.h>
#include <stdio.h>
namespace cg = cooperative_groups;

typedef unsigned short u16;
typedef unsigned char u8;
typedef uint32_t u32;
typedef __attribute__((ext_vector_type(8))) short bf16x8;
typedef __attribute__((ext_vector_type(4))) short s16x4;
typedef __attribute__((ext_vector_type(4))) float f32x4;
typedef __attribute__((ext_vector_type(16))) float f32x16;
typedef short v4i16_t __attribute__((ext_vector_type(4)));
typedef __attribute__((ext_vector_type(4))) unsigned int u32x4;
typedef __attribute__((address_space(3))) v4i16_t* lds_v4p;

#ifndef ONE_LAUNCH
#define ONE_LAUNCH 1
#endif

#define DM 1024
#define SEQP 16400
#define NPROMPT_ROWS 32800
#define NROWS 33312
#define RPMAX 16912
#define NCOL 8320
#define C_GQ 0
#define C_GK 512
#define C_GV 1024
#define C_GR 2048
#define C_DQ 3072
#define C_DK 4096
#define C_DV 4352
#define C_IQ 4608
#define C_DZ 5120
#define C_MA 6144
#define C_MB 7168
#define C_SM 8192
#define NKEYS_S 2064
#define CAP 576
#define CLIMIT 544
#define CVN 9
#define NORM_EPS 1e-5f
#define ALPHA_F 1.189207115002721f
#define IDX_W_SCALE 0.04419417382415922f
#define GLA_QSCALE 0.08838834764831845f
#define DSA_SCALE 0.125f

struct Params {
  const float *x_prompt, *x_sample, *cache_k, *cache_v, *cache_idx_k, *state_gla, *meta, *ln_in_g, *ln_in_b,
      *w_in, *gla_w2, *gla_gate_b, *gla_norm_g, *idx_kn_g, *idx_kn_b, *w_gla, *w_dsa, *gate_b, *w_out, *ln_g, *ln_b;
  float *y_prompt, *y_sample, *k_prompt, *v_prompt, *idx_k_prompt, *gla_prompt, *k_sample, *v_sample, *idx_k_sample, *gla_sample;
  u16 *WinT, *WglaT, *WdsaT, *WoutT, *H, *P, *KI, *US, *KIS, *SEL;
  u8 *KV8S, *KV8P;
  float *STATS, *PS, *DEC;
  unsigned* bar;
};

#define XB_TMO      128
#define XB_XCNT(j)  (256  + 64 * (j))
#define XB_XSUB(j)  (1280 + 64 * (j))
#define XB_XGEN(j)  (2304 + 64 * (j))
#define XB_TOP      3328
#define XB_TOPGEN   3392
#define XCD_BAR_WORDS 3456
#define XB_SPIN_CAP (1u << 22)
#define LAS __attribute__((address_space(3)))
__device__ __forceinline__ unsigned xb_ld(unsigned* p)              { return __hip_atomic_load(p, __ATOMIC_RELAXED, __HIP_MEMORY_SCOPE_AGENT); }
__device__ __forceinline__ unsigned xb_add(unsigned* p, unsigned v) { return __hip_atomic_fetch_add(p, v, __ATOMIC_RELAXED, __HIP_MEMORY_SCOPE_AGENT); }
__device__ __forceinline__ unsigned xb_xcc_id() { return (unsigned)__builtin_amdgcn_s_getreg((3 << 11) | 20) & 0xFu; }
#define XB_SPIN(cond, bar) do { unsigned _sp = 0; while (cond) { __builtin_amdgcn_s_sleep(1); \
    if ((++_sp & 255u) == 0u) { if (xb_ld(&(bar)[XB_TMO])) break; if (_sp > XB_SPIN_CAP) { atomicAdd(&(bar)[XB_TMO], 1u); break; } } } } while (0)
struct XcdBarrier { unsigned* bar; unsigned x; volatile LAS unsigned* st; };
__device__ __forceinline__ XcdBarrier xcd_barrier_post(unsigned* bar, volatile LAS unsigned* st) {
    XcdBarrier b; b.bar = bar; b.x = xb_xcc_id(); b.st = st;
    if (threadIdx.x == 0) (void)xb_add(&bar[XB_XCNT(b.x)], 1u);
    return b;
}
__device__ __forceinline__ void xcd_barrier_complete(unsigned* bar, unsigned x, unsigned& nloc, unsigned& nx) {
    const unsigned G = gridDim.x * gridDim.y * gridDim.z;
    unsigned sum, cnt, mine, sp = 0u;
    for (;;) {
        sum = 0u; cnt = 0u; mine = 0u;
#pragma unroll
        for (unsigned j = 0; j < 16; ++j) { const unsigned c = xb_ld(&bar[XB_XCNT(j)]); sum += c; cnt += (c > 0u) ? 1u : 0u; mine = (j == x) ? c : mine; }
        if (sum == G) break;
        __builtin_amdgcn_s_sleep(1);
        if ((++sp & 255u) == 0u) { if (xb_ld(&bar[XB_TMO])) break; if (sp > XB_SPIN_CAP) { atomicAdd(&bar[XB_TMO], 1u); break; } }
    }
    nloc = mine > 0u ? mine : 1u; nx = cnt > 0u ? cnt : 1u;
}
__device__ __forceinline__ void xcd_barrier(const XcdBarrier& b) {
    asm volatile("s_waitcnt vmcnt(0)" ::: "memory");
    __syncthreads();
    if (threadIdx.x == 0) {
        unsigned* bar = b.bar;
        __builtin_amdgcn_s_waitcnt(0);
        unsigned nloc = b.st[0], nx = b.st[1];
        if (nloc == 0u) { xcd_barrier_complete(bar, b.x, nloc, nx); b.st[0] = nloc; b.st[1] = nx; }
        const unsigned old = xb_add(&bar[XB_XSUB(b.x)], 1u);
        const unsigned gen = old / nloc;
        if (old + 1u == (gen + 1u) * nloc) {
            __builtin_amdgcn_fence(__ATOMIC_RELEASE, "agent");
            asm volatile("s_waitcnt vmcnt(0)" ::: "memory");
            const unsigned og = xb_add(&bar[XB_TOP], 1u);
            const unsigned tg = og / nx;
            if (og + 1u == (tg + 1u) * nx) xb_add(&bar[XB_TOPGEN], 1u);
            else XB_SPIN(xb_ld(&bar[XB_TOPGEN]) == tg, bar);
            __builtin_amdgcn_fence(__ATOMIC_ACQUIRE, "agent");
            xb_add(&bar[XB_XGEN(b.x)], 1u);
            asm volatile("s_waitcnt vmcnt(0)" ::: "memory");
        } else {
            XB_SPIN(xb_ld(&bar[XB_XGEN(b.x)]) == gen, bar);
            __builtin_amdgcn_fence(__ATOMIC_ACQUIRE, "agent");
            asm volatile("s_waitcnt vmcnt(0)" ::: "memory");
        }
    }
    __syncthreads();
}

__device__ __forceinline__ int tid_opaque() { int t = threadIdx.x; asm volatile("" : "+v"(t)); return t; }
#define TIDX tid_opaque()
__device__ __forceinline__ u16 f2bf(float f) {
  u32 u = __float_as_uint(f);
  u += 0x7fffu + ((u >> 16) & 1u);
  return (u16)(u >> 16);
}
__device__ __forceinline__ float bf2f(u16 h) { return __uint_as_float(((u32)h) << 16); }
__device__ __forceinline__ u32 pack2(float a, float b) { return (u32)f2bf(a) | ((u32)f2bf(b) << 16); }
__device__ __forceinline__ float relu1(float x) { float r; asm("v_max_f32 %0, 0, %1" : "=v"(r) : "v"(x)); return r; }
__device__ __forceinline__ u32 cvt_pk_bf16(float lo, float hi) { u32 r; asm("v_cvt_pk_bf16_f32 %0, %1, %2" : "=v"(r) : "v"(lo), "v"(hi)); return r; }
__device__ __forceinline__ u32 pk4_fp8(float a, float b, float c, float d) {
  int r = __builtin_amdgcn_cvt_pk_fp8_f32(a, b, 0, false);
  r = __builtin_amdgcn_cvt_pk_fp8_f32(c, d, r, true);
  return (u32)r;
}
__device__ __forceinline__ void fp8x4_to_bf16(u32 x, u32& lo, u32& hi) {
  auto a = __builtin_amdgcn_cvt_pk_f32_fp8((int)x, false);
  auto b = __builtin_amdgcn_cvt_pk_f32_fp8((int)x, true);
  lo = cvt_pk_bf16(a[0], a[1]); hi = cvt_pk_bf16(b[0], b[1]);
}
__device__ __forceinline__ float sigmoidf_(float x) { return 1.f / (1.f + __expf(-x)); }
__device__ __forceinline__ float siluf_(float x) { return x / (1.f + __expf(-x)); }

__device__ __forceinline__ float wave_sum(float v) {
#pragma unroll
  for (int o = 32; o > 0; o >>= 1) v += __shfl_xor(v, o);
  return v;
}

__device__ __forceinline__ const float* xrow_ptr(const Params& p, int gr) {
  if (gr < NPROMPT_ROWS) {
    int b = gr / SEQP, pos = gr - b * SEQP;
    return pos < 16 ? p.meta + pos * DM : p.x_prompt + ((size_t)b * 16384 + (pos - 16)) * DM;
  }
  return p.x_sample + (size_t)(gr - NPROMPT_ROWS) * DM;
}
__device__ __forceinline__ float* yrow_ptr(const Params& p, int gr) {
  if (gr < NPROMPT_ROWS) {
    int b = gr / SEQP, pos = gr - b * SEQP;
    return pos < 16 ? nullptr : p.y_prompt + ((size_t)b * 16384 + (pos - 16)) * DM;
  }
  return p.y_sample + (size_t)(gr - NPROMPT_ROWS) * DM;
}

__device__ __forceinline__ int src_col(int n) {
  if (n < 2048) return n;
  if (n < 3072) return n - 2048 + 2064;
  if (n < 4096) return n - 3072 + 3088;
  if (n < 4352) return n - 4096 + 4112;
  if (n < 4608) return n - 4352 + 4368;
  if (n < 5120) return n - 4608 + 4624;
  if (n < 6144) return n - 5120 + 5208;
  if (n < 7168) return n - 6144 + 6232;
  if (n < 8192) return n - 7168 + 7256;
  if (n < 8256) return n - 8192 + 5136;
  if (n < 8272) return n - 8256 + 2048;
  if (n < 8280) return n - 8272 + 5200;
  return -1;
}

__device__ __forceinline__ int pass_row0(int pass) { return pass == 0 ? 0 : SEQP; }
__device__ __forceinline__ int pass_rows(int pass) { return pass == 0 ? SEQP : RPMAX; }
__device__ __forceinline__ int pass_nblk(int pass) { return pass == 0 ? 257 : 289; }
__device__ __forceinline__ void blk_info(int blk, int& row0, int& len) {
  if (blk < 257) { row0 = blk * 64; len = (blk == 256) ? 16 : 64; }
  else { row0 = SEQP + 16 * (blk - 257); len = 16; }
}

__device__ __forceinline__ int dq_next(unsigned* ctr, char* lds) {
  int* item = (int*)(lds + 77808);
  __syncthreads();
  if (TIDX == 0) *item = (int)atomicAdd(ctr, 1u);
  __syncthreads();
  return *item;
}

__device__ __forceinline__ void transpose_tile(const float* __restrict__ src, int nsrc, u16* __restrict__ dst, int k0, int n0, bool map, float* tile) {
  int tx = TIDX & 63, ty = TIDX >> 6;
  int sc = map ? src_col(n0 + tx) : (n0 + tx);
  for (int kk = ty; kk < 64; kk += 4) tile[kk * 65 + tx] = sc >= 0 ? src[(size_t)(k0 + kk) * nsrc + sc] : 0.f;
  __syncthreads();
  for (int nn = ty; nn < 64; nn += 4) dst[(size_t)(n0 + nn) * DM + k0 + tx] = f2bf(tile[tx * 65 + nn]);
  __syncthreads();
}

__device__ __forceinline__ void phase_prep(const Params& p, char* lds) {
  float* tile = (float*)lds;
  const int nt_in = 130 * 16;
  const int nt_all = nt_in + 3 * 256;
  for (int t = blockIdx.x; t < nt_all; t += gridDim.x) {
    if (t < nt_in) {
      transpose_tile(p.w_in, 8280, p.WinT, (t & 15) * 64, (t >> 4) * 64, true, tile);
    } else {
      int u = t - nt_in, w = u >> 8, r = u & 255;
      const float* s = w == 0 ? p.w_gla : (w == 1 ? p.w_dsa : p.w_out);
      u16* d = w == 0 ? p.WglaT : (w == 1 ? p.WdsaT : p.WoutT);
      transpose_tile(s, DM, d, (r & 15) * 64, (r >> 4) * 64, false, tile);
    }
  }
  const size_t nk4 = (size_t)32 * 2048 * 256 / 4;
  size_t stride = (size_t)gridDim.x * blockDim.x;
  for (size_t i = (size_t)blockIdx.x * blockDim.x + TIDX; i < nk4; i += stride) {
    size_t e = i * 4; size_t row = e >> 8; int c = (int)(e & 255);
    size_t sb = row >> 11, j = row & 2047;
    float4 kv = *(const float4*)(p.cache_k + e);
    float4 vv = *(const float4*)(p.cache_v + e);
    u8* o = p.KV8S + (sb * NKEYS_S + j) * 512 + (c >> 6) * 128 + (c & 63);
    *(u32*)o = pk4_fp8(kv.x, kv.y, kv.z, kv.w);
    *(u32*)(o + 64) = pk4_fp8(vv.x, vv.y, vv.z, vv.w);
  }
  const size_t ni4 = (size_t)32 * 2048 * 64 / 4;
  for (size_t i = (size_t)blockIdx.x * blockDim.x + TIDX; i < ni4; i += stride) {
    size_t e = i * 4; size_t row = e >> 6; int c = (int)(e & 63);
    size_t sb = row >> 11, j = row & 2047;
    float4 kv = *(const float4*)(p.cache_idx_k + e);
    *(uint2*)(p.KIS + (sb * NKEYS_S + j) * 64 + c) = make_uint2(pack2(kv.x, kv.y), pack2(kv.z, kv.w));
  }
}

__device__ __forceinline__ void phase_ln_in(const Params& p, int pass) {
  int R = pass_rows(pass), r0 = pass_row0(pass);
  int wave = TIDX >> 6, lane = TIDX & 63;
  for (int m = blockIdx.x * 4 + wave; m < R; m += gridDim.x * 4) {
    int gr = r0 + m;
    const float* x = xrow_ptr(p, gr);
    float4 v[4];
    float s = 0.f;
#pragma unroll
    for (int i = 0; i < 4; ++i) { v[i] = *(const float4*)(x + i * 256 + lane * 4); s += v[i].x + v[i].y + v[i].z + v[i].w; }
    float mu = wave_sum(s) * (1.f / DM);
    float q = 0.f;
#pragma unroll
    for (int i = 0; i < 4; ++i) {
      float a = v[i].x - mu, b = v[i].y - mu, c = v[i].z - mu, d = v[i].w - mu;
      q += a * a + b * b + c * c + d * d;
    }
    float rstd = rsqrtf(wave_sum(q) * (1.f / DM) + NORM_EPS);
#pragma unroll
    for (int i = 0; i < 4; ++i) {
      int c = i * 256 + lane * 4;
      float4 g = *(const float4*)(p.ln_in_g + c), b = *(const float4*)(p.ln_in_b + c);
      float h0 = (v[i].x - mu) * rstd * g.x + b.x, h1 = (v[i].y - mu) * rstd * g.y + b.y;
      float h2 = (v[i].z - mu) * rstd * g.z + b.z, h3 = (v[i].w - mu) * rstd * g.w + b.w;
      *(uint2*)(p.H + (size_t)m * DM + c) = make_uint2(pack2(h0, h1), pack2(h2, h3));
    }
    if (lane == 0) { p.STATS[gr * 2] = mu; p.STATS[gr * 2 + 1] = rstd; }
  }
}

#define GS 72
template <bool SWAP = false>
__device__ __forceinline__ void gemm_core(const u16* __restrict__ A, int lda, int m0, int mvalid,
                                          const u16* __restrict__ B, int ldb, int n0, int K,
                                          f32x16 (&acc)[2][2], u16* lds) {
  const int tid = TIDX, lane = tid & 63, w = tid >> 6, wm = w >> 1, wn = w & 1;
  u16* As = lds;
  u16* Bs = lds + 2 * 128 * GS;
  uint4 ra0, ra1, ra2, ra3, rb0, rb1, rb2, rb3;
  const int nk = K >> 6;
  const int lrow = tid >> 3, lch = tid & 7;
  const u16* ap[4]; const u16* bp[4];
#pragma unroll
  for (int i = 0; i < 4; ++i) {
    int ar = m0 + lrow + 32 * i; ar = ar < mvalid ? ar : mvalid - 1;
    ap[i] = A + (size_t)ar * lda + lch * 8;
    bp[i] = B + (size_t)(n0 + lrow + 32 * i) * ldb + lch * 8;
  }
#define GLOAD(kt) do { \
    ra0 = *(const uint4*)(ap[0] + (kt) * 64); ra1 = *(const uint4*)(ap[1] + (kt) * 64); \
    ra2 = *(const uint4*)(ap[2] + (kt) * 64); ra3 = *(const uint4*)(ap[3] + (kt) * 64); \
    rb0 = *(const uint4*)(bp[0] + (kt) * 64); rb1 = *(const uint4*)(bp[1] + (kt) * 64); \
    rb2 = *(const uint4*)(bp[2] + (kt) * 64); rb3 = *(const uint4*)(bp[3] + (kt) * 64); } while (0)
#define GSWRITE(buf) do { \
    u16* as_ = As + ((buf) * 128 + lrow) * GS + lch * 8; u16* bs_ = Bs + ((buf) * 128 + lrow) * GS + lch * 8; \
    *(uint4*)(as_) = ra0; *(uint4*)(as_ + 32 * GS) = ra1; *(uint4*)(as_ + 64 * GS) = ra2; *(uint4*)(as_ + 96 * GS) = ra3; \
    *(uint4*)(bs_) = rb0; *(uint4*)(bs_ + 32 * GS) = rb1; *(uint4*)(bs_ + 64 * GS) = rb2; *(uint4*)(bs_ + 96 * GS) = rb3; } while (0)
  GLOAD(0);
  GSWRITE(0);
  __syncthreads();
  for (int kt = 0; kt < nk; ++kt) {
    int buf = kt & 1;
    if (kt + 1 < nk) GLOAD(kt + 1);
    __builtin_amdgcn_sched_barrier(0);
    bf16x8 af[4][2], bf[4][2];
#pragma unroll
    for (int ks = 0; ks < 4; ++ks)
#pragma unroll
      for (int t = 0; t < 2; ++t) {
        af[ks][t] = *(const bf16x8*)(As + (buf * 128 + wm * 64 + t * 32 + (lane & 31)) * GS + ks * 16 + (lane >> 5) * 8);
        bf[ks][t] = *(const bf16x8*)(Bs + (buf * 128 + wn * 64 + t * 32 + (lane & 31)) * GS + ks * 16 + (lane >> 5) * 8);
      }
    __builtin_amdgcn_sched_barrier(0);
#pragma unroll
    for (int ks = 0; ks < 4; ++ks)
#pragma unroll
      for (int tm = 0; tm < 2; ++tm)
#pragma unroll
        for (int tn = 0; tn < 2; ++tn)
          acc[tm][tn] = SWAP ? __builtin_amdgcn_mfma_f32_32x32x16_bf16(bf[ks][tn], af[ks][tm], acc[tm][tn], 0, 0, 0)
                             : __builtin_amdgcn_mfma_f32_32x32x16_bf16(af[ks][tm], bf[ks][tn], acc[tm][tn], 0, 0, 0);
    __builtin_amdgcn_sched_barrier(0);
    if (kt + 1 < nk) GSWRITE(buf ^ 1);
    __syncthreads();
  }
}
#define ACC_ROW(wm, tm, r, lane) ((wm) * 64 + (tm) * 32 + ((r) & 3) + 8 * ((r) >> 2) + 4 * ((lane) >> 5))
#define ACC_COL(wn, tn, lane) ((wn) * 64 + (tn) * 32 + ((lane) & 31))

#define ES 136
__device__ __forceinline__ void store_tile_bf16(const f32x16 (&acc)[2][2], u16* lds, u16* __restrict__ dst, int ldd, int m0, int mvalid, int n0) {
  const int tid = TIDX, lane = tid & 63, w = tid >> 6, wm = w >> 1, wn = w & 1;
#pragma unroll
  for (int tm = 0; tm < 2; ++tm)
#pragma unroll
    for (int tn = 0; tn < 2; ++tn)
#pragma unroll
      for (int r = 0; r < 16; ++r)
        lds[ACC_ROW(wm, tm, r, lane) * ES + ACC_COL(wn, tn, lane)] = f2bf(acc[tm][tn][r]);
  __syncthreads();
#pragma unroll
  for (int i = 0; i < 8; ++i) {
    int c = tid + 256 * i, row = c >> 4, ch = c & 15;
    if (m0 + row < mvalid) *(uint4*)(dst + (size_t)(m0 + row) * ldd + n0 + ch * 8) = *(const uint4*)(lds + row * ES + ch * 8);
  }
  __syncthreads();
}

__device__ __forceinline__ void phase_gemm1(const Params& p, int pass, char* lds, unsigned xcc) {
  int R = pass_rows(pass), r0 = pass_row0(pass);
  int mt = (R + 127) >> 7;
  int lane = TIDX & 63, w = TIDX >> 6, wm = w >> 1, wn = w & 1;
  int* item = (int*)(lds + 77808);
  unsigned* ctr = p.bar + XCD_BAR_WORDS + 32 + pass * 8;
  int q = (int)(xcc & 7u), tries = 0;
  while (tries < 8) {
    __syncthreads();
    if (TIDX == 0) *item = (int)atomicAdd(&ctr[q], 1u);
    __syncthreads();
    int idx = *item;
    int nq = mt * 8 + (mt - q + 7) / 8;
    if (idx >= nq) { q = (q + 1) & 7; ++tries; continue; }
    int tm_, tn_;
    if (idx < mt * 8) { tm_ = idx >> 3; tn_ = q * 8 + (idx & 7); }
    else { tm_ = q + 8 * (idx - mt * 8); tn_ = 64; }
    int m0 = tm_ * 128, n0 = tn_ * 128;
    f32x16 acc[2][2];
#pragma unroll
    for (int i = 0; i < 2; ++i)
#pragma unroll
      for (int j = 0; j < 2; ++j)
#pragma unroll
        for (int r = 0; r < 16; ++r) acc[i][j][r] = 0.f;
    gemm_core<true>(p.H, DM, m0, R, p.WinT, DM, n0, DM, acc, (u16*)lds);
    int kind = 0;
    if (n0 >= C_DK && n0 < C_DV) kind = 1; else if (n0 >= C_DV && n0 < C_IQ) kind = 2; else if (n0 >= C_SM) kind = 3;
    const int half = lane >> 5;
#pragma unroll
    for (int tm = 0; tm < 2; ++tm) {
      int m = m0 + wm * 64 + tm * 32 + (lane & 31);
      if (kind != 3) {
#pragma unroll
        for (int tn = 0; tn < 2; ++tn)
#pragma unroll
          for (int gp = 0; gp < 2; ++gp) {
            u32 a0 = pack2(acc[tm][tn][8 * gp + 0], acc[tm][tn][8 * gp + 1]), a1 = pack2(acc[tm][tn][8 * gp + 2], acc[tm][tn][8 * gp + 3]);
            u32 b0 = pack2(acc[tm][tn][8 * gp + 4], acc[tm][tn][8 * gp + 5]), b1 = pack2(acc[tm][tn][8 * gp + 6], acc[tm][tn][8 * gp + 7]);
            auto s0 = __builtin_amdgcn_permlane32_swap(a0, b0, false, false);
            auto s1 = __builtin_amdgcn_permlane32_swap(a1, b1, false, false);
            int n = n0 + wn * 64 + tn * 32 + 8 * (2 * gp + half);
            if (m < R) *(uint4*)(p.P + (size_t)m * NCOL + n) = make_uint4(s0[0], s1[0], s0[1], s1[1]);
          }
      }
      if (kind != 0 && m < R) {
        int gr = r0 + m;
#pragma unroll
        for (int tn = 0; tn < 2; ++tn)
#pragma unroll
          for (int g = 0; g < 4; ++g) {
            int n = n0 + wn * 64 + tn * 32 + 8 * g + 4 * half;
            float4 v = make_float4(acc[tm][tn][4 * g + 0], acc[tm][tn][4 * g + 1], acc[tm][tn][4 * g + 2], acc[tm][tn][4 * g + 3]);
            if (kind == 3) {
              *(float4*)(p.PS + (size_t)m * 128 + (n - C_SM)) = v;
            } else {
              float* base = kind == 1 ? (gr < NPROMPT_ROWS ? p.k_prompt : p.k_sample) : (gr < NPROMPT_ROWS ? p.v_prompt : p.v_sample);
              int rr = gr < NPROMPT_ROWS ? gr : gr - NPROMPT_ROWS;
              *(float4*)(base + (size_t)rr * 256 + (n - (kind == 1 ? C_DK : C_DV))) = v;
            }
          }
      }
    }
  }
}

__device__ __forceinline__ void phase_tok(const Params& p, int pass, char* lds, bool dry) {
  float* glow = (float*)lds;
  int r0g = pass_row0(pass);
  int nblk = pass_nblk(pass);
  int tid = TIDX, lane = tid & 63, wave = tid >> 6;
  for (int tile = blockIdx.x; tile < nblk * 2; tile += gridDim.x) {
    int blk = tile >> 1, hf = tile & 1;
    int row0, len; blk_info(blk, row0, len);
    for (int t = wave; t < (hf == 0 ? len : 0); t += 4) {
      int m = row0 + t, gr = r0g + m;
      float x = p.PS[(size_t)m * 128 + lane];
      float mu = wave_sum(x) * (1.f / 64);
      float xc = x - mu;
      float var = wave_sum(xc * xc) * (1.f / 64);
      float y = xc * rsqrtf(var + NORM_EPS) * p.idx_kn_g[lane] + p.idx_kn_b[lane];
      u16 yb = f2bf(y);
      p.KI[(size_t)m * 64 + lane] = yb;
      if (gr < NPROMPT_ROWS) p.idx_k_prompt[(size_t)gr * 64 + lane] = y;
      else {
        int sr = gr - NPROMPT_ROWS; p.idx_k_sample[(size_t)sr * 64 + lane] = y;
        int sb = sr >> 4, tt = sr & 15;
        p.KIS[((size_t)sb * NKEYS_S + 2048 + tt) * 64 + lane] = yb;
      }
    }
    if (hf == 0) {
      u8* dst0 = blk < 257 ? p.KV8P + (size_t)row0 * 512 : p.KV8S + ((size_t)(blk - 257) * NKEYS_S + 2048) * 512;
      for (int i = tid; i < len * 64; i += 256) {
        int tt = i >> 6, c = (i & 63) * 4;
        const u16* src = p.P + (size_t)(row0 + tt) * NCOL + C_DK + c;
        uint2 kk = *(const uint2*)src, vv = *(const uint2*)(src + 256);
        u8* o = dst0 + (size_t)tt * 512 + (c >> 6) * 128 + (c & 63);
        *(u32*)o = pk4_fp8(bf2f((u16)(kk.x & 0xffff)), bf2f((u16)(kk.x >> 16)), bf2f((u16)(kk.y & 0xffff)), bf2f((u16)(kk.y >> 16)));
        *(u32*)(o + 64) = pk4_fp8(bf2f((u16)(vv.x & 0xffff)), bf2f((u16)(vv.x >> 16)), bf2f((u16)(vv.y & 0xffff)), bf2f((u16)(vv.y >> 16)));
      }
    }
    for (int i = tid; i < 64 * 16; i += 256) {
      int t = i >> 4, r = i & 15;
      glow[i] = t < len ? p.PS[(size_t)(row0 + t) * 128 + 64 + r] : 0.f;
    }
    __syncthreads();
    {
      const int ch = hf * 256 + tid;
      float w2[16];
#pragma unroll
      for (int r = 0; r < 16; ++r) w2[r] = p.gla_w2[r * 512 + ch];
      float bias = p.gla_gate_b[ch];
      float b = 0.f;
      for (int t0 = 0; t0 < len; t0 += 16) {
        u32 qr[16], kr[16];
#pragma unroll
        for (int j = 0; j < 16; ++j) {
          size_t o = (size_t)(row0 + t0 + j) * NCOL;
          qr[j] = 0u; kr[j] = 0u;
          if (t0 + j < len) { qr[j] = p.P[o + C_GQ + ch]; kr[j] = p.P[o + C_GK + ch]; }
        }
        __builtin_amdgcn_sched_barrier(0);
#pragma unroll
        for (int j = 0; j < 16; ++j) {
          const int t = t0 + j;
          if (t < len) {
            float x = bias;
#pragma unroll
            for (int r = 0; r < 16; ++r) x += glow[t * 16 + r] * w2[r];
            float ls = fminf(x, 0.f) - log1pf(expf(-fabsf(x)));
            b += ls * (1.f / 16.f);
            size_t o = (size_t)(row0 + t) * NCOL;
            float qv = bf2f((u16)qr[j]) * GLA_QSCALE * expf(b);
            float kv = bf2f((u16)kr[j]) * expf(-b);
            if (!dry) { p.P[o + C_GQ + ch] = f2bf(qv); p.P[o + C_GK + ch] = f2bf(kv); }
          }
        }
      }
      p.DEC[blk * 512 + ch] = expf(b);
    }
    __syncthreads();
  }
}

#define TS 72
template <int NIT>
__device__ __forceinline__ void stage_transposed(const u16* __restrict__ P, int row0, int len, int col0, u16* dst) {
  const int tid = TIDX, t = tid & 63, dc0 = tid >> 6;
  u32x4 v[NIT];
  const u16* src = P + (size_t)(row0 + (t < len ? t : 0)) * NCOL + col0;
#pragma unroll
  for (int i = 0; i < NIT; ++i) v[i] = *(const u32x4*)(src + (dc0 + 4 * i) * 8);
  __builtin_amdgcn_sched_barrier(0);
#pragma unroll
  for (int i = 0; i < NIT; ++i) {
    u32x4 x = v[i];
    if (t >= len) x = u32x4{0u, 0u, 0u, 0u};
    u16* d = dst + ((dc0 + 4 * i) * 8) * TS + t;
    d[0 * TS] = (u16)(x[0] & 0xffff); d[1 * TS] = (u16)(x[0] >> 16);
    d[2 * TS] = (u16)(x[1] & 0xffff); d[3 * TS] = (u16)(x[1] >> 16);
    d[4 * TS] = (u16)(x[2] & 0xffff); d[5 * TS] = (u16)(x[2] >> 16);
    d[6 * TS] = (u16)(x[3] & 0xffff); d[7 * TS] = (u16)(x[3] >> 16);
  }
}

__device__ __forceinline__ void phase_u(const Params& p, int pass, char* lds) {
  u16* KT = (u16*)lds;
  u16* VT = KT + 128 * TS;
  int nblk = pass_nblk(pass);
  int lane = TIDX & 63, w = TIDX >> 6;
  unsigned* ctr = p.bar + XCD_BAR_WORDS + 64 + pass;
  for (int t = dq_next(ctr, lds); t < nblk * 4; t = dq_next(ctr, lds)) {
    int blk = t >> 2, h = t & 3;
    int row0, len; blk_info(blk, row0, len);
    stage_transposed<4>(p.P, row0, len, C_GK + h * 128, KT);
    stage_transposed<8>(p.P, row0, len, C_GV + h * 256, VT);
    __syncthreads();
#pragma unroll
    for (int half = 0; half < 2; ++half) {
      f32x16 acc[2][2];
#pragma unroll
      for (int i = 0; i < 2; ++i)
#pragma unroll
        for (int j = 0; j < 2; ++j)
#pragma unroll
          for (int r = 0; r < 16; ++r) acc[i][j][r] = 0.f;
#pragma unroll
      for (int ks = 0; ks < 4; ++ks) {
        bf16x8 a[2], b[2];
#pragma unroll
        for (int tn = 0; tn < 2; ++tn) {
          a[tn] = *(const bf16x8*)(VT + (w * 64 + tn * 32 + (lane & 31)) * TS + ks * 16 + (lane >> 5) * 8);
          b[tn] = *(const bf16x8*)(KT + (half * 64 + tn * 32 + (lane & 31)) * TS + ks * 16 + (lane >> 5) * 8);
        }
#pragma unroll
        for (int tm = 0; tm < 2; ++tm)
#pragma unroll
          for (int tn = 0; tn < 2; ++tn)
            acc[tm][tn] = __builtin_amdgcn_mfma_f32_32x32x16_bf16(a[tm], b[tn], acc[tm][tn], 0, 0, 0);
      }
#pragma unroll
      for (int tn = 0; tn < 2; ++tn) {
        int d = half * 64 + tn * 32 + (lane & 31);
        float dec = p.DEC[blk * 512 + h * 128 + d];
#pragma unroll
        for (int tm = 0; tm < 2; ++tm)
#pragma unroll
          for (int r = 0; r < 16; ++r) {
            int e = w * 64 + tm * 32 + (r & 3) + 8 * (r >> 2) + 4 * (lane >> 5);
            p.US[((size_t)(blk * 4 + h) * 256 + e) * 128 + d] = f2bf(acc[tm][tn][r] * dec);
          }
      }
    }
    __syncthreads();
  }
}

__device__ __forceinline__ void phase_scan(const Params& p, int pass, bool dry) {
  int ntiles = 128 + (pass == 1 ? 32 * 128 : 0);
  for (int t = blockIdx.x; t < ntiles; t += gridDim.x) {
    bool samp = t >= 128;
    int sb = samp ? (t - 128) >> 7 : 0;
    int g4 = ((samp ? (t - 128) & 127 : t) << 8) + TIDX;
    int h = g4 >> 13, e = (g4 >> 5) & 255, d4 = (g4 & 31) * 4;
    float S[4];
    float* outp;
    int blk0, nb;
    if (!samp) {
      S[0] = S[1] = S[2] = S[3] = 0.f;
      outp = p.gla_prompt + (size_t)pass * 131072;
      blk0 = 0; nb = 257;
    } else {
      const float* st = p.state_gla + (size_t)sb * 131072;
#pragma unroll
      for (int j = 0; j < 4; ++j) S[j] = st[((size_t)(h * 128 + d4 + j)) * 256 + e];
      outp = p.gla_sample + (size_t)sb * 131072;
      blk0 = 257 + sb; nb = 1;
    }
    size_t eoff = (size_t)g4 * 4;
    for (int n0 = 0; n0 < nb; n0 += 8) {
      uint2 u[8]; float4 dc[8];
#pragma unroll
      for (int j = 0; j < 8; ++j) {
        int n = n0 + j; if (n < nb) {
          u[j] = *(const uint2*)(p.US + (size_t)(blk0 + n) * 131072 + eoff);
          dc[j] = *(const float4*)(p.DEC + (blk0 + n) * 512 + h * 128 + d4);
        }
      }
      __builtin_amdgcn_sched_barrier(0);
#pragma unroll
      for (int j = 0; j < 8; ++j) {
        int n = n0 + j; if (n < nb) {
          if (!dry) *(uint2*)(p.US + (size_t)(blk0 + n) * 131072 + eoff) = make_uint2(pack2(S[0], S[1]), pack2(S[2], S[3]));
          S[0] = dc[j].x * S[0] + bf2f((u16)(u[j].x & 0xffff));
          S[1] = dc[j].y * S[1] + bf2f((u16)(u[j].x >> 16));
          S[2] = dc[j].z * S[2] + bf2f((u16)(u[j].y & 0xffff));
          S[3] = dc[j].w * S[3] + bf2f((u16)(u[j].y >> 16));
        }
      }
    }
#pragma unroll
    for (int j = 0; j < 4; ++j) outp[((size_t)(h * 128 + d4 + j)) * 256 + e] = S[j];
  }
}

#define OS 264
__device__ __forceinline__ void phase_o(const Params& p, int pass, char* lds, bool dry) {
  u16* VT = (u16*)lds;
  u16* AS = VT + 256 * TS;
  u16* OT = VT;
  int nblk = pass_nblk(pass);
  int tid = TIDX, lane = tid & 63, w = tid >> 6;
  int* item = (int*)(lds + 77808);
  unsigned* ctr = p.bar + XCD_BAR_WORDS + 48 + (dry ? 8 : 0) + pass;
  for (;;) {
    __syncthreads();
    if (tid == 0) *item = (int)atomicAdd(ctr, 1u);
    __syncthreads();
    int t = *item;
    if (t >= nblk * 4) break;
    int blk = t >> 2, h = t & 3;
    int row0, len; blk_info(blk, row0, len);
    stage_transposed<8>(p.P, row0, len, C_GV + h * 256, VT);
    {
      int ti = w >> 1, tj = w & 1;
      f32x16 acc;
#pragma unroll
      for (int r = 0; r < 16; ++r) acc[r] = 0.f;
      if (tj <= ti) {
        int qi = ti * 32 + (lane & 31), kj = tj * 32 + (lane & 31);
        const u16* qp = p.P + (size_t)(row0 + (qi < len ? qi : 0)) * NCOL + C_GQ + h * 128 + (lane >> 5) * 8;
        const u16* kp = p.P + (size_t)(row0 + (kj < len ? kj : 0)) * NCOL + C_GK + h * 128 + (lane >> 5) * 8;
#pragma unroll
        for (int ks = 0; ks < 8; ++ks) {
          bf16x8 a = *(const bf16x8*)(qp + ks * 16), b = *(const bf16x8*)(kp + ks * 16);
          acc = __builtin_amdgcn_mfma_f32_32x32x16_bf16(a, b, acc, 0, 0, 0);
        }
      }
#pragma unroll
      for (int r = 0; r < 16; ++r) {
        int i = ti * 32 + (r & 3) + 8 * (r >> 2) + 4 * (lane >> 5), j = tj * 32 + (lane & 31);
        float v = (j <= i && i < len && j < len) ? acc[r] : 0.f;
        AS[i * TS + j] = f2bf(v);
      }
    }
    __syncthreads();
    f32x16 acc[2][2];
#pragma unroll
    for (int i = 0; i < 2; ++i)
#pragma unroll
      for (int j = 0; j < 2; ++j)
#pragma unroll
        for (int r = 0; r < 16; ++r) acc[i][j][r] = 0.f;
#pragma unroll
    for (int ks = 0; ks < 4; ++ks) {
      bf16x8 a[2], b[2];
#pragma unroll
      for (int x = 0; x < 2; ++x) {
        a[x] = *(const bf16x8*)(AS + (x * 32 + (lane & 31)) * TS + ks * 16 + (lane >> 5) * 8);
        b[x] = *(const bf16x8*)(VT + (w * 64 + x * 32 + (lane & 31)) * TS + ks * 16 + (lane >> 5) * 8);
      }
#pragma unroll
      for (int tm = 0; tm < 2; ++tm)
#pragma unroll
        for (int tn = 0; tn < 2; ++tn)
          acc[tm][tn] = __builtin_amdgcn_mfma_f32_32x32x16_bf16(a[tm], b[tn], acc[tm][tn], 0, 0, 0);
    }
    {
      const u16* Sp = p.US + (size_t)(blk * 4 + h) * 32768;
#pragma unroll
      for (int ks = 0; ks < 8; ++ks) {
        bf16x8 a[2], b[2];
#pragma unroll
        for (int x = 0; x < 2; ++x) {
          int qi = x * 32 + (lane & 31);
          bf16x8 z = {0, 0, 0, 0, 0, 0, 0, 0};
          a[x] = qi < len ? *(const bf16x8*)(p.P + (size_t)(row0 + qi) * NCOL + C_GQ + h * 128 + ks * 16 + (lane >> 5) * 8) : z;
          b[x] = *(const bf16x8*)(Sp + (size_t)(w * 64 + x * 32 + (lane & 31)) * 128 + ks * 16 + (lane >> 5) * 8);
        }
#pragma unroll
        for (int tm = 0; tm < 2; ++tm)
#pragma unroll
          for (int tn = 0; tn < 2; ++tn)
            acc[tm][tn] = __builtin_amdgcn_mfma_f32_32x32x16_bf16(a[tm], b[tn], acc[tm][tn], 0, 0, 0);
      }
    }
    __syncthreads();
#pragma unroll
    for (int tm = 0; tm < 2; ++tm)
#pragma unroll
      for (int tn = 0; tn < 2; ++tn)
#pragma unroll
        for (int r = 0; r < 16; ++r) {
          int i = tm * 32 + (r & 3) + 8 * (r >> 2) + 4 * (lane >> 5), e = w * 64 + tn * 32 + (lane & 31);
          OT[i * OS + e] = f2bf(acc[tm][tn][r]);
        }
    __syncthreads();
    {
      int i = tid >> 2, seg = tid & 3;
      float vals[64];
      float ss = 0.f;
#pragma unroll
      for (int c = 0; c < 8; ++c) {
        uint4 v = *(const uint4*)(OT + i * OS + seg * 64 + c * 8);
        u32 ww[4] = {v.x, v.y, v.z, v.w};
#pragma unroll
        for (int k = 0; k < 4; ++k) {
          float a = bf2f((u16)(ww[k] & 0xffff)), b = bf2f((u16)(ww[k] >> 16));
          vals[c * 8 + 2 * k] = a; vals[c * 8 + 2 * k + 1] = b; ss += a * a + b * b;
        }
      }
      ss += __shfl_xor(ss, 1); ss += __shfl_xor(ss, 2);
      float rstd = rsqrtf(ss * (1.f / 256) + NORM_EPS);
      if (i < len && !dry) {
        size_t o = (size_t)(row0 + i) * NCOL;
        u32x4 grv[8];
#pragma unroll
        for (int c = 0; c < 8; ++c) grv[c] = *(const u32x4*)(p.P + o + C_GR + h * 256 + seg * 64 + c * 8);
        __builtin_amdgcn_sched_barrier(0);
#pragma unroll
        for (int c = 0; c < 8; ++c) {
          int e = seg * 64 + c * 8;
          u32x4 ow;
#pragma unroll
          for (int k = 0; k < 4; ++k) {
            float g0 = bf2f((u16)(grv[c][k] & 0xffff)), g1 = bf2f((u16)(grv[c][k] >> 16));
            float y0 = vals[c * 8 + 2 * k] * rstd * p.gla_norm_g[e + 2 * k] * siluf_(g0);
            float y1 = vals[c * 8 + 2 * k + 1] * rstd * p.gla_norm_g[e + 2 * k + 1] * siluf_(g1);
            ow[k] = pack2(y0, y1);
          }
          *(u32x4*)(p.P + o + C_GV + h * 256 + e) = ow;
        }
      }
    }
    __syncthreads();
  }
}

struct DTile {
  int qrow0, qrow1;
  int nkeys0, nkeys1;
  const u16* ki; int ki_stride;
  const u16* kv; int kv_stride;
};

__device__ __forceinline__ u32 score_key(float s, int keyidx) {
  u32 u = __float_as_uint(s);
  u ^= (u32)(((int)u) >> 31) | 0x80000000u;
  return (u & 0xFFFF8000u) | (u32)(32767 - keyidx);
}

__device__ __forceinline__ void compact(u32* cand, int n, int hi, int& newcnt, u32& newthr) {
  int lane = TIDX & 63;
  u32 v[CVN];
#pragma unroll
  for (int e = 0; e < CVN; ++e) { int idx = lane + 64 * e; v[e] = idx < n ? cand[idx] : 0u; }
  u32 prefix = 0;
  for (int bit = 31; bit >= 0; --bit) {
    u32 trial = prefix | (1u << bit);
    int c = 0;
#pragma unroll
    for (int e = 0; e < CVN; ++e) c += __popcll(__ballot(v[e] >= trial));
    if (c >= 256) { prefix = trial; if (c <= hi) break; }
  }
  int base = 0;
  unsigned long long lt = (1ull << lane) - 1ull;
#pragma unroll
  for (int e = 0; e < CVN; ++e) {
    bool keep = v[e] >= prefix && prefix != 0;
    unsigned long long m = __ballot(keep);
    int pos = base + __popcll(m & lt);
    if (keep) cand[pos] = v[e];
    base += __popcll(m);
  }
  newcnt = base; newthr = prefix - 1u;
}

__device__ __forceinline__ void dsa_tile(const Params& p, const DTile& T, char* lds, bool dry) {
  u32* cand = (u32*)lds;
  u16* kst = (u16*)(lds + 32 * CAP * 4);
  const int tid = TIDX, lane = tid & 63, w = tid >> 6, half = lane >> 5;
  bf16x8 afr[2][4];
  bf16x8 aW[2][2];
#pragma unroll
  for (int rt = 0; rt < 2; ++rt) {
    bool act = (rt == 0 ? T.nkeys0 : T.nkeys1) > 0;
    int qr = (act && rt == 1) ? T.qrow1 : T.qrow0;
    int m = qr + 4 * w + ((lane & 31) >> 3);
    const u16* ap = p.P + (size_t)m * NCOL + C_IQ + (lane & 7) * 64 + half * 8;
#pragma unroll
    for (int ks = 0; ks < 4; ++ks) afr[rt][ks] = *(const bf16x8*)(ap + ks * 16);
    const int rho = lane & 31;
    const bool vrow = (rho & ~5) == 0;
    const int qi = 2 * (rho & 1) + ((rho >> 2) & 1);
    float4 w4 = *(const float4*)(p.PS + (size_t)(qr + 4 * w + qi) * 128 + 80 + 4 * half);
    u32 lo = pack2(w4.x * IDX_W_SCALE, w4.y * IDX_W_SCALE), hi = pack2(w4.z * IDX_W_SCALE, w4.w * IDX_W_SCALE);
#pragma unroll
    for (int sx = 0; sx < 2; ++sx) {
      bool on = vrow && (qi >> 1) == sx;
      u32x4 wd = {0u, 0u, 0u, 0u};
      if (on && (qi & 1) == 0) { wd[0] = lo; wd[1] = hi; }
      if (on && (qi & 1) == 1) { wd[2] = lo; wd[3] = hi; }
      aW[rt][sx] = __builtin_bit_cast(bf16x8, wd);
    }
  }
  u32 thr[2][2]; int cnt[2][2];
#pragma unroll
  for (int rt = 0; rt < 2; ++rt)
#pragma unroll
    for (int pp = 0; pp < 2; ++pp) { thr[rt][pp] = 0u; cnt[rt][pp] = 0; }
  const int NH = T.nkeys0, NL = T.nkeys1;
  const int nkt = (NH + 63) >> 6;
  const unsigned long long lt = (1ull << lane) - 1ull;
#define SCORE(ACC, RT, K0, KEY0, KEY1, M0, M1) do { \
    const int N_ = (RT) == 0 ? NH : NL; \
    M0 = 0ull; M1 = 0ull; KEY0 = 0u; KEY1 = 0u; \
    if ((K0) < N_) { \
      const int keyidx = (K0) + (lane & 31); \
      const bool valid = keyidx < N_; \
      u32x4 xa_ = {cvt_pk_bf16(relu1(ACC[0]), relu1(ACC[1])), cvt_pk_bf16(relu1(ACC[2]), relu1(ACC[3])), \
                   cvt_pk_bf16(relu1(ACC[4]), relu1(ACC[5])), cvt_pk_bf16(relu1(ACC[6]), relu1(ACC[7]))}; \
      u32x4 xb_ = {cvt_pk_bf16(relu1(ACC[8]), relu1(ACC[9])), cvt_pk_bf16(relu1(ACC[10]), relu1(ACC[11])), \
                   cvt_pk_bf16(relu1(ACC[12]), relu1(ACC[13])), cvt_pk_bf16(relu1(ACC[14]), relu1(ACC[15]))}; \
      f32x16 s2_; \
      _Pragma("unroll") for (int r_ = 0; r_ < 16; ++r_) s2_[r_] = 0.f; \
      s2_ = __builtin_amdgcn_mfma_f32_32x32x16_bf16(aW[RT][0], __builtin_bit_cast(bf16x8, xa_), s2_, 0, 0, 0); \
      s2_ = __builtin_amdgcn_mfma_f32_32x32x16_bf16(aW[RT][1], __builtin_bit_cast(bf16x8, xb_), s2_, 0, 0, 0); \
      KEY0 = score_key(s2_[0], keyidx); \
      KEY1 = score_key(s2_[1], keyidx); \
      M0 = __ballot(valid && KEY0 > thr[RT][0]); \
      M1 = __ballot(valid && KEY1 > thr[RT][1]); \
    } } while (0)
#define APPEND(RT, PP, KEY, M) do { \
    if (M) { \
      bool pass = (M >> lane) & 1ull; \
      pass = pass && (KEY > thr[RT][PP]); \
      unsigned long long m = __ballot(pass); \
      u32 mh = half ? (u32)(m >> 32) : (u32)m; \
      int slot = (RT) * 16 + 4 * w + 2 * (PP) + half; \
      int pos = cnt[RT][PP] + __popc(mh & (u32)(lt >> (half * 32))); \
      if (pass) cand[slot * CAP + pos] = KEY; \
      cnt[RT][PP] += __popc(mh); \
      unsigned long long over = __ballot(cnt[RT][PP] > CLIMIT); \
      if (over) { \
        _Pragma("unroll") \
        for (int hh = 0; hh < 2; ++hh) { \
          if ((u32)(over >> (hh * 32)) != 0u) { \
            int sl = (RT) * 16 + 4 * w + 2 * (PP) + hh; \
            int n = __shfl(cnt[RT][PP], hh * 32); \
            int nc; u32 nt; \
            compact(cand + sl * CAP, n, 320, nc, nt); \
            if (half == hh) { cnt[RT][PP] = nc; thr[RT][PP] = nt; } \
          } \
        } \
      } \
    } } while (0)
  bf16x8 nA[4], nB[4];
#define BLOAD(kt) do { \
    int ka_ = (kt) * 64 + (lane & 31), kb_ = ka_ + 32; \
    ka_ = ka_ < NH ? ka_ : NH - 1; kb_ = kb_ < NH ? kb_ : NH - 1; \
    const u16* pa_ = T.ki + (size_t)ka_ * T.ki_stride + half * 8; \
    const u16* pb_ = T.ki + (size_t)kb_ * T.ki_stride + half * 8; \
    _Pragma("unroll") for (int ks = 0; ks < 4; ++ks) { nA[ks] = *(const bf16x8*)(pa_ + ks * 16); nB[ks] = *(const bf16x8*)(pb_ + ks * 16); } } while (0)
  BLOAD(0);
#pragma unroll 1
  for (int kt = 0; kt < nkt; ++kt) {
    const int k0a = kt * 64, k0b = kt * 64 + 32;
    bf16x8 bA[4], bB[4];
#pragma unroll
    for (int ks = 0; ks < 4; ++ks) { bA[ks] = nA[ks]; bB[ks] = nB[ks]; }
    if (kt + 1 < nkt) BLOAD(kt + 1);
    __builtin_amdgcn_sched_barrier(0);
    f32x16 aH0, aL0, aH1, aL1;
#pragma unroll
    for (int r = 0; r < 16; ++r) { aH0[r] = 0.f; aL0[r] = 0.f; aH1[r] = 0.f; aL1[r] = 0.f; }
    const bool lact = k0a < NL;
#pragma unroll
    for (int ks = 0; ks < 4; ++ks) {
      aH0 = __builtin_amdgcn_mfma_f32_32x32x16_bf16(afr[0][ks], bA[ks], aH0, 0, 0, 0);
      aH1 = __builtin_amdgcn_mfma_f32_32x32x16_bf16(afr[0][ks], bB[ks], aH1, 0, 0, 0);
    }
    if (lact) {
#pragma unroll
      for (int ks = 0; ks < 4; ++ks) {
        aL0 = __builtin_amdgcn_mfma_f32_32x32x16_bf16(afr[1][ks], bA[ks], aL0, 0, 0, 0);
        aL1 = __builtin_amdgcn_mfma_f32_32x32x16_bf16(afr[1][ks], bB[ks], aL1, 0, 0, 0);
      }
    }
    u32 kH0a, kH0b, kH1a, kH1b, kL0a, kL0b, kL1a, kL1b;
    unsigned long long mH0a, mH0b, mH1a, mH1b, mL0a, mL0b, mL1a, mL1b;
    SCORE(aH0, 0, k0a, kH0a, kH0b, mH0a, mH0b);
    SCORE(aH1, 0, k0b, kH1a, kH1b, mH1a, mH1b);
    SCORE(aL0, 1, k0a, kL0a, kL0b, mL0a, mL0b);
    SCORE(aL1, 1, k0b, kL1a, kL1b, mL1a, mL1b);
    if (mH0a | mH0b | mH1a | mH1b | mL0a | mL0b | mL1a | mL1b) {
      APPEND(0, 0, kH0a, mH0a); APPEND(0, 1, kH0b, mH0b);
      APPEND(0, 0, kH1a, mH1a); APPEND(0, 1, kH1b, mH1b);
      APPEND(1, 0, kL0a, mL0a); APPEND(1, 1, kL0b, mL0b);
      APPEND(1, 0, kL1a, mL1a); APPEND(1, 1, kL1b, mL1b);
    }
  }
  int* nselp = (int*)(lds + 32 * CAP * 4);
#pragma unroll
  for (int rt = 0; rt < 2; ++rt)
#pragma unroll
    for (int pp = 0; pp < 2; ++pp)
#pragma unroll
      for (int hh = 0; hh < 2; ++hh) {
        int sl = rt * 16 + 4 * w + 2 * pp + hh;
        int n = __shfl(cnt[rt][pp], hh * 32);
        if (n > 256) { int nc; u32 nt; compact(cand + sl * CAP, n, 256, nc, nt); n = nc; }
        if (lane == 0) nselp[sl] = n;
      }
#pragma unroll 1
  for (int qq = 0; qq < 8; ++qq) {
    int rt = qq >> 2, qi = qq & 3;
    if ((rt == 0 ? T.nkeys0 : T.nkeys1) == 0) continue;
    int sl = rt * 16 + 4 * w + qi;
    int nsel = nselp[sl];
    const u32* cq = cand + sl * CAP;
    int m = (rt == 0 ? T.qrow0 : T.qrow1) + 4 * w + qi;
    u32 k0 = 4 * lane + 0 < nsel ? 32767u - (cq[4 * lane + 0] & 0x7fffu) : 0u;
    u32 k1 = 4 * lane + 1 < nsel ? 32767u - (cq[4 * lane + 1] & 0x7fffu) : 0u;
    u32 k2 = 4 * lane + 2 < nsel ? 32767u - (cq[4 * lane + 2] & 0x7fffu) : 0u;
    u32 k3 = 4 * lane + 3 < nsel ? 32767u - (cq[4 * lane + 3] & 0x7fffu) : 0u;
    if (!dry) *(uint2*)(p.SEL + (size_t)m * 256 + 4 * lane) = make_uint2(k0 | (k1 << 16), k2 | (k3 << 16));
  }
  __syncthreads();
}

typedef __attribute__((ext_vector_type(2))) unsigned int u32x2;
__device__ __forceinline__ bf16x8 fp8x8_to_bf16x8(u32x2 x) {
  u32 a0, a1, a2, a3;
  fp8x4_to_bf16(x[0], a0, a1);
  fp8x4_to_bf16(x[1], a2, a3);
  u32x4 r = {a0, a1, a2, a3};
  return __builtin_bit_cast(bf16x8, r);
}
__device__ __forceinline__ void att_unit(const Params& p, int m, int g, int nsel, const u8* __restrict__ kv,
                                         const u16* sl, u16* vs, bool dry) {
  const int lane = TIDX & 63, g4 = lane >> 4, i16 = lane & 15;
  bf16x8 bq0, bq1;
  {
    bf16x8 z = {0, 0, 0, 0, 0, 0, 0, 0};
    const u16* qp = p.P + (size_t)m * NCOL + C_DQ + (g * 4 + (i16 & 3)) * 64 + g4 * 8;
    bq0 = i16 < 4 ? *(const bf16x8*)(qp) : z;
    bq1 = i16 < 4 ? *(const bf16x8*)(qp + 32) : z;
  }
  const int npad = (nsel + 31) & ~31;
  const int nchunk = (npad + 63) >> 6;
  const u8* kbase = kv + g * 128 + g4 * 8;
  const u8* vbase = kv + g * 128 + 64 + (lane & 3) * 16;
  u32x2 kc[4][2], kn[4][2];
#pragma unroll
  for (int tt = 0; tt < 4; ++tt) {
    const u8* kp = kbase + (size_t)sl[tt * 16 + i16] * 512;
    kc[tt][0] = *(const u32x2*)kp; kc[tt][1] = *(const u32x2*)(kp + 32);
    kn[tt][0] = kc[tt][0]; kn[tt][1] = kc[tt][1];
  }
  u32x4 vc[2][2], vn[2][2];
#pragma unroll
  for (int s2 = 0; s2 < 2; ++s2)
#pragma unroll
    for (int it = 0; it < 2; ++it) {
      vc[s2][it] = *(const u32x4*)(vbase + (size_t)sl[s2 * 32 + it * 16 + (lane >> 2)] * 512);
      vn[s2][it] = vc[s2][it];
    }
  float mrun = -3.0e38f, lrun = 0.f;
  f32x4 oacc[4];
#pragma unroll
  for (int dt = 0; dt < 4; ++dt) oacc[dt] = f32x4{0.f, 0.f, 0.f, 0.f};
#pragma unroll 1
  for (int c = 0; c < nchunk; ++c) {
    if (c + 1 < nchunk) {
#pragma unroll
      for (int s2 = 0; s2 < 2; ++s2)
#pragma unroll
        for (int it = 0; it < 2; ++it)
          vn[s2][it] = *(const u32x4*)(vbase + (size_t)sl[(c + 1) * 64 + s2 * 32 + it * 16 + (lane >> 2)] * 512);
#pragma unroll
      for (int tt = 0; tt < 4; ++tt) {
        const u8* kp = kbase + (size_t)sl[(c + 1) * 64 + tt * 16 + i16] * 512;
        kn[tt][0] = *(const u32x2*)kp; kn[tt][1] = *(const u32x2*)(kp + 32);
      }
    }
    __builtin_amdgcn_sched_barrier(0);
    f32x4 lg[4];
    float cmax = -3.0e38f;
#pragma unroll
    for (int tt = 0; tt < 4; ++tt) {
      f32x4 cc = {0.f, 0.f, 0.f, 0.f};
      cc = __builtin_amdgcn_mfma_f32_16x16x32_bf16(fp8x8_to_bf16x8(kc[tt][0]), bq0, cc, 0, 0, 0);
      cc = __builtin_amdgcn_mfma_f32_16x16x32_bf16(fp8x8_to_bf16x8(kc[tt][1]), bq1, cc, 0, 0, 0);
#pragma unroll
      for (int r = 0; r < 4; ++r) {
        int ks = (c * 4 + tt) * 16 + 4 * g4 + r;
        float v = ks < nsel ? cc[r] : -3.0e38f;
        lg[tt][r] = v; cmax = fmaxf(cmax, v);
      }
    }
    cmax = fmaxf(cmax, __shfl_xor(cmax, 16)); cmax = fmaxf(cmax, __shfl_xor(cmax, 32));
    float mnew = fmaxf(mrun, cmax);
    float alpha = __expf((mrun - mnew) * DSA_SCALE);
    mrun = mnew;
    bf16x8 pa[2];
    float psum = 0.f;
#pragma unroll
    for (int s2 = 0; s2 < 2; ++s2) {
#pragma unroll
      for (int r = 0; r < 4; ++r) {
        float e0 = __expf((lg[2 * s2][r] - mnew) * DSA_SCALE);
        float e1 = __expf((lg[2 * s2 + 1][r] - mnew) * DSA_SCALE);
        psum += e0 + e1;
        pa[s2][r] = (short)f2bf(e0); pa[s2][4 + r] = (short)f2bf(e1);
      }
    }
    lrun = lrun * alpha + psum;
    float al[4];
#pragma unroll
    for (int r = 0; r < 4; ++r) al[r] = __shfl(alpha, r);
#pragma unroll
    for (int dt = 0; dt < 4; ++dt)
#pragma unroll
      for (int r = 0; r < 4; ++r) oacc[dt][r] *= al[r];
#pragma unroll
    for (int s2 = 0; s2 < 2; ++s2) {
      __builtin_amdgcn_wave_barrier();
#pragma unroll
      for (int it = 0; it < 2; ++it) {
        u32 a0, a1, a2, a3, b0, b1, b2, b3;
        fp8x4_to_bf16(vc[s2][it][0], a0, a1); fp8x4_to_bf16(vc[s2][it][1], a2, a3);
        fp8x4_to_bf16(vc[s2][it][2], b0, b1); fp8x4_to_bf16(vc[s2][it][3], b2, b3);
        u32x4 w0 = {a0, a1, a2, a3}, w1 = {b0, b1, b2, b3};
        u16* vd = vs + (it * 16 + (lane >> 2)) * 64 + (lane & 3) * 16;
        *(u32x4*)vd = w0; *(u32x4*)(vd + 8) = w1;
      }
      __builtin_amdgcn_fence(__ATOMIC_RELEASE, "wavefront");
      __builtin_amdgcn_wave_barrier();
      __builtin_amdgcn_fence(__ATOMIC_ACQUIRE, "wavefront");
#pragma unroll
      for (int dt = 0; dt < 4; ++dt) {
        int q = i16 >> 2, pq = i16 & 3;
        const u16* a0 = vs + (4 * g4 + q) * 64 + dt * 16 + 4 * pq;
        const u16* a1 = vs + (16 + 4 * g4 + q) * 64 + dt * 16 + 4 * pq;
        s16x4 lo = __builtin_bit_cast(s16x4, __builtin_amdgcn_ds_read_tr16_b64_v4i16((lds_v4p)(a0)));
        s16x4 hi = __builtin_bit_cast(s16x4, __builtin_amdgcn_ds_read_tr16_b64_v4i16((lds_v4p)(a1)));
        bf16x8 bv = {lo[0], lo[1], lo[2], lo[3], hi[0], hi[1], hi[2], hi[3]};
        oacc[dt] = __builtin_amdgcn_mfma_f32_16x16x32_bf16(pa[s2], bv, oacc[dt], 0, 0, 0);
      }
    }
#pragma unroll
    for (int tt = 0; tt < 4; ++tt) { kc[tt][0] = kn[tt][0]; kc[tt][1] = kn[tt][1]; }
#pragma unroll
    for (int s2 = 0; s2 < 2; ++s2) { vc[s2][0] = vn[s2][0]; vc[s2][1] = vn[s2][1]; }
  }
  float sum = lrun;
  sum += __shfl_xor(sum, 16); sum += __shfl_xor(sum, 32);
  float inv[4];
#pragma unroll
  for (int r = 0; r < 4; ++r) inv[r] = 1.f / __shfl(sum, r);
  if (lane < 16 && !dry) {
    size_t o = (size_t)m * NCOL;
#pragma unroll
    for (int r = 0; r < 4; ++r)
#pragma unroll
      for (int dt = 0; dt < 4; ++dt) {
        int col = (g * 4 + r) * 64 + dt * 16 + lane;
        float z = bf2f(p.P[o + C_DZ + col]);
        p.P[o + C_DQ + col] = f2bf(oacc[dt][r] * inv[r] * siluf_(z));
      }
  }
}

__device__ __forceinline__ void att_item(const Params& p, int m0, int g, int nsel, const u8* __restrict__ kv,
                                         u16* slw, u16* vs, bool dry) {
  const int lane = TIDX & 63, g4 = lane >> 4, i16 = lane & 15;
  const int npad = (nsel + 31) & ~31;
  const int nchunk = (npad + 63) >> 6;
  const u8* kbase = kv + g * 128 + g4 * 8;
  const u8* vbase = kv + g * 128 + 64 + (lane & 3) * 16;
  const bf16x8 zf = {0, 0, 0, 0, 0, 0, 0, 0};
  u32x2 selr = *(const u32x2*)(p.SEL + (size_t)m0 * 256 + 4 * lane);
  __builtin_amdgcn_wave_barrier();
  *(u32x2*)(slw + 4 * lane) = selr;
  __builtin_amdgcn_fence(__ATOMIC_RELEASE, "wavefront");
  __builtin_amdgcn_wave_barrier();
  __builtin_amdgcn_fence(__ATOMIC_ACQUIRE, "wavefront");
  selr = *(const u32x2*)(p.SEL + (size_t)(m0 + 1) * 256 + 4 * lane);
  bf16x8 bq0, bq1, bn0, bn1;
  {
    const u16* qp = p.P + (size_t)m0 * NCOL + C_DQ + (g * 4 + (i16 & 3)) * 64 + g4 * 8;
    bq0 = i16 < 4 ? *(const bf16x8*)(qp) : zf;
    bq1 = i16 < 4 ? *(const bf16x8*)(qp + 32) : zf;
    bn0 = bq0; bn1 = bq1;
  }
  u32x2 kc[4][2], kn[4][2];
  u32x4 vc[2][2], vn[2][2];
#pragma unroll
  for (int tt = 0; tt < 4; ++tt) {
    const u8* kp = kbase + (size_t)slw[tt * 16 + i16] * 512;
    kc[tt][0] = *(const u32x2*)kp; kc[tt][1] = *(const u32x2*)(kp + 32);
    kn[tt][0] = kc[tt][0]; kn[tt][1] = kc[tt][1];
  }
#pragma unroll
  for (int s2 = 0; s2 < 2; ++s2)
#pragma unroll
    for (int it = 0; it < 2; ++it) {
      vc[s2][it] = *(const u32x4*)(vbase + (size_t)slw[s2 * 32 + it * 16 + (lane >> 2)] * 512);
      vn[s2][it] = vc[s2][it];
    }
  float mrun = -3.0e38f, lrun = 0.f;
  f32x4 oacc[4];
#pragma unroll
  for (int dt = 0; dt < 4; ++dt) oacc[dt] = f32x4{0.f, 0.f, 0.f, 0.f};
  const int nt = 4 * nchunk;
  int u = 0, c = 0;
#pragma unroll 1
  for (int t = 0; t < nt; ++t) {
    const int m = m0 + u;
    if (c + 1 < nchunk) {
      const u16* slc = slw + (u & 1) * 256 + (c + 1) * 64;
#pragma unroll
      for (int s2 = 0; s2 < 2; ++s2)
#pragma unroll
        for (int it = 0; it < 2; ++it)
          vn[s2][it] = *(const u32x4*)(vbase + (size_t)slc[s2 * 32 + it * 16 + (lane >> 2)] * 512);
#pragma unroll
      for (int tt = 0; tt < 4; ++tt) {
        const u8* kp = kbase + (size_t)slc[tt * 16 + i16] * 512;
        kn[tt][0] = *(const u32x2*)kp; kn[tt][1] = *(const u32x2*)(kp + 32);
      }
    } else if (u + 1 < 4) {
      u16* sln = slw + ((u + 1) & 1) * 256;
      __builtin_amdgcn_wave_barrier();
      *(u32x2*)(sln + 4 * lane) = selr;
      __builtin_amdgcn_fence(__ATOMIC_RELEASE, "wavefront");
      __builtin_amdgcn_wave_barrier();
      __builtin_amdgcn_fence(__ATOMIC_ACQUIRE, "wavefront");
      if (u + 2 < 4) selr = *(const u32x2*)(p.SEL + (size_t)(m + 2) * 256 + 4 * lane);
#pragma unroll
      for (int s2 = 0; s2 < 2; ++s2)
#pragma unroll
        for (int it = 0; it < 2; ++it)
          vn[s2][it] = *(const u32x4*)(vbase + (size_t)sln[s2 * 32 + it * 16 + (lane >> 2)] * 512);
#pragma unroll
      for (int tt = 0; tt < 4; ++tt) {
        const u8* kp = kbase + (size_t)sln[tt * 16 + i16] * 512;
        kn[tt][0] = *(const u32x2*)kp; kn[tt][1] = *(const u32x2*)(kp + 32);
      }
      const u16* qp = p.P + (size_t)(m + 1) * NCOL + C_DQ + (g * 4 + (i16 & 3)) * 64 + g4 * 8;
      bn0 = i16 < 4 ? *(const bf16x8*)(qp) : zf;
      bn1 = i16 < 4 ? *(const bf16x8*)(qp + 32) : zf;
    }
    __builtin_amdgcn_sched_barrier(0);
    f32x4 lg[4];
    float cmax = -3.0e38f;
#pragma unroll
    for (int tt = 0; tt < 4; ++tt) {
      f32x4 cc = {0.f, 0.f, 0.f, 0.f};
      cc = __builtin_amdgcn_mfma_f32_16x16x32_bf16(fp8x8_to_bf16x8(kc[tt][0]), bq0, cc, 0, 0, 0);
      cc = __builtin_amdgcn_mfma_f32_16x16x32_bf16(fp8x8_to_bf16x8(kc[tt][1]), bq1, cc, 0, 0, 0);
#pragma unroll
      for (int r = 0; r < 4; ++r) {
        int ks = (c * 4 + tt) * 16 + 4 * g4 + r;
        float v = ks < nsel ? cc[r] : -3.0e38f;
        lg[tt][r] = v; cmax = fmaxf(cmax, v);
      }
    }
    cmax = fmaxf(cmax, __shfl_xor(cmax, 16)); cmax = fmaxf(cmax, __shfl_xor(cmax, 32));
    float mnew = fmaxf(mrun, cmax);
    float alpha = __expf((mrun - mnew) * DSA_SCALE);
    mrun = mnew;
    bf16x8 pa[2];
    float psum = 0.f;
#pragma unroll
    for (int s2 = 0; s2 < 2; ++s2) {
#pragma unroll
      for (int r = 0; r < 4; ++r) {
        float e0 = __expf((lg[2 * s2][r] - mnew) * DSA_SCALE);
        float e1 = __expf((lg[2 * s2 + 1][r] - mnew) * DSA_SCALE);
        psum += e0 + e1;
        pa[s2][r] = (short)f2bf(e0); pa[s2][4 + r] = (short)f2bf(e1);
      }
    }
    lrun = lrun * alpha + psum;
    float al[4];
#pragma unroll
    for (int r = 0; r < 4; ++r) al[r] = __shfl(alpha, r);
#pragma unroll
    for (int dt = 0; dt < 4; ++dt)
#pragma unroll
      for (int r = 0; r < 4; ++r) oacc[dt][r] *= al[r];
#pragma unroll
    for (int s2 = 0; s2 < 2; ++s2) {
      __builtin_amdgcn_wave_barrier();
#pragma unroll
      for (int it = 0; it < 2; ++it) {
        u32 a0, a1, a2, a3, b0, b1, b2, b3;
        fp8x4_to_bf16(vc[s2][it][0], a0, a1); fp8x4_to_bf16(vc[s2][it][1], a2, a3);
        fp8x4_to_bf16(vc[s2][it][2], b0, b1); fp8x4_to_bf16(vc[s2][it][3], b2, b3);
        u32x4 w0 = {a0, a1, a2, a3}, w1 = {b0, b1, b2, b3};
        u16* vd = vs + (it * 16 + (lane >> 2)) * 64 + (lane & 3) * 16;
        *(u32x4*)vd = w0; *(u32x4*)(vd + 8) = w1;
      }
      __builtin_amdgcn_fence(__ATOMIC_RELEASE, "wavefront");
      __builtin_amdgcn_wave_barrier();
      __builtin_amdgcn_fence(__ATOMIC_ACQUIRE, "wavefront");
#pragma unroll
      for (int dt = 0; dt < 4; ++dt) {
        int q = i16 >> 2, pq = i16 & 3;
        const u16* a0 = vs + (4 * g4 + q) * 64 + dt * 16 + 4 * pq;
        const u16* a1 = vs + (16 + 4 * g4 + q) * 64 + dt * 16 + 4 * pq;
        s16x4 lo = __builtin_bit_cast(s16x4, __builtin_amdgcn_ds_read_tr16_b64_v4i16((lds_v4p)(a0)));
        s16x4 hi = __builtin_bit_cast(s16x4, __builtin_amdgcn_ds_read_tr16_b64_v4i16((lds_v4p)(a1)));
        bf16x8 bv = {lo[0], lo[1], lo[2], lo[3], hi[0], hi[1], hi[2], hi[3]};
        oacc[dt] = __builtin_amdgcn_mfma_f32_16x16x32_bf16(pa[s2], bv, oacc[dt], 0, 0, 0);
      }
    }
#pragma unroll
    for (int tt = 0; tt < 4; ++tt) { kc[tt][0] = kn[tt][0]; kc[tt][1] = kn[tt][1]; }
#pragma unroll
    for (int s2 = 0; s2 < 2; ++s2) { vc[s2][0] = vn[s2][0]; vc[s2][1] = vn[s2][1]; }
    if (c == nchunk - 1) {
      float sum = lrun;
      sum += __shfl_xor(sum, 16); sum += __shfl_xor(sum, 32);
      float inv[4];
#pragma unroll
      for (int r = 0; r < 4; ++r) inv[r] = 1.f / __shfl(sum, r);
      __builtin_amdgcn_wave_barrier();
      if (lane < 16) {
#pragma unroll
        for (int r = 0; r < 4; ++r)
#pragma unroll
          for (int dt = 0; dt < 4; ++dt) vs[r * 64 + dt * 16 + lane] = f2bf(oacc[dt][r] * inv[r]);
      }
      __builtin_amdgcn_fence(__ATOMIC_RELEASE, "wavefront");
      __builtin_amdgcn_wave_barrier();
      __builtin_amdgcn_fence(__ATOMIC_ACQUIRE, "wavefront");
      if (lane < 32 && !dry) {
        size_t o = (size_t)m * NCOL + g * 256 + lane * 8;
        u32x4 ov = *(const u32x4*)(vs + lane * 8);
        u32x4 zv = *(const u32x4*)(p.P + o + C_DZ);
        u32x4 rv;
#pragma unroll
        for (int k = 0; k < 4; ++k) {
          float o0 = bf2f((u16)(ov[k] & 0xffff)), o1 = bf2f((u16)(ov[k] >> 16));
          float z0 = bf2f((u16)(zv[k] & 0xffff)), z1 = bf2f((u16)(zv[k] >> 16));
          rv[k] = pack2(o0 * siluf_(z0), o1 * siluf_(z1));
        }
        *(u32x4*)(p.P + o + C_DQ) = rv;
      }
      __builtin_amdgcn_wave_barrier();

      mrun = -3.0e38f; lrun = 0.f;
#pragma unroll
      for (int dt = 0; dt < 4; ++dt) oacc[dt] = f32x4{0.f, 0.f, 0.f, 0.f};
      bq0 = bn0; bq1 = bn1;
      c = 0; ++u;
    } else ++c;
  }
}

__device__ __forceinline__ void phase_att(const Params& p, int pass, char* lds, bool dry, unsigned xcc) {
  const int tid = TIDX, lane = tid & 63, w = tid >> 6;
  u16* sl = (u16*)lds + w * 512;
  u16* vs = (u16*)(lds + 4096) + w * (32 * 64);
  int* item = (int*)(lds + 4096 + 4 * 4096);
  const int ngroups = 1024 + (pass == 1 ? 32 : 0);
  unsigned* ctr = p.bar + XCD_BAR_WORDS + (dry ? 16 : 0) + pass * 4;
  int gsel = (int)(xcc & 3u);
  int tries = 0;
  while (tries < 4) {
    __syncthreads();
    if (tid == 0) *item = (int)atomicAdd(&ctr[gsel], 1u);
    __syncthreads();
    int it = *item;
    if (it >= ngroups) { gsel = (gsel + 1) & 3; ++tries; continue; }
    int row0, nsel; const u8* kv;
    if (it < 1024) {
      int c = it >> 2;
      row0 = 16 + 16 * it; int n = 80 + 64 * c; nsel = n < 256 ? n : 256;
      kv = p.KV8P;
    } else {
      int sb = it - 1024;
      row0 = SEQP + 16 * sb; nsel = 256;
      kv = p.KV8S + (size_t)sb * NKEYS_S * 512;
    }
    att_item(p, row0 + 4 * w, gsel, nsel, kv, sl, vs, dry);
  }
}

__device__ __forceinline__ void phase_dsa(const Params& p, int pass, char* lds, bool dry) {
  int ntiles = 512 + (pass == 1 ? 32 : 0);
  for (int t = blockIdx.x; t < ntiles; t += gridDim.x) {
    DTile T;
    if (t < 512) {
      int c = t >> 2, qq = t & 3;
      int chh = 255 - c, cl = c;
      T.qrow0 = 16 + 64 * chh + 16 * qq; T.nkeys0 = 80 + 64 * chh;
      T.qrow1 = 16 + 64 * cl + 16 * qq;  T.nkeys1 = 80 + 64 * cl;
      T.ki = p.KI; T.ki_stride = 64;
      T.kv = nullptr; T.kv_stride = 0;
    } else {
      int sb = t - 512;
      T.qrow0 = SEQP + 16 * sb; T.nkeys0 = NKEYS_S;
      T.qrow1 = SEQP + 16 * sb; T.nkeys1 = 0;
      T.ki = p.KIS + (size_t)sb * NKEYS_S * 64; T.ki_stride = 64;
      T.kv = nullptr; T.kv_stride = 0;
    }
    dsa_tile(p, T, lds, dry);
  }
}

template <int BR>
__device__ __forceinline__ void merge_half(const Params& p, int R, int m0, int n0, char* ldsc, bool dry) {
  const int tid = TIDX, lane = tid & 63, w = tid >> 6, wm = w >> 1, wn = w & 1;
  u16* lds = (u16*)ldsc;
  f32x16 acc[2][2];
#pragma unroll
  for (int i = 0; i < 2; ++i)
#pragma unroll
    for (int j = 0; j < 2; ++j)
#pragma unroll
      for (int r = 0; r < 16; ++r) acc[i][j][r] = 0.f;
  gemm_core(p.P + (BR == 0 ? C_GV : C_DQ), NCOL, m0, R, BR == 0 ? p.WglaT : p.WdsaT, DM, n0, DM, acc, lds);
#pragma unroll
  for (int tm = 0; tm < 2; ++tm)
#pragma unroll
    for (int tn = 0; tn < 2; ++tn)
#pragma unroll
      for (int r = 0; r < 16; ++r)
        lds[ACC_ROW(wm, tm, r, lane) * ES + ACC_COL(wn, tn, lane)] = f2bf(acc[tm][tn][r]);
  __syncthreads();
  const int ch = tid & 15;
  float gb[8];
#pragma unroll
  for (int k = 0; k < 8; ++k) gb[k] = p.gate_b[(BR == 0 ? 0 : DM) + n0 + ch * 8 + k];
  u32x4 mvv[8], pvv[8];
#pragma unroll
  for (int i = 0; i < 8; ++i) {
    int row = (tid >> 4) + 16 * i;
    mvv[i] = u32x4{0u, 0u, 0u, 0u}; pvv[i] = u32x4{0u, 0u, 0u, 0u};
    if (m0 + row < R) {
      size_t o = (size_t)(m0 + row) * NCOL + n0 + ch * 8;
      mvv[i] = *(const u32x4*)(p.P + o + (BR == 0 ? C_MA : C_MB));
      if (BR == 1) pvv[i] = *(const u32x4*)(p.P + o + C_MA);
    }
  }
  __builtin_amdgcn_sched_barrier(0);
#pragma unroll
  for (int i = 0; i < 8; ++i) {
    int row = (tid >> 4) + 16 * i;
    if (m0 + row < R && !dry) {
      size_t o = (size_t)(m0 + row) * NCOL + n0 + ch * 8;
      u32x4 yv = *(const u32x4*)(lds + row * ES + ch * 8);
      u32x4 ow;
#pragma unroll
      for (int k = 0; k < 4; ++k) {
        float y0 = bf2f((u16)(yv[k] & 0xffff)), y1 = bf2f((u16)(yv[k] >> 16));
        float g0 = sigmoidf_(bf2f((u16)(mvv[i][k] & 0xffff)) + gb[2 * k]), g1 = sigmoidf_(bf2f((u16)(mvv[i][k] >> 16)) + gb[2 * k + 1]);
        float r0 = g0 * y0, r1 = g1 * y1;
        if (BR == 1) { r0 += bf2f((u16)(pvv[i][k] & 0xffff)); r1 += bf2f((u16)(pvv[i][k] >> 16)); }
        ow[k] = pack2(r0, r1);
      }
      *(u32x4*)(p.P + o + C_MA) = ow;
    }
  }
  __syncthreads();
}
__device__ __forceinline__ void phase_merge(const Params& p, int pass, char* lds, bool dry) {
  int R = pass_rows(pass);
  int mt = (R + 127) >> 7;
  unsigned* ctr = p.bar + XCD_BAR_WORDS + 72 + (dry ? 8 : 0) + pass;
  for (int t = dq_next(ctr, lds); t < mt * 8; t = dq_next(ctr, lds)) {
    int tn_ = t & 7, tm_ = t >> 3;
    int m0 = tm_ * 128, n0 = tn_ * 128;
    merge_half<0>(p, R, m0, n0, lds, dry);
    merge_half<1>(p, R, m0, n0, lds, dry);
  }
}

__device__ __forceinline__ void phase_out(const Params& p, int pass, char* lds) {
  int R = pass_rows(pass), r0 = pass_row0(pass);
  int mt = (R + 127) >> 7;
  int lane = TIDX & 63, w = TIDX >> 6, wm = w >> 1, wn = w & 1;
  unsigned* ctr = p.bar + XCD_BAR_WORDS + 88 + pass;
  for (int t = dq_next(ctr, lds); t < mt * 8; t = dq_next(ctr, lds)) {
    int tn_ = t & 7, tm_ = t >> 3;
    int m0 = tm_ * 128, n0 = tn_ * 128;
    f32x16 acc[2][2];
#pragma unroll
    for (int i = 0; i < 2; ++i)
#pragma unroll
      for (int j = 0; j < 2; ++j)
#pragma unroll
        for (int r = 0; r < 16; ++r) acc[i][j][r] = 0.f;
    gemm_core(p.P + C_MA, NCOL, m0, R, p.WoutT, DM, n0, DM, acc, (u16*)lds);
    float lg_[2], lb_[2];
#pragma unroll
    for (int tn = 0; tn < 2; ++tn) { int n = n0 + ACC_COL(wn, tn, lane); lg_[tn] = p.ln_in_g[n]; lb_[tn] = p.ln_in_b[n]; }
#pragma unroll
    for (int tm = 0; tm < 2; ++tm) {
      float xv[16][2], mu_[16], rs_[16];
#pragma unroll
      for (int r = 0; r < 16; ++r) {
        int m = m0 + ACC_ROW(wm, tm, r, lane);
        xv[r][0] = 0.f; xv[r][1] = 0.f; mu_[r] = 0.f; rs_[r] = 0.f;
        if (m < R) {
          int gr = r0 + m;
          const float* x = xrow_ptr(p, gr);
          mu_[r] = p.STATS[gr * 2]; rs_[r] = p.STATS[gr * 2 + 1];
          xv[r][0] = x[n0 + ACC_COL(wn, 0, lane)]; xv[r][1] = x[n0 + ACC_COL(wn, 1, lane)];
        }
      }
      __builtin_amdgcn_sched_barrier(0);
#pragma unroll
      for (int r = 0; r < 16; ++r) {
        int m = m0 + ACC_ROW(wm, tm, r, lane);
        if (m < R) {
          float* y = yrow_ptr(p, r0 + m);
          if (y) {
#pragma unroll
            for (int tn = 0; tn < 2; ++tn) {
              float hh = (xv[r][tn] - mu_[r]) * rs_[r] * lg_[tn] + lb_[tn];
              y[n0 + ACC_COL(wn, tn, lane)] = ALPHA_F * hh + acc[tm][tn][r];
            }
          }
        }
      }
    }
  }
}

__device__ __forceinline__ void phase_ln_out(const Params& p, int pass, bool dry) {
  int R = pass_rows(pass), r0 = pass_row0(pass);
  int wave = TIDX >> 6, lane = TIDX & 63;
  for (int m = blockIdx.x * 4 + wave; m < R; m += gridDim.x * 4) {
    float* y = yrow_ptr(p, r0 + m);
    if (!y) continue;
    float4 v[4];
    float s = 0.f;
#pragma unroll
    for (int i = 0; i < 4; ++i) { v[i] = *(const float4*)(y + i * 256 + lane * 4); s += v[i].x + v[i].y + v[i].z + v[i].w; }
    float mu = wave_sum(s) * (1.f / DM);
    float q = 0.f;
#pragma unroll
    for (int i = 0; i < 4; ++i) {
      float a = v[i].x - mu, b = v[i].y - mu, c = v[i].z - mu, d = v[i].w - mu;
      q += a * a + b * b + c * c + d * d;
    }
    float rstd = rsqrtf(wave_sum(q) * (1.f / DM) + NORM_EPS);
#pragma unroll
    for (int i = 0; i < 4; ++i) {
      int c = i * 256 + lane * 4;
      float4 g = *(const float4*)(p.ln_g + c), b = *(const float4*)(p.ln_b + c);
      float4 o;
      o.x = (v[i].x - mu) * rstd * g.x + b.x; o.y = (v[i].y - mu) * rstd * g.y + b.y;
      o.z = (v[i].z - mu) * rstd * g.z + b.z; o.w = (v[i].w - mu) * rstd * g.w + b.w;
      if (!dry) *(float4*)(y + c) = o;
    }
  }
}

#define LDS_BYTES 77824
#define NPHASE 9
#ifndef PHASE_MASK
#define PHASE_MASK 0x7ff
#endif
#define EN(x) (((PHASE_MASK) >> (x)) & 1)
__device__ __forceinline__ void run_phase(const Params& p, int pass, int ph, char* lds, bool dry = false, unsigned xcc = 0) {
  switch (ph) {
    case 0: if (EN(0)) { if (pass == 0) phase_prep(p, lds); phase_ln_in(p, pass); } break;
    case 1: if (EN(1)) phase_gemm1(p, pass, lds, xcc); break;
    case 2: if (EN(2)) phase_tok(p, pass, lds, dry); break;
    case 3: if (EN(3)) phase_u(p, pass, lds); break;
    case 4: if (EN(4)) phase_scan(p, pass, dry); break;
    case 5: if (EN(5)) phase_dsa(p, pass, lds, dry); break;
    case 9: if (EN(9)) phase_o(p, pass, lds, dry); break;
    case 10: if (EN(10)) phase_att(p, pass, lds, dry, xcc); break;
    case 6: if (EN(6)) phase_merge(p, pass, lds, dry); break;
    case 7: if (EN(7)) phase_out(p, pass, lds); break;
    case 8: if (EN(8)) phase_ln_out(p, pass, dry); break;
  }
}

#if ONE_LAUNCH
#ifndef PROBE_BAR2
#define PROBE_BAR2 0
#endif
#define XBAR do { xcd_barrier(xb); if (PROBE_BAR2) xcd_barrier(xb); } while (0)
#ifndef PROBE_REP
#define PROBE_REP 0
#endif
#define RUNP(ph) do { if ((PROBE_REP >> (ph)) & 1) run_phase(p, pass, ph, lds, true, xb.x); run_phase(p, pass, ph, lds, false, xb.x); } while (0)
__global__ void __launch_bounds__(256, 2) fwd_kernel(Params p) {
  __shared__ __attribute__((aligned(16))) char lds[LDS_BYTES];
  __shared__ uint4 xb_words;
  cg::grid_group grid = cg::this_grid();
  if (threadIdx.x == 0) xb_words = make_uint4(0u, 0u, 0u, 0u);
  __syncthreads();
  XcdBarrier xb = xcd_barrier_post(p.bar, (volatile LAS unsigned*)&xb_words);
#pragma unroll 1
  for (int pass = 0; pass < 2; ++pass) {
    RUNP(0);
    if (pass == 0) grid.sync(); else XBAR;
    RUNP(1); XBAR;
    RUNP(2); XBAR;
    RUNP(3); XBAR;
    RUNP(4); XBAR;
    RUNP(5);
    RUNP(9); XBAR;
    RUNP(10); XBAR;
    RUNP(6); XBAR;
    RUNP(7); XBAR;
    RUNP(8);
  }
}
#else
template <int PH>
__global__ void __launch_bounds__(256, 2) phase_kernel(Params p, int pass) {
  __shared__ __attribute__((aligned(16))) char lds[LDS_BYTES];
  run_phase(p, pass, PH, lds, false, xb_xcc_id());
}
#endif

static inline size_t align_up(size_t x) { return (x + 255) & ~(size_t)255; }

extern "C" void kernel_launch(void* const* d_in, const int* in_sizes, int n_in, void* d_out, int out_size,
                              void* d_ws, size_t ws_size, hipStream_t stream) {
  Params p{};
  const float* const* in = (const float* const*)d_in;
  p.x_prompt = in[0]; p.x_sample = in[1]; p.cache_k = in[2]; p.cache_v = in[3]; p.cache_idx_k = in[4];
  p.state_gla = in[5]; p.meta = in[6]; p.ln_in_g = in[7]; p.ln_in_b = in[8]; p.w_in = in[9]; p.gla_w2 = in[10];
  p.gla_gate_b = in[11]; p.gla_norm_g = in[12]; p.idx_kn_g = in[13]; p.idx_kn_b = in[14]; p.w_gla = in[15];
  p.w_dsa = in[16]; p.gate_b = in[17]; p.w_out = in[18]; p.ln_g = in[19]; p.ln_b = in[20];
  float* o = (float*)d_out;
  p.y_prompt = o; o += (size_t)2 * 16384 * 1024;
  p.y_sample = o; o += (size_t)32 * 16 * 1024;
  p.k_prompt = o; o += (size_t)2 * SEQP * 256;
  p.v_prompt = o; o += (size_t)2 * SEQP * 256;
  p.idx_k_prompt = o; o += (size_t)2 * SEQP * 64;
  p.gla_prompt = o; o += (size_t)2 * 131072;
  p.k_sample = o; o += (size_t)512 * 256;
  p.v_sample = o; o += (size_t)512 * 256;
  p.idx_k_sample = o; o += (size_t)512 * 64;
  p.gla_sample = o; o += (size_t)32 * 131072;
  char* wsp = (char*)d_ws;
  size_t off = 0;
  auto take = [&](size_t bytes) { char* r = wsp + off; off = align_up(off + bytes); return r; };
  p.WinT = (u16*)take((size_t)NCOL * DM * 2);
  p.WglaT = (u16*)take((size_t)DM * DM * 2);
  p.WdsaT = (u16*)take((size_t)DM * DM * 2);
  p.WoutT = (u16*)take((size_t)DM * DM * 2);
  p.H = (u16*)take((size_t)RPMAX * DM * 2);
  p.P = (u16*)take((size_t)(RPMAX + 8) * NCOL * 2);
  p.KI = (u16*)take((size_t)RPMAX * 64 * 2);
  p.US = (u16*)take((size_t)289 * 131072 * 2);
  p.KV8S = (u8*)take((size_t)32 * NKEYS_S * 512);
  p.KV8P = (u8*)take((size_t)SEQP * 512);
  p.KIS = (u16*)take((size_t)32 * NKEYS_S * 64 * 2);
  p.SEL = (u16*)take((size_t)RPMAX * 256 * 2);
  p.STATS = (float*)take((size_t)NROWS * 2 * 4);
  p.PS = (float*)take((size_t)RPMAX * 128 * 4);
  p.DEC = (float*)take((size_t)289 * 512 * 4);
  p.bar = (unsigned*)take((size_t)(XCD_BAR_WORDS + 128) * 4);
  if (off > ws_size) { fprintf(stderr, "workspace too small: need %zu have %zu\n", off, ws_size); return; }
#if ONE_LAUNCH
  static int grid_blocks = 0;
  if (!grid_blocks) {
    int dev = 0, cus = 0, per_cu = 0;
    hipGetDevice(&dev);
    hipDeviceGetAttribute(&cus, hipDeviceAttributeMultiprocessorCount, dev);
    hipOccupancyMaxActiveBlocksPerMultiprocessor(&per_cu, fwd_kernel, 256, 0);
    per_cu = 2;
    grid_blocks = cus * per_cu;
  }
  (void)hipMemsetAsync(p.bar, 0, (size_t)(XCD_BAR_WORDS + 128) * 4, stream);
  void* args[] = {&p};
  hipError_t e = hipLaunchCooperativeKernel((void*)fwd_kernel, dim3(grid_blocks), dim3(256), args, 0, stream);
  if (e != hipSuccess) fprintf(stderr, "cooperative launch failed: %s (grid %d)\n", hipGetErrorString(e), grid_blocks);
#else
  (void)hipMemsetAsync(p.bar, 0, (size_t)(XCD_BAR_WORDS + 128) * 4, stream);
  for (int pass = 0; pass < 2; ++pass) {
    phase_kernel<0><<<512, 256, 0, stream>>>(p, pass);
    phase_kernel<1><<<512, 256, 0, stream>>>(p, pass);
    phase_kernel<2><<<512, 256, 0, stream>>>(p, pass);
    phase_kernel<3><<<512, 256, 0, stream>>>(p, pass);
    phase_kernel<4><<<512, 256, 0, stream>>>(p, pass);
    phase_kernel<5><<<512, 256, 0, stream>>>(p, pass);
    phase_kernel<10><<<512, 256, 0, stream>>>(p, pass);
    phase_kernel<9><<<512, 256, 0, stream>>>(p, pass);
    phase_kernel<6><<<512, 256, 0, stream>>>(p, pass);
    phase_kernel<7><<<512, 256, 0, stream>>>(p, pass);
    phase_kernel<8><<<512, 256, 0, stream>>>(p, pass);
  }
#endif
}
```
